# Optimizing an MI355X kernel written in HIP

```python
import math
import jax, jax.numpy as jnp
from jax import lax
import numpy as np

D_MODEL = 1024
BATCH = 4
SEQ = 8192
DEPTH = 4

CHUNK = 64
Q_BLOCK = 128
EPS = 1e-6
NEG_INF = -1e30

GM_WIDTH = 512
GM_GROUPS = 4
GM_CH = GM_WIDTH // GM_GROUPS
GM_SPAN = 128

MLA_HEADS = 4
MLA_Q_RANK = 256
MLA_KV_RANK = 128
MLA_NOPE = 128
MLA_ROPE = 64
MLA_V = 128
ROPE_THETA = 10000.0

DIFF_HEADS = 4
DIFF_HEAD = 64
DIFF_V = 2 * DIFF_HEAD

REL_BUCKETS = 32
REL_MAX_DIST = 128

N_BRANCH = 3
BRANCH_WIDTH = 512

FFN_DENSE = 2816
N_EXPERTS = 8
TOP_K = 2
FFN_EXPERT = 3584
N_DENSE = (DEPTH + 1) // 2
N_MOE = DEPTH // 2

A_COLS = 2 * GM_WIDTH
C_Q_COLS = DIFF_HEADS * 2 * DIFF_HEAD
C_K_COLS = DIFF_HEADS * 2 * DIFF_HEAD
C_V_COLS = DIFF_HEADS * DIFF_V
IN_SIZES = (A_COLS, MLA_Q_RANK, MLA_KV_RANK, MLA_ROPE, C_Q_COLS, C_K_COLS, C_V_COLS)
IN_SPLITS = tuple(int(v) for v in np.cumsum(IN_SIZES)[:-1])
IN_WIDTH = int(sum(IN_SIZES))

kernel_name = 'hybrid_gmlp_mla_diffattn_moe_encoder'


def rmsnorm(x, g):
    xf = x.astype(jnp.float32)
    y = xf * lax.rsqrt(jnp.mean(xf * xf, axis=-1, keepdims=True) + EPS)
    return (y * g.astype(jnp.float32)).astype(x.dtype)


def layernorm(x, g, b):
    xf = x.astype(jnp.float32)
    mu = jnp.mean(xf, axis=-1, keepdims=True)
    xc = xf - mu
    y = xc * lax.rsqrt(jnp.mean(xc * xc, axis=-1, keepdims=True) + EPS)
    return (y * g.astype(jnp.float32) + b.astype(jnp.float32)).astype(x.dtype)


def rope_tables(seq):
    pos = jnp.arange(seq, dtype=jnp.float32)
    inv = ROPE_THETA ** (-jnp.arange(0, MLA_ROPE, 2, dtype=jnp.float32) / MLA_ROPE)
    ang = pos[:, None] * inv[None, :]
    return jnp.cos(ang), jnp.sin(ang)


def rope(x, cos, sin):
    half = x.shape[-1] // 2
    x1, x2 = x[..., :half], x[..., half:]
    return jnp.concatenate([x1 * cos - x2 * sin, x2 * cos + x1 * sin], axis=-1).astype(x.dtype)


def chunk_mask(q_idx, k_idx):
    return (k_idx[None, :] // CHUNK) <= (q_idx[:, None] // CHUNK)


def rel_bucket(rel):
    nb = REL_BUCKETS // 2
    max_exact = nb // 2
    ret = jnp.where(rel > 0, nb, 0)
    n = jnp.abs(rel)
    nf = jnp.maximum(n, 1).astype(jnp.float32)
    large = max_exact + (jnp.log(nf / max_exact) / math.log(REL_MAX_DIST / max_exact) * (nb - max_exact)).astype(jnp.int32)
    large = jnp.minimum(large, nb - 1)
    return ret + jnp.where(n < max_exact, n, large)


def lambda_init(layer):
    return 0.8 - 0.6 * math.exp(-0.3 * layer)


def gmlp_branch(uv, ln_g, ln_b, w_s, b_s):
    b, s, _ = uv.shape
    uv = jax.nn.gelu(uv)
    u, v = uv[..., :GM_WIDTH], uv[..., GM_WIDTH:]
    v = layernorm(v, ln_g, ln_b).reshape(b, s // GM_SPAN, GM_SPAN, GM_GROUPS, GM_CH)
    p = jnp.arange(GM_SPAN)
    w = jnp.where(chunk_mask(p, p)[None], w_s, jnp.zeros_like(w_s))
    v = jnp.einsum('gpq,bnqgc->bnpgc', w, v) + b_s.T[None, None, :, :, None]
    return u * v.reshape(b, s, GM_WIDTH)


def mla_branch(cq, ckv, kr, g_cq, g_ckv, w_uq, w_ukv, cos, sin):
    b, s, _ = cq.shape
    q = (rmsnorm(cq, g_cq) @ w_uq).reshape(b, s, MLA_HEADS, MLA_NOPE + MLA_ROPE)
    q_nope = q[..., :MLA_NOPE].transpose(0, 2, 1, 3)
    q_rope = rope(q[..., MLA_NOPE:], cos[:, None], sin[:, None]).transpose(0, 2, 1, 3)
    kv = (rmsnorm(ckv, g_ckv) @ w_ukv).reshape(b, s, MLA_HEADS, MLA_NOPE + MLA_V)
    k_nope = kv[..., :MLA_NOPE].transpose(0, 2, 1, 3)
    v = kv[..., MLA_NOPE:].transpose(0, 2, 1, 3)
    k_rope = rope(kr, cos, sin)
    scale = (MLA_NOPE + MLA_ROPE) ** -0.5
    k_idx = jnp.arange(s)

    def block(blk):
        qs = blk * Q_BLOCK
        qn = lax.dynamic_slice_in_dim(q_nope, qs, Q_BLOCK, axis=2)
        qr = lax.dynamic_slice_in_dim(q_rope, qs, Q_BLOCK, axis=2)
        logits = (jnp.einsum('bhqd,bhkd->bhqk', qn, k_nope)
                  + jnp.einsum('bhqr,bkr->bhqk', qr, k_rope)).astype(jnp.float32) * scale
        mask = chunk_mask(qs + jnp.arange(Q_BLOCK), k_idx)
        p = jax.nn.softmax(jnp.where(mask, logits, NEG_INF), axis=-1)
        return jnp.einsum('bhqk,bhkd->bqhd', p.astype(v.dtype), v)

    out = lax.map(block, jnp.arange(s // Q_BLOCK))
    return out.transpose(1, 0, 2, 3, 4).reshape(b, s, MLA_HEADS * MLA_V)


def diff_branch(dq, dk, dv, lq1, lk1, lq2, lk2, g_sub, rel_bias, lam_init):
    b, s, _ = dq.shape
    q = dq.reshape(b, s, DIFF_HEADS, 2, DIFF_HEAD)
    k = dk.reshape(b, s, DIFF_HEADS, 2, DIFF_HEAD)
    q1 = q[..., 0, :].transpose(0, 2, 1, 3)
    q2 = q[..., 1, :].transpose(0, 2, 1, 3)
    k1 = k[..., 0, :].transpose(0, 2, 1, 3)
    k2 = k[..., 1, :].transpose(0, 2, 1, 3)
    v = dv.reshape(b, s, DIFF_HEADS, DIFF_V).transpose(0, 2, 1, 3)
    lam = (jnp.exp(jnp.sum(lq1.astype(jnp.float32) * lk1.astype(jnp.float32)))
           - jnp.exp(jnp.sum(lq2.astype(jnp.float32) * lk2.astype(jnp.float32))) + lam_init)
    scale = DIFF_HEAD ** -0.5
    k_idx = jnp.arange(s)

    def block(blk):
        qs = blk * Q_BLOCK
        q_idx = qs + jnp.arange(Q_BLOCK)
        q1b = lax.dynamic_slice_in_dim(q1, qs, Q_BLOCK, axis=2)
        q2b = lax.dynamic_slice_in_dim(q2, qs, Q_BLOCK, axis=2)
        bias = jnp.moveaxis(rel_bias[rel_bucket(k_idx[None, :] - q_idx[:, None])], -1, 0).astype(jnp.float32)
        mask = chunk_mask(q_idx, k_idx)
        s1 = jnp.einsum('bhqd,bhkd->bhqk', q1b, k1).astype(jnp.float32) * scale + bias
        s2 = jnp.einsum('bhqd,bhkd->bhqk', q2b, k2).astype(jnp.float32) * scale + bias
        a = (jax.nn.softmax(jnp.where(mask, s1, NEG_INF), axis=-1)
             - lam * jax.nn.softmax(jnp.where(mask, s2, NEG_INF), axis=-1))
        return jnp.einsum('bhqk,bhkd->bqhd', a.astype(v.dtype), v)

    out = lax.map(block, jnp.arange(s // Q_BLOCK))
    out = out.transpose(1, 0, 2, 3, 4).reshape(b, s, DIFF_HEADS, DIFF_V)
    out = rmsnorm(out, g_sub) * (1.0 - lam_init)
    return out.reshape(b, s, DIFF_HEADS * DIFF_V)


def swiglu(h, w1, w3, w2):
    return (jax.nn.silu(h @ w1) * (h @ w3)) @ w2


def moe_ffn(h, router, w1, w3, w2):
    logits = (h @ router).astype(jnp.float32)
    top_v, top_i = lax.top_k(logits, TOP_K)
    top_w = jax.nn.softmax(top_v, axis=-1)
    gates = jnp.sum(jax.nn.one_hot(top_i, N_EXPERTS, dtype=jnp.float32) * top_w[..., None], axis=-2)
    gates = gates.astype(h.dtype)
    y = gates[..., 0:1] * swiglu(h, w1[0], w3[0], w2[0])
    for e in range(1, N_EXPERTS):
        y = y + gates[..., e:e + 1] * swiglu(h, w1[e], w3[e], w2[e])
    return y


def setup_inputs(seed: int = 0) -> dict:
    key = jax.random.key(seed)
    ks = jax.random.split(key, 40)

    def nrm(i, shape, scale):
        return jax.random.normal(ks[i], shape, jnp.float32) * scale

    def gain(i, shape):
        return 1.0 + nrm(i, shape, 0.02)

    L = DEPTH
    D = D_MODEL
    return {
        'x': nrm(0, (BATCH, SEQ, D), 1.0),
        'g_mix': gain(1, (L, D)),
        'w_in': nrm(2, (L, D, IN_WIDTH), D ** -0.5),
        'gm_ln_g': gain(3, (L, GM_WIDTH)),
        'gm_ln_b': nrm(4, (L, GM_WIDTH), 0.02),
        'gm_w_s': nrm(5, (L, GM_GROUPS, GM_SPAN, GM_SPAN), GM_SPAN ** -0.5),
        'gm_b_s': gain(6, (L, GM_GROUPS, GM_SPAN)),
        'mla_g_cq': gain(7, (L, MLA_Q_RANK)),
        'mla_g_ckv': gain(8, (L, MLA_KV_RANK)),
        'mla_w_uq': nrm(9, (L, MLA_Q_RANK, MLA_HEADS * (MLA_NOPE + MLA_ROPE)), MLA_Q_RANK ** -0.5),
        'mla_w_ukv': nrm(10, (L, MLA_KV_RANK, MLA_HEADS * (MLA_NOPE + MLA_V)), MLA_KV_RANK ** -0.5),
        'diff_lq1': nrm(11, (L, DIFF_HEAD), 0.1),
        'diff_lk1': nrm(12, (L, DIFF_HEAD), 0.1),
        'diff_lq2': nrm(13, (L, DIFF_HEAD), 0.1),
        'diff_lk2': nrm(14, (L, DIFF_HEAD), 0.1),
        'diff_g_sub': gain(15, (L, DIFF_V)),
        'rel_bias': nrm(16, (REL_BUCKETS, DIFF_HEADS), 0.2),
        'w_gate': nrm(17, (L, N_BRANCH, D, D), D ** -0.5),
        'b_gate': nrm(18, (L, N_BRANCH, D), 0.02),
        'w_branch': nrm(19, (L, N_BRANCH, BRANCH_WIDTH, D), BRANCH_WIDTH ** -0.5),
        'w_o': nrm(20, (L, D, D), D ** -0.5),
        'g_ffn': gain(21, (L, D)),
        'ffn_w1': nrm(22, (N_DENSE, D, FFN_DENSE), D ** -0.5),
        'ffn_w3': nrm(23, (N_DENSE, D, FFN_DENSE), D ** -0.5),
        'ffn_w2': nrm(24, (N_DENSE, FFN_DENSE, D), FFN_DENSE ** -0.5),
        'moe_router': nrm(25, (N_MOE, D, N_EXPERTS), D ** -0.5),
        'moe_w1': nrm(26, (N_MOE, N_EXPERTS, D, FFN_EXPERT), D ** -0.5),
        'moe_w3': nrm(27, (N_MOE, N_EXPERTS, D, FFN_EXPERT), D ** -0.5),
        'moe_w2': nrm(28, (N_MOE, N_EXPERTS, FFN_EXPERT, D), FFN_EXPERT ** -0.5),
        'g_final': gain(29, (D,)),
    }


def reference(x, g_mix, w_in, gm_ln_g, gm_ln_b, gm_w_s, gm_b_s, mla_g_cq, mla_g_ckv, mla_w_uq, mla_w_ukv,
              diff_lq1, diff_lk1, diff_lq2, diff_lk2, diff_g_sub, rel_bias, w_gate, b_gate, w_branch, w_o,
              g_ffn, ffn_w1, ffn_w3, ffn_w2, moe_router, moe_w1, moe_w3, moe_w2, g_final):
    cos, sin = rope_tables(x.shape[1])
    for l in range(DEPTH):
        h = rmsnorm(x, g_mix[l])
        uv, cq, ckv, kr, dq, dk, dv = jnp.split(h @ w_in[l], IN_SPLITS, axis=-1)
        br_a = gmlp_branch(uv, gm_ln_g[l], gm_ln_b[l], gm_w_s[l], gm_b_s[l])
        br_b = mla_branch(cq, ckv, kr, mla_g_cq[l], mla_g_ckv[l], mla_w_uq[l], mla_w_ukv[l], cos, sin)
        br_c = diff_branch(dq, dk, dv, diff_lq1[l], diff_lk1[l], diff_lq2[l], diff_lk2[l], diff_g_sub[l],
                           rel_bias, lambda_init(l))
        merged = None
        for n, br in enumerate((br_a, br_b, br_c)):
            gate = jax.nn.sigmoid((h @ w_gate[l, n] + b_gate[l, n]).astype(jnp.float32)).astype(x.dtype)
            term = gate * (br @ w_branch[l, n])
            merged = term if merged is None else merged + term
        x = x + merged @ w_o[l]
        h = rmsnorm(x, g_ffn[l])
        if l % 2 == 0:
            i = l // 2
            x = x + swiglu(h, ffn_w1[i], ffn_w3[i], ffn_w2[i])
        else:
            i = l // 2
            x = x + moe_ffn(h, moe_router[i], moe_w1[i], moe_w3[i], moe_w2[i])
    return rmsnorm(x, g_final)
```

```cpp
#include <hip/hip_runtime.h>
#include <cstdio>
#include <cstdint>

#define GAS __attribute__((address_space(1)))
#define LAS __attribute__((address_space(3)))
typedef unsigned short bf16_t;
typedef short bf16x8 __attribute__((ext_vector_type(8)));
typedef short s16x4 __attribute__((ext_vector_type(4)));
typedef float f32x2 __attribute__((ext_vector_type(2)));
typedef float f32x4 __attribute__((ext_vector_type(4)));
typedef float f32x16 __attribute__((ext_vector_type(16)));
typedef unsigned u32x2 __attribute__((ext_vector_type(2)));
typedef unsigned u32x4 __attribute__((ext_vector_type(4)));

#ifndef MK_MULTI
#define MK_MULTI 0
#endif
#ifndef MK_CHECK
#define MK_CHECK 0
#endif

constexpr int T = 32768, DM = 1024, SEQ = 8192, NBATCH = 4, NLAYER = 4;
constexpr int NCAT = 6144;
constexpr int FD = 2816, FE = 3584, NEXP = 8;
constexpr int MAXROWS = 65536 + NEXP * 256;
constexpr float EPS = 1e-6f;
constexpr float LOG2E = 1.4426950408889634f;
constexpr float QS_MLA = 0.07216878364870322f * LOG2E;
constexpr float QS_DIF = 0.125f * LOG2E;

constexpr size_t MiB = 1u << 20;
constexpr size_t WS_CTL = 0, CTL_ZERO_BYTES = 1 * MiB;
constexpr size_t WS_ROPEC = 1 * MiB, WS_ROPES = 2 * MiB;
constexpr size_t WS_BIAST = 3 * MiB;
constexpr size_t WS_LAM = 3 * MiB + 8192;
constexpr size_t WS_META = 3 * MiB + 16384;
constexpr size_t WS_CQP = 4 * MiB, WS_CKVP = 4 * MiB + 512 * 1024;
constexpr size_t WS_SEL = 5 * MiB;
constexpr size_t WS_SLOT = 5 * MiB + 512 * 1024;
constexpr size_t WS_CNT = 5 * MiB + 768 * 1024;
constexpr size_t WS_ROWW = 6 * MiB;
constexpr size_t WS_WMIX = 8 * MiB, WMIX_STRIDE = 18 * MiB;
constexpr size_t WM_CAT = 0, WM_UQ = 12 * MiB, WM_UKV = 12 * MiB + 512 * 1024, WM_B = 13 * MiB, WM_O = 16 * MiB;
constexpr size_t WS_WDEN = 80 * MiB, WDEN_STRIDE = 16 * MiB + 512 * 1024;
constexpr size_t WD_13 = 0, WD_2 = 11 * MiB;
constexpr size_t WS_WMOE = 113 * MiB;
constexpr size_t WE_13 = 0, WE_2 = 112 * MiB;
constexpr size_t WS_H = 281 * MiB;
constexpr size_t WS_R = 345 * MiB;
constexpr size_t R_UV = 0, R_MERGED = 0, R_CQ = 64 * MiB, R_CKV = 80 * MiB, R_DQ = 96 * MiB, R_K12 = 128 * MiB, R_VD = 160 * MiB,
                 R_G = 192 * MiB, R_QM = 384 * MiB, R_KM = 432 * MiB, R_VM = 480 * MiB, R_BR = 512 * MiB;
constexpr size_t R_HMD = 0;
constexpr size_t R_XG = 0, R_Y = 0, R_HME = 132 * MiB;
constexpr size_t WS_END = 953 * MiB;
static_assert(R_HME + (size_t)MAXROWS * FE * 2 <= 608 * MiB, "moe hidden fits");
static_assert((size_t)MAXROWS * 2048 == 132 * MiB, "xg size");

constexpr int RING_BYTES = 131072;
constexpr int MISC_OFF = RING_BYTES;
constexpr int LDS_BYTES = 147456;
constexpr int NWAVES = 8, NTHR = 512;

typedef __bf16 bf16x2_t __attribute__((ext_vector_type(2)));
__device__ __forceinline__ unsigned cvt_pk_bf16(float lo, float hi) { f32x2 v = {lo, hi}; bf16x2_t b = __builtin_convertvector(v, bf16x2_t); return __builtin_bit_cast(unsigned, b); }
__device__ __forceinline__ float bf2f(unsigned short b) { return __uint_as_float(((unsigned)b) << 16); }
__device__ __forceinline__ float bflo(unsigned w) { return __uint_as_float(w << 16); }
__device__ __forceinline__ float bfhi(unsigned w) { return __uint_as_float(w & 0xffff0000u); }
__device__ __forceinline__ u32x4 pack8(f32x4 a, f32x4 b) { u32x4 w; w.x = cvt_pk_bf16(a[0], a[1]); w.y = cvt_pk_bf16(a[2], a[3]); w.z = cvt_pk_bf16(b[0], b[1]); w.w = cvt_pk_bf16(b[2], b[3]); return w; }
__device__ __forceinline__ float fast_exp2(float x) { return __builtin_amdgcn_exp2f(x); }
__device__ __forceinline__ float fast_rcp(float x) { return __builtin_amdgcn_rcpf(x); }
#if MK_CHECK == 36
__device__ __forceinline__ float sigmoidf_(float z) { return 1.0f / (1.0f + expf(-z)); }
#else
__device__ __forceinline__ float sigmoidf_(float z) { return fast_rcp(1.0f + fast_exp2(-z * LOG2E)); }
#endif
__device__ __forceinline__ float gelu_tanh(float x) { const float u = 0.7978845608028654f * (x + 0.044715f * x * x * x); return x * fast_rcp(1.0f + fast_exp2(-2.0f * LOG2E * u)); }
template <int CTRL> __device__ __forceinline__ float dppf(float v) { return __int_as_float(__builtin_amdgcn_update_dpp(0, __float_as_int(v), CTRL, 0xf, 0xf, true)); }
template <int CTRL> __device__ __forceinline__ int dppi(int v) { return __builtin_amdgcn_update_dpp(0, v, CTRL, 0xf, 0xf, true); }
__device__ __forceinline__ float sum_x16(float v) { auto r = __builtin_amdgcn_permlane16_swap(__float_as_uint(v), __float_as_uint(v), false, false); return __uint_as_float(r[0]) + __uint_as_float(r[1]); }
__device__ __forceinline__ float sum_x32(float v) { auto r = __builtin_amdgcn_permlane32_swap(__float_as_uint(v), __float_as_uint(v), false, false); return __uint_as_float(r[0]) + __uint_as_float(r[1]); }
__device__ __forceinline__ int isum_x16(int v) { auto r = __builtin_amdgcn_permlane16_swap((unsigned)v, (unsigned)v, false, false); return (int)(r[0] + r[1]); }
__device__ __forceinline__ int isum_x32(int v) { auto r = __builtin_amdgcn_permlane32_swap((unsigned)v, (unsigned)v, false, false); return (int)(r[0] + r[1]); }
__device__ __forceinline__ float wave_sum(float v) {
    v += dppf<0xB1>(v); v += dppf<0x4E>(v); v += dppf<0x141>(v); v += dppf<0x140>(v); v = sum_x16(v); return sum_x32(v);
}
__device__ __forceinline__ int wave_isum(int v) {
    v += dppi<0xB1>(v); v += dppi<0x4E>(v); v += dppi<0x141>(v); v += dppi<0x140>(v); v = isum_x16(v); return isum_x32(v);
}
__device__ __forceinline__ int opaque_tid() { int t = threadIdx.x; asm volatile("" : "+v"(t)); return t; }
#define LDS_WAIT() asm volatile("s_waitcnt lgkmcnt(0)" ::: "memory")
#define VM_WAIT() asm volatile("s_waitcnt vmcnt(0)" ::: "memory")

__device__ __forceinline__ size_t km_addr(int bh, int tile, int chunk, int kv) { return ((((size_t)bh * 128 + tile) * 24 + chunk) * 64 + kv) * 8; }
__device__ __forceinline__ size_t k12_addr(int bh, int tile, int map, int chunk, int kv) { return (((((size_t)bh * 128 + tile) * 2 + map) * 8 + chunk) * 64 + kv) * 8; }
__device__ __forceinline__ size_t vimg_addr(int bh, int tile, int dblk, int kv) { return ((((size_t)bh * 128 + tile) * 4 + dblk) * 64 + kv) * 32; }

#define XB_TMO      128
#define XB_XCNT(j)  (256  + 64 * (j))
#define XB_XSUB(j)  (1280 + 64 * (j))
#define XB_XGEN(j)  (2304 + 64 * (j))
#define XB_TOP      3328
#define XB_TOPGEN   3392
#define XCD_BAR_WORDS 3456
#define XB_SPIN_CAP (1u << 20)

__device__ __forceinline__ unsigned xb_ld(unsigned* p)              { return __hip_atomic_load(p, __ATOMIC_RELAXED, __HIP_MEMORY_SCOPE_AGENT); }
__device__ __forceinline__ unsigned xb_add(unsigned* p, unsigned v) { return __hip_atomic_fetch_add(p, v, __ATOMIC_RELAXED, __HIP_MEMORY_SCOPE_AGENT); }
__device__ __forceinline__ unsigned xb_xcc_id() { return (unsigned)__builtin_amdgcn_s_getreg((3 << 11) | 20) & 0xFu; }
#define XB_SPIN(cond, bar) do { unsigned _sp = 0; while (cond) { __builtin_amdgcn_s_sleep(1); \
    if ((++_sp & 255u) == 0u) { if (xb_ld(&(bar)[XB_TMO])) break; if (_sp > XB_SPIN_CAP) { atomicAdd(&(bar)[XB_TMO], 1u); break; } } } } while (0)

struct XcdBarrier { unsigned* bar; unsigned x; volatile LAS unsigned* st; };

__device__ __forceinline__ XcdBarrier xcd_barrier_post(unsigned* bar, volatile LAS unsigned* st) {
    XcdBarrier b; b.bar = bar; b.x = xb_xcc_id(); b.st = st;
    if (threadIdx.x == 0) (void)xb_add(&bar[XB_XCNT(b.x)], 1u);
    return b;
}
__device__ __forceinline__ void xcd_barrier_complete(unsigned* bar, unsigned x, unsigned& nloc, unsigned& nx) {
    const unsigned G = gridDim.x * gridDim.y * gridDim.z;
    unsigned sum, cnt, mine, sp = 0u;
    for (;;) {
        sum = 0u; cnt = 0u; mine = 0u;
#pragma unroll
        for (unsigned j = 0; j < 16; ++j) { const unsigned c = xb_ld(&bar[XB_XCNT(j)]); sum += c; cnt += (c > 0u) ? 1u : 0u; mine = (j == x) ? c : mine; }
        if (sum == G) break;
        __builtin_amdgcn_s_sleep(1);
        if ((++sp & 255u) == 0u) { if (xb_ld(&bar[XB_TMO])) break; if (sp > XB_SPIN_CAP) { atomicAdd(&bar[XB_TMO], 1u); break; } }
    }
    nloc = mine > 0u ? mine : 1u; nx = cnt > 0u ? cnt : 1u;
}
__device__ __forceinline__ void xcd_barrier(const XcdBarrier& b) {
    asm volatile("s_waitcnt vmcnt(0)" ::: "memory");
    __syncthreads();
    if (threadIdx.x == 0) {
        unsigned* bar = b.bar;
        __builtin_amdgcn_s_waitcnt(0);
        unsigned nloc = b.st[0], nx = b.st[1];
        if (nloc == 0u) { xcd_barrier_complete(bar, b.x, nloc, nx); b.st[0] = nloc; b.st[1] = nx; }
        const unsigned old = xb_add(&bar[XB_XSUB(b.x)], 1u);
        const unsigned gen = old / nloc;
        if (old + 1u == (gen + 1u) * nloc) {
            __builtin_amdgcn_fence(__ATOMIC_RELEASE, "agent");
            asm volatile("s_waitcnt vmcnt(0)" ::: "memory");
            const unsigned og = xb_add(&bar[XB_TOP], 1u);
            const unsigned tg = og / nx;
            if (og + 1u == (tg + 1u) * nx) xb_add(&bar[XB_TOPGEN], 1u);
            else XB_SPIN(xb_ld(&bar[XB_TOPGEN]) == tg, bar);
            __builtin_amdgcn_fence(__ATOMIC_ACQUIRE, "agent");
            xb_add(&bar[XB_XGEN(b.x)], 1u);
            asm volatile("s_waitcnt vmcnt(0)" ::: "memory");
        } else {
            XB_SPIN(xb_ld(&bar[XB_XGEN(b.x)]) == gen, bar);
            __builtin_amdgcn_fence(__ATOMIC_ACQUIRE, "agent");
            asm volatile("s_waitcnt vmcnt(0)" ::: "memory");
        }
    }
    __syncthreads();
}
namespace pg8 {
constexpr int BM = 256, BK = 64, HALF = 128, HTB = HALF * BK * 2, STAGE_BYTES = 8 * HTB, NXCD = 8, WGM = 8;
__host__ __device__ __forceinline__ int lds_byte(int r, int c) { const int st = (r >> 4) * 2 + (c >> 5), rr = r & 15, cc = c & 31, ob = rr * 64 + cc * 2; return st * 1024 + (ob ^ (((ob >> 9) & 1) << 5)); }
__host__ __device__ __forceinline__ void stage_rc(int b, int& R, int& C) { const int st = b / 1024, sb = b % 1024, swz = sb ^ (((sb >> 9) & 1) << 5); R = (st >> 1) * 16 + swz / 64; C = (st & 1) * 32 + (swz % 64) / 2; }
__host__ __device__ __forceinline__ int perm32(int rho) { const int n = rho >> 4, i = rho & 15; return 8 * (i >> 2) + 4 * n + (i & 3); }

struct Unit { int pm, pn, aux; const char* a; const char* b; };
struct Gemm { int K; int lda, ldb; };

__device__ __forceinline__ void tile_of(int wgid, int nM, int nN, int& pm, int& pn) {
    const int nwg = nM * nN;
    { const int q = nwg / NXCD, r = nwg % NXCD, xcd = wgid % NXCD, off = wgid / NXCD; wgid = (xcd < r ? xcd * (q + 1) : r * (q + 1) + (xcd - r) * q) + off; }
    const int nig = WGM * nN, gid = wgid / nig, fm = gid * WGM, gsz = (nM - fm) < WGM ? (nM - fm) : WGM;
    pm = fm + ((wgid % nig) % gsz); pn = (wgid % nig) / gsz;
}

template <class Epi, class Sched>
__device__ __forceinline__ void gemm_phase(LAS unsigned char* lds, const Gemm g, const Sched& S, const Epi& E) {
    const int tid = opaque_tid(), wid = __builtin_amdgcn_readfirstlane(tid >> 6), lane = tid & 63, wr = wid >> 2, wc = wid & 3, fr = lane & 15, fq = lane >> 4;
    const int K = g.K, nt = K / BK;
    unsigned voffA[2], voffB[2];
#pragma unroll
    for (int i = 0; i < 2; ++i) { int R, C; stage_rc(tid * 16 + i * 8192, R, C); const int Rb = Epi::PERM ? ((R & ~31) + perm32(R & 31)) : R;
        voffA[i] = (unsigned)(R * g.lda + C) * 2u; voffB[i] = (unsigned)(Rb * g.ldb + C) * 2u; }
    const size_t kstep = (size_t)(BK * 2);
    const size_t hstepA = (size_t)HALF * g.lda * 2, hstepB = (size_t)HALF * g.ldb * 2;
    const unsigned ldsw = (unsigned)wid * 1024u;
    const int aoff = lds_byte(wr * 64 + fr, fq * 8), boff = lds_byte(wc * 32 + fr, fq * 8);
#define PG8_SA(b, h) (((b) * 2 + (h)) * HTB)
#define PG8_SB(b, h) ((4 + (b) * 2 + (h)) * HTB)
#define PG8_STAGE(bufoff, gbase, voff) do { _Pragma("unroll") for (int _i = 0; _i < 2; ++_i) \
        __builtin_amdgcn_global_load_lds((const unsigned*)((const char*)(gbase) + (voff)[_i]), (LAS unsigned*)(lds + (bufoff) + ldsw + _i * 8192), 16, 0, 0); } while (0)
#define PG8_LDA(dst, b, h) do { _Pragma("unroll") for (int m = 0; m < 4; ++m) _Pragma("unroll") for (int k = 0; k < 2; ++k) dst[m][k] = *(const LAS bf16x8*)(lds + PG8_SA(b, h) + aoff + m * 2048 + k * 1024); } while (0)
#define PG8_LDB(dst, b, h) do { _Pragma("unroll") for (int n = 0; n < 2; ++n) _Pragma("unroll") for (int k = 0; k < 2; ++k) dst[n][k] = *(const LAS bf16x8*)(lds + PG8_SB(b, h) + boff + n * 2048 + k * 1024); } while (0)
#define PG8_MMA(ai, bj, At, Bt) do { __builtin_amdgcn_s_setprio(1); _Pragma("unroll") for (int m = 0; m < 4; ++m) _Pragma("unroll") for (int n = 0; n < 2; ++n) _Pragma("unroll") for (int k = 0; k < 2; ++k) \
        acc[ai][bj][m][n] = __builtin_amdgcn_mfma_f32_16x16x32_bf16(Bt[n][k], At[m][k], acc[ai][bj][m][n], 0, 0, 0); __builtin_amdgcn_s_setprio(0); } while (0)
#define PG8_WAIT_V(n) asm volatile("s_waitcnt vmcnt(" #n ")" ::: "memory")
#define PG8_WAIT_L(n) asm volatile("s_waitcnt lgkmcnt(" #n ")" ::: "memory")
#define PG8_BAR __builtin_amdgcn_s_barrier()
#define PG8_SCHED __builtin_amdgcn_sched_barrier(0)
    Unit cur, nxt; int ui = 0;
    if (!S.next(0, cur)) return;
    f32x4 acc[2][2][4][2];
#pragma unroll
    for (int a = 0; a < 2; ++a)
#pragma unroll
        for (int b = 0; b < 2; ++b)
#pragma unroll
            for (int m = 0; m < 4; ++m)
#pragma unroll
                for (int n = 0; n < 2; ++n) acc[a][b][m][n] = (f32x4){0.f, 0.f, 0.f, 0.f};
    bf16x8 At[4][2], B0[2][2], B1[2][2];
    const char* cA = cur.a; const char* cB = cur.b;
    PG8_STAGE(PG8_SB(0, 0), cB, voffB); PG8_STAGE(PG8_SB(0, 1), cB + hstepB, voffB); PG8_STAGE(PG8_SA(0, 0), cA, voffA); PG8_STAGE(PG8_SA(0, 1), cA + hstepA, voffA);
    if (wr == 1) PG8_BAR;
    PG8_WAIT_V(2); PG8_BAR;
    PG8_STAGE(PG8_SB(1, 0), cB + kstep, voffB); PG8_STAGE(PG8_SA(1, 0), cA + kstep, voffA); PG8_STAGE(PG8_SB(1, 1), cB + hstepB + kstep, voffB);
    PG8_WAIT_V(6); PG8_BAR;
    for (;;) {
        const bool has_next = S.next(ui + 1, nxt);
        const char* nA = has_next ? nxt.a : cA; const char* nB = has_next ? nxt.b : cB;
#pragma nounroll
        for (int t = 0; t < nt; t += 2) {
            const bool last = (t == nt - 2);
            const char* a1 = cA + (size_t)(t + 1) * kstep;
            const char* a2 = last ? nA : cA + (size_t)(t + 2) * kstep; const char* b2 = last ? nB : cB + (size_t)(t + 2) * kstep;
            const char* a3 = a2 + kstep; const char* b3 = b2 + kstep;
            PG8_LDB(B0, 0, 0); PG8_LDB(B1, 0, 1); PG8_SCHED; PG8_LDA(At, 0, 0); PG8_STAGE(PG8_SA(1, 1), a1 + hstepA, voffA);
            PG8_WAIT_V(8); PG8_WAIT_L(0); PG8_BAR; PG8_MMA(0, 0, At, B0); PG8_MMA(0, 1, At, B1); PG8_BAR; PG8_SCHED;
            PG8_LDA(At, 0, 1); PG8_STAGE(PG8_SB(0, 0), b2, voffB); PG8_STAGE(PG8_SB(0, 1), b2 + hstepB, voffB); PG8_STAGE(PG8_SA(0, 0), a2, voffA);
            PG8_WAIT_V(8); PG8_WAIT_L(0); PG8_BAR; PG8_MMA(1, 0, At, B0); PG8_MMA(1, 1, At, B1); PG8_BAR; PG8_SCHED;
            PG8_LDB(B0, 1, 0); PG8_LDB(B1, 1, 1); PG8_SCHED; PG8_LDA(At, 1, 0); PG8_STAGE(PG8_SA(0, 1), a2 + hstepA, voffA);
            PG8_WAIT_V(8); PG8_WAIT_L(0); PG8_BAR; PG8_MMA(0, 0, At, B0); PG8_MMA(0, 1, At, B1); PG8_BAR; PG8_SCHED;
            PG8_LDA(At, 1, 1); PG8_STAGE(PG8_SB(1, 0), b3, voffB); PG8_STAGE(PG8_SB(1, 1), b3 + hstepB, voffB); PG8_STAGE(PG8_SA(1, 0), a3, voffA);
            PG8_WAIT_V(8); PG8_WAIT_L(0); PG8_BAR; PG8_MMA(1, 0, At, B0); PG8_MMA(1, 1, At, B1); PG8_BAR; PG8_SCHED;
        }
        if (wr == 0) PG8_BAR;
        E(acc, cur, wr, wc, fr, fq);
        if (!has_next) break;
#pragma unroll
        for (int a = 0; a < 2; ++a)
#pragma unroll
            for (int b = 0; b < 2; ++b)
#pragma unroll
                for (int m = 0; m < 4; ++m)
#pragma unroll
                    for (int n = 0; n < 2; ++n) acc[a][b][m][n] = (f32x4){0.f, 0.f, 0.f, 0.f};
        cur = nxt; cA = nA; cB = nB; ++ui;
        if (wr == 1) PG8_BAR;
    }
    PG8_WAIT_V(0);
    PG8_BAR;
#undef PG8_SA
#undef PG8_SB
#undef PG8_STAGE
#undef PG8_LDA
#undef PG8_LDB
#undef PG8_MMA
#undef PG8_WAIT_V
#undef PG8_WAIT_L
#undef PG8_BAR
#undef PG8_SCHED
}

struct SchedDense {
    int nM, nN, G, c; const char* A; const char* B; size_t astep, bstep;
    __device__ __forceinline__ bool next(int i, Unit& u) const {
        const long L = (long)i * G + c; if (L >= (long)nM * nN) return false;
        tile_of((int)L, nM, nN, u.pm, u.pn); u.aux = 0; u.a = A + (size_t)u.pm * astep; u.b = B + (size_t)u.pn * bstep; return true;
    }
};
struct SchedBranch {
    int nM, nN, G, c; const char* A; const char* B; size_t astep, bstep, asub, bsub;
    __device__ __forceinline__ bool next(int i, Unit& u) const {
        const int n = i % 3; const long L = (long)(i / 3) * G + c; if (L >= (long)nM * nN) return false;
        tile_of((int)L, nM, nN, u.pm, u.pn); u.aux = n; u.a = A + (size_t)u.pm * astep + (size_t)n * asub; u.b = B + (size_t)u.pn * bstep + (size_t)n * bsub; return true;
    }
};
struct SchedMoe {
    int nM, nN, G, c; const char* A; const char* B; size_t astep, bstep, bexp; int ts[9];
    __device__ __forceinline__ bool next(int i, Unit& u) const {
        const long L = (long)i * G + c; if (L >= (long)nM * nN) return false;
        tile_of((int)L, nM, nN, u.pm, u.pn); int e = 0;
#pragma unroll
        for (int j = 1; j < 8; ++j) e += (u.pm >= ts[j]) ? 1 : 0;
        u.aux = e; u.a = A + (size_t)u.pm * astep; u.b = B + (size_t)e * bexp + (size_t)u.pn * bstep; return true;
    }
};
}
namespace pg8 {
#define EPI_ARGS const f32x4 (&acc)[2][2][4][2], const Unit& u, int wr, int wc, int fr, int fq
#define EPI_FOR_AI_M _Pragma("unroll") for (int ai = 0; ai < 2; ++ai) _Pragma("unroll") for (int m = 0; m < 4; ++m)
#define EPI_FOR_BJ _Pragma("unroll") for (int bj = 0; bj < 2; ++bj)

__device__ __forceinline__ void rope4(f32x4& x1, f32x4& x2, const float* rc, const float* rs, int pos, int i0) {
    const f32x4 c = *(const f32x4*)(rc + pos * 32 + i0), s = *(const f32x4*)(rs + pos * 32 + i0);
    const f32x4 o1 = x1 * c - x2 * s, o2 = x2 * c + x1 * s; x1 = o1; x2 = o2;
}

struct EpiInproj {
    static constexpr bool PERM = true;
    bf16_t *UV, *CQ, *CKV, *DQ, *K12, *VD, *G, *KM; float *cqp, *ckvp; const float* bgate; const float* rc; const float* rs;
    __device__ __forceinline__ void operator()(EPI_ARGS) const {
        const int pn = u.pn, row0 = u.pm * BM + wr * 64 + fr, c0 = wc * 32 + 8 * fq;
#if MK_CHECK == 35 || MK_CHECK == 36
        if (pn < 4) {
            EPI_FOR_AI_M { const int row = row0 + ai * HALF + m * 16; bf16_t* rp = UV + (size_t)row * 1024 + pn * 256 + c0;
                EPI_FOR_BJ { f32x4 v0 = acc[ai][bj][m][0], v1 = acc[ai][bj][m][1];
#pragma unroll
                    for (int j = 0; j < 4; ++j) { v0[j] = sigmoidf_(v0[j]); v1[j] = sigmoidf_(v1[j]); }
                    *(u32x4*)(rp + bj * HALF) = pack8(v0, v1); } }
        } else
#endif
#if MK_CHECK == 34
        if (pn < 4) {
            const int gc0 = pn * 256 + c0;
            f32x4 bv[2][2];
            EPI_FOR_BJ { bv[bj][0] = *(const f32x4*)(bgate + gc0 + bj * HALF); bv[bj][1] = *(const f32x4*)(bgate + gc0 + bj * HALF + 4); }
            EPI_FOR_AI_M { const int row = row0 + ai * HALF + m * 16; bf16_t* rp = UV + (size_t)row * 1024 + gc0;
                EPI_FOR_BJ { f32x4 v0 = acc[ai][bj][m][0] + bv[bj][0], v1 = acc[ai][bj][m][1] + bv[bj][1];
#pragma unroll
                    for (int j = 0; j < 4; ++j) { v0[j] = sigmoidf_(v0[j]); v1[j] = sigmoidf_(v1[j]); }
                    *(u32x4*)(rp + bj * HALF) = pack8(v0, v1); } }
        } else
#endif
        if (pn < 4) {
            EPI_FOR_AI_M { const int row = row0 + ai * HALF + m * 16; bf16_t* rp = UV + (size_t)row * 1024 + pn * 256 + c0;
                EPI_FOR_BJ { f32x4 v0 = acc[ai][bj][m][0], v1 = acc[ai][bj][m][1];
#pragma unroll
                    for (int j = 0; j < 4; ++j) { v0[j] = gelu_tanh(v0[j]); v1[j] = gelu_tanh(v1[j]); }
                    *(u32x4*)(rp + bj * HALF) = pack8(v0, v1); } }
        } else if (pn == 4) {
            EPI_FOR_AI_M { const int row = row0 + ai * HALF + m * 16; bf16_t* rp = CQ + (size_t)row * 256 + c0; float ss = 0.f;
                EPI_FOR_BJ { const f32x4 v0 = acc[ai][bj][m][0], v1 = acc[ai][bj][m][1];
                    ss += (v0[0] * v0[0] + v0[1] * v0[1]) + (v0[2] * v0[2] + v0[3] * v0[3]) + (v1[0] * v1[0] + v1[1] * v1[1]) + (v1[2] * v1[2] + v1[3] * v1[3]);
                    *(u32x4*)(rp + bj * HALF) = pack8(v0, v1); }
                ss = sum_x32(sum_x16(ss));
                if (fq == 0) cqp[(size_t)row * 4 + wc] = ss; }
        } else if (pn == 5) {
            EPI_FOR_AI_M { const int row = row0 + ai * HALF + m * 16; bf16_t* rp = CKV + (size_t)row * 256 + c0;
                const f32x4 a0 = acc[ai][0][m][0], a1 = acc[ai][0][m][1];
                float ss = (a0[0] * a0[0] + a0[1] * a0[1]) + (a0[2] * a0[2] + a0[3] * a0[3]) + (a1[0] * a1[0] + a1[1] * a1[1]) + (a1[2] * a1[2] + a1[3] * a1[3]);
                *(u32x4*)(rp) = pack8(a0, a1);
                ss = sum_x32(sum_x16(ss));
                if (fq == 0) ckvp[(size_t)row * 4 + wc] = ss;
                f32x4 x1 = acc[ai][1][m][0], x2 = acc[ai][1][m][1];
                *(u32x4*)(rp + HALF) = pack8(x1, x2);
                if (wc < 2) { const int g8 = 4 * wc + fq, pos = row & (SEQ - 1), b = row >> 13;
                    rope4(x1, x2, rc, rs, pos, 4 * g8);
                    const u32x4 w = pack8(x1, x2);
#pragma unroll
                    for (int h = 0; h < 4; ++h) *(u32x4*)(KM + km_addr(b * 4 + h, pos >> 6, 16 + g8, pos & 63)) = w; } }
        } else if (pn < 8) {
            EPI_FOR_AI_M { const int row = row0 + ai * HALF + m * 16; bf16_t* rp = DQ + (size_t)row * 512 + (pn - 6) * 256 + c0;
                EPI_FOR_BJ { *(u32x4*)(rp + bj * HALF) = pack8(acc[ai][bj][m][0] * QS_DIF, acc[ai][bj][m][1] * QS_DIF); } }
        } else if (pn < 10) {
            EPI_FOR_AI_M { const int row = row0 + ai * HALF + m * 16, pos = row & (SEQ - 1), b = row >> 13;
                EPI_FOR_BJ { const int h = 2 * (pn - 8) + bj;
                    *(u32x4*)(K12 + k12_addr(b * 4 + h, pos >> 6, wc >> 1, 4 * (wc & 1) + fq, pos & 63)) = pack8(acc[ai][bj][m][0], acc[ai][bj][m][1]); } }
        } else if (pn < 12) {
            EPI_FOR_AI_M { const int row = row0 + ai * HALF + m * 16, pos = row & (SEQ - 1), b = row >> 13;
                EPI_FOR_BJ { const int h = 2 * (pn - 10) + bj;
                    *(u32x4*)(VD + vimg_addr(b * 4 + h, pos >> 6, wc, pos & 63) + 8 * fq) = pack8(acc[ai][bj][m][0], acc[ai][bj][m][1]); } }
        } else {
            const int gc0 = (pn - 12) * 256 + c0;
            f32x4 bv[2][2];
            EPI_FOR_BJ { bv[bj][0] = *(const f32x4*)(bgate + gc0 + bj * HALF); bv[bj][1] = *(const f32x4*)(bgate + gc0 + bj * HALF + 4); }
            EPI_FOR_AI_M { const int row = row0 + ai * HALF + m * 16; bf16_t* rp = G + (size_t)row * 3072 + gc0;
                EPI_FOR_BJ { f32x4 v0 = acc[ai][bj][m][0] + bv[bj][0], v1 = acc[ai][bj][m][1] + bv[bj][1];
#pragma unroll
#if MK_CHECK == 37
                    for (int j = 0; j < 4; ++j) { v0[j] = gelu_tanh(v0[j]); v1[j] = gelu_tanh(v1[j]); }
#else
                    for (int j = 0; j < 4; ++j) { v0[j] = sigmoidf_(v0[j]); v1[j] = sigmoidf_(v1[j]); }
#endif
                    *(u32x4*)(rp + bj * HALF) = pack8(v0, v1); } }
        }
    }
};

struct EpiQ {
    static constexpr bool PERM = true;
    bf16_t* QM; const float* cqp; const float* rc; const float* rs;
    __device__ __forceinline__ void operator()(EPI_ARGS) const {
        const int row0 = u.pm * BM + wr * 64 + fr, c0 = u.pn * 256 + wc * 32 + 8 * fq;
        float sc[2][4];
        EPI_FOR_AI_M { const f32x4 p = *(const f32x4*)(cqp + (unsigned)(row0 + ai * HALF + m * 16) * 4u);
            sc[ai][m] = __builtin_amdgcn_rsqf(((p[0] + p[1]) + (p[2] + p[3])) * (1.0f / 256.0f) + EPS) * QS_MLA; }
        __builtin_amdgcn_sched_barrier(0);
        EPI_FOR_AI_M { const int row = row0 + ai * HALF + m * 16, pos = row & (SEQ - 1);
            EPI_FOR_BJ { const int col = c0 + bj * HALF, w = col % 192;
                f32x4 v0 = acc[ai][bj][m][0] * sc[ai][m], v1 = acc[ai][bj][m][1] * sc[ai][m];
                if (w >= 128) rope4(v0, v1, rc, rs, pos, (w - 128) >> 1);
                *(u32x4*)(QM + (unsigned)row * 768u + (unsigned)col) = pack8(v0, v1); }
            __builtin_amdgcn_sched_barrier(0); }
    }
};
struct EpiKV {
    static constexpr bool PERM = true;
    bf16_t *KM, *VM; const float* ckvp;
    __device__ __forceinline__ void operator()(EPI_ARGS) const {
        const int row0 = u.pm * BM + wr * 64 + fr, h = u.pn;
        float sc[2][4];
        EPI_FOR_AI_M { const f32x4 p = *(const f32x4*)(ckvp + (unsigned)(row0 + ai * HALF + m * 16) * 4u);
            sc[ai][m] = __builtin_amdgcn_rsqf(((p[0] + p[1]) + (p[2] + p[3])) * (1.0f / 128.0f) + EPS); }
        __builtin_amdgcn_sched_barrier(0);
        const int b = (u.pm * BM) >> 13, t0 = ((u.pm * BM) & (SEQ - 1)) >> 6;
        const unsigned tb = (unsigned)((b * 4 + h) * 128 + t0 + wr);
        bf16_t* kb = KM + ((tb * 24u + (unsigned)(4 * wc + fq)) * 64u + (unsigned)fr) * 8u;
        bf16_t* vb = VM + ((tb * 4u + (unsigned)wc) * 64u + (unsigned)fr) * 32u + 8u * fq;
        EPI_FOR_AI_M {
            *(u32x4*)(kb + ai * (2 * 24 * 512) + m * (16 * 8)) = pack8(acc[ai][0][m][0] * sc[ai][m], acc[ai][0][m][1] * sc[ai][m]);
            *(u32x4*)(vb + ai * (2 * 4 * 2048) + m * (16 * 32)) = pack8(acc[ai][1][m][0] * sc[ai][m], acc[ai][1][m][1] * sc[ai][m]); }
    }
};
struct EpiBranch {
    static constexpr bool PERM = true;
    bf16_t* MG; const bf16_t* G;
    __device__ __forceinline__ void operator()(EPI_ARGS) const {
        const int row0 = u.pm * BM + wr * 64 + fr, c0 = u.pn * 256 + wc * 32 + 8 * fq, n = u.aux;
        EPI_FOR_AI_M { const int row = row0 + ai * HALF + m * 16;
            EPI_FOR_BJ { const int col = c0 + bj * HALF;
                const u32x4 gw = *(const u32x4*)(G + (size_t)row * 3072 + n * 1024 + col);
                f32x4 v0 = acc[ai][bj][m][0], v1 = acc[ai][bj][m][1];
                v0[0] *= bflo(gw.x); v0[1] *= bfhi(gw.x); v0[2] *= bflo(gw.y); v0[3] *= bfhi(gw.y);
                v1[0] *= bflo(gw.z); v1[1] *= bfhi(gw.z); v1[2] *= bflo(gw.w); v1[3] *= bfhi(gw.w);
                bf16_t* mp = MG + (size_t)row * 1024 + col;
                if (n > 0) { const u32x4 o = *(const u32x4*)mp;
                    v0[0] += bflo(o.x); v0[1] += bfhi(o.x); v0[2] += bflo(o.y); v0[3] += bfhi(o.y);
                    v1[0] += bflo(o.z); v1[1] += bfhi(o.z); v1[2] += bflo(o.w); v1[3] += bfhi(o.w); }
                *(u32x4*)mp = pack8(v0, v1); } }
    }
};
struct EpiResid {
    static constexpr bool PERM = false;
    const float* xin; float* xout;
    __device__ __forceinline__ void operator()(EPI_ARGS) const {
        const int row0 = u.pm * BM + wr * 64 + fr, c0 = u.pn * 256 + wc * 32 + 4 * fq;
        EPI_FOR_AI_M { const size_t ro = (size_t)(row0 + ai * HALF + m * 16) * 1024 + c0;
            EPI_FOR_BJ {
#pragma unroll
                for (int n = 0; n < 2; ++n) { const size_t o = ro + bj * HALF + n * 16; *(f32x4*)(xout + o) = *(const f32x4*)(xin + o) + acc[ai][bj][m][n]; } } }
    }
};
struct EpiSwiglu {
    static constexpr bool PERM = true;
    bf16_t* HM; int ldh;
    __device__ __forceinline__ void operator()(EPI_ARGS) const {
        const int row0 = u.pm * BM + wr * 64 + fr, c0 = u.pn * 128 + wc * 32 + 8 * fq;
        EPI_FOR_AI_M { const int row = row0 + ai * HALF + m * 16;
            f32x4 a0 = acc[ai][0][m][0], a1 = acc[ai][0][m][1]; const f32x4 b0 = acc[ai][1][m][0], b1 = acc[ai][1][m][1];
#pragma unroll
            for (int j = 0; j < 4; ++j) { a0[j] = a0[j] * sigmoidf_(a0[j]) * b0[j]; a1[j] = a1[j] * sigmoidf_(a1[j]) * b1[j]; }
            *(u32x4*)(HM + (size_t)row * ldh + c0) = pack8(a0, a1); }
    }
};
struct EpiMoeDown {
    static constexpr bool PERM = true;
    bf16_t* Y; const float* roww;
    __device__ __forceinline__ void operator()(EPI_ARGS) const {
        const int row0 = u.pm * BM + wr * 64 + fr, c0 = u.pn * 256 + wc * 32 + 8 * fq;
        EPI_FOR_AI_M { const int row = row0 + ai * HALF + m * 16; const float w = roww[row];
            EPI_FOR_BJ { *(u32x4*)(Y + (size_t)row * 1024 + c0 + bj * HALF) = pack8(acc[ai][bj][m][0] * w, acc[ai][bj][m][1] * w); } }
    }
};
}
namespace attn {
constexpr int SLOT = 40960, NSLOT = 3, LDS_TAB = NSLOT * SLOT;
__device__ __forceinline__ void glds16(const void* gsrc, unsigned lds_dst) { unsigned keep;
    asm volatile("s_mov_b32 %0, m0\n\ts_mov_b32 m0, %2\n\ts_nop 0\n\tglobal_load_lds_dwordx4 %1, off\n\ts_mov_b32 m0, %0" : "=&s"(keep) : "v"(gsrc), "s"(lds_dst) : "memory"); }
__device__ __forceinline__ s16x4 vtr(const LAS unsigned char* p) { return __builtin_bit_cast(s16x4, __builtin_amdgcn_ds_read_tr16_b64_v4i16((LAS s16x4*)p)); }
__device__ __forceinline__ float halfmax(float m) { auto rr = __builtin_amdgcn_permlane32_swap(__float_as_uint(m), __float_as_uint(m), false, false); return fmaxf(__uint_as_float(rr[0]), __uint_as_float(rr[1])); }
__device__ __forceinline__ float halfsum(float m) { auto rr = __builtin_amdgcn_permlane32_swap(__float_as_uint(m), __float_as_uint(m), false, false); return __uint_as_float(rr[0]) + __uint_as_float(rr[1]); }
__device__ __forceinline__ float max16(const f32x16& a) { float x = fmaxf(fmaxf(a[0], a[1]), fmaxf(a[2], a[3])), y = fmaxf(fmaxf(a[4], a[5]), fmaxf(a[6], a[7]));
    float z = fmaxf(fmaxf(a[8], a[9]), fmaxf(a[10], a[11])), w = fmaxf(fmaxf(a[12], a[13]), fmaxf(a[14], a[15])); return fmaxf(fmaxf(x, y), fmaxf(z, w)); }
#define ATT_WAITBAR(N) asm volatile("s_waitcnt vmcnt(" #N ") lgkmcnt(0)\n\ts_barrier" ::: "memory")

__device__ __forceinline__ void softmax_tile(f32x16& s0, f32x16& s1, float& m, float& l, float& alpha, bf16x8 (&pf)[4]) {
    float mx = fmaxf(max16(s0), max16(s1)); mx = halfmax(mx);
    const float mn = fmaxf(m, mx); alpha = fast_exp2(m - mn); m = mn;
    float rs = 0.f;
#pragma unroll
    for (int r = 0; r < 16; ++r) { s0[r] = fast_exp2(s0[r] - mn); s1[r] = fast_exp2(s1[r] - mn); rs += s0[r] + s1[r]; }
    l = l * alpha + rs;
#pragma unroll
    for (int s = 0; s < 2; ++s) {
        u32x4 a, b;
        a.x = cvt_pk_bf16(s0[8 * s + 0], s0[8 * s + 1]); a.y = cvt_pk_bf16(s0[8 * s + 2], s0[8 * s + 3]); a.z = cvt_pk_bf16(s0[8 * s + 4], s0[8 * s + 5]); a.w = cvt_pk_bf16(s0[8 * s + 6], s0[8 * s + 7]);
        b.x = cvt_pk_bf16(s1[8 * s + 0], s1[8 * s + 1]); b.y = cvt_pk_bf16(s1[8 * s + 2], s1[8 * s + 3]); b.z = cvt_pk_bf16(s1[8 * s + 4], s1[8 * s + 5]); b.w = cvt_pk_bf16(s1[8 * s + 6], s1[8 * s + 7]);
        pf[s] = __builtin_bit_cast(bf16x8, a); pf[2 + s] = __builtin_bit_cast(bf16x8, b);
    }
}

template <int NKS, bool BIAS>
__device__ __forceinline__ void attn_core(LAS unsigned char* lds, const char* kimg, int ktile_bytes, const char* vimg, const bf16x8 (&qf)[NKS], int NT, int tmax, int qpos,
                                          f32x16 (&o)[4], float& linv) {
    constexpr int NKP = 2 * NKS, NPW = (NKP + 16) / 8, KB = NKP * 1024;
    static_assert((NKP + 16) % 8 == 0, "pieces divide over 8 waves");
    const int tid = opaque_tid(), lane = tid & 63, r32 = lane & 31, hi = lane >> 5, wid = __builtin_amdgcn_readfirstlane(tid >> 6);
    const unsigned lds0 = (unsigned)(size_t)lds;
#define ATT_DMA(t, slot) do { _Pragma("unroll") for (int _i = 0; _i < NPW; ++_i) { const int _p = wid + 8 * _i; \
        const char* _s = (_p < NKP) ? kimg + (size_t)(t) * ktile_bytes + _p * 1024 : vimg + (size_t)(t) * 16384 + (_p - NKP) * 1024; \
        glds16(_s + lane * 16, (unsigned)__builtin_amdgcn_readfirstlane(lds0 + (slot) + _p * 1024)); } } while (0)
    ATT_DMA(0, 0); ATT_DMA(1, SLOT);
#pragma unroll
    for (int i = 0; i < 4; ++i) o[i] = f32x16{};
    float m = -1e30f, l = 0.f;
    int sl_cur = 0, sl_nn = 2 * SLOT;
    const LAS unsigned char* vp0 = lds + KB + ((lane >> 4) & 1) * 32 + (lane & 3) * 8 + (4 * hi + ((lane & 15) >> 2)) * 64;
    const LAS unsigned char* kp0 = lds + hi * 1024 + r32 * 16;
    const LAS float* tab = (const LAS float*)(lds + LDS_TAB);
    for (int t = 0; t < NT; ++t) {
        if (t + 1 < NT) { if (NPW == 5) { ATT_WAITBAR(5); } else { ATT_WAITBAR(3); } } else { ATT_WAITBAR(0); }
        if (t + 2 < NT) ATT_DMA(t + 2, sl_nn);
        if (t <= tmax) {
            f32x16 s0 = f32x16{}, s1 = f32x16{};
            if (BIAS) { if (t + 2 >= tmax) { const int bbase = 64 * t + 4 * hi - qpos + 192;
#pragma unroll
                for (int r = 0; r < 16; ++r) { const int ix = bbase + (r & 3) + 8 * (r >> 2); s0[r] = tab[ix]; s1[r] = tab[ix + 32]; } } }
            const LAS unsigned char* kp = kp0 + sl_cur;
#pragma unroll
            for (int d0 = 0; d0 < NKS; ++d0) {
                const bf16x8 k0 = *(const LAS bf16x8*)(kp + d0 * 2048), k1 = *(const LAS bf16x8*)(kp + d0 * 2048 + 512);
                s0 = __builtin_amdgcn_mfma_f32_32x32x16_bf16(k0, qf[d0], s0, 0, 0, 0);
                s1 = __builtin_amdgcn_mfma_f32_32x32x16_bf16(k1, qf[d0], s1, 0, 0, 0);
            }
            float alpha; bf16x8 pf[4];
            softmax_tile(s0, s1, m, l, alpha, pf);
            if (__any(alpha != 1.0f)) {
#pragma unroll
                for (int i = 0; i < 4; ++i)
#pragma unroll
                    for (int r = 0; r < 16; ++r) o[i][r] *= alpha;
            }
            const LAS unsigned char* vp = vp0 + sl_cur;
#pragma unroll
            for (int db = 0; db < 4; ++db)
#pragma unroll
                for (int ks = 0; ks < 4; ++ks) {
                    const s16x4 lo = vtr(vp + db * 4096 + ks * 1024), hh = vtr(vp + db * 4096 + ks * 1024 + 512);
                    const bf16x8 vf = (bf16x8){lo[0], lo[1], lo[2], lo[3], hh[0], hh[1], hh[2], hh[3]};
                    o[db] = __builtin_amdgcn_mfma_f32_32x32x16_bf16(vf, pf[ks], o[db], 0, 0, 0);
                }
        }
        sl_cur = (sl_cur == 2 * SLOT) ? 0 : sl_cur + SLOT; sl_nn = (sl_nn == 2 * SLOT) ? 0 : sl_nn + SLOT;
    }
    linv = fast_rcp(halfsum(l));
    asm volatile("s_waitcnt vmcnt(0) lgkmcnt(0)\n\ts_barrier" ::: "memory");
#undef ATT_DMA
}

__device__ __forceinline__ void mla_unit(LAS unsigned char* lds, int bh, int qb, const bf16_t* QM, const bf16_t* KM, const bf16_t* VM, bf16_t* BR) {
    const int tid = opaque_tid(), lane = tid & 63, r32 = lane & 31, hi = lane >> 5, wid = __builtin_amdgcn_readfirstlane(tid >> 6);
    const int b = bh >> 2, h = bh & 3;
    const size_t qrow = (size_t)b * SEQ + qb * 256 + wid * 32 + r32;
    bf16x8 qf[12];
#pragma unroll
    for (int d0 = 0; d0 < 12; ++d0) qf[d0] = *(const bf16x8*)(QM + qrow * 768 + h * 192 + d0 * 16 + hi * 8);
    f32x16 o[4]; float inv;
    attn_core<12, false>(lds, (const char*)(KM + km_addr(bh, 0, 0, 0)), 24576, (const char*)(VM + vimg_addr(bh, 0, 0, 0)), qf, 4 * (qb + 1), 4 * qb + (wid >> 1), 0, o, inv);
    bf16_t* op = BR + qrow * 1536 + 512 + h * 128 + 4 * hi;
#pragma unroll
    for (int db = 0; db < 4; ++db)
#pragma unroll
        for (int g = 0; g < 4; ++g) { u32x2 w; w.x = cvt_pk_bf16(o[db][4 * g] * inv, o[db][4 * g + 1] * inv); w.y = cvt_pk_bf16(o[db][4 * g + 2] * inv, o[db][4 * g + 3] * inv);
            *(u32x2*)(op + db * 32 + g * 8) = w; }
}

__device__ __forceinline__ void diff_unit(LAS unsigned char* lds, int bh, int qb, const bf16_t* DQ, const bf16_t* K12, const bf16_t* VD, bf16_t* BR,
                                          const float* biast, const float* gsub, float lam, float outscale) {
    const int tid = opaque_tid(), lane = tid & 63, r32 = lane & 31, hi = lane >> 5, wid = __builtin_amdgcn_readfirstlane(tid >> 6);
    const int b = bh >> 2, h = bh & 3;
    LAS float* tab = (LAS float*)(lds + LDS_TAB);
    if (tid < 256) tab[tid] = biast[h * 256 + tid];
    const size_t qrow = (size_t)b * SEQ + qb * 256 + wid * 32 + r32;
    const int qpos = qb * 256 + wid * 32 + r32, NT = 4 * (qb + 1), tmax = 4 * qb + (wid >> 1);
    const char* vimg = (const char*)(VD + vimg_addr(bh, 0, 0, 0));
    f32x16 oa[4];
    {
        bf16x8 qf[4];
#pragma unroll
        for (int d0 = 0; d0 < 4; ++d0) qf[d0] = *(const bf16x8*)(DQ + qrow * 512 + h * 128 + d0 * 16 + hi * 8);
        float inv;
        attn_core<4, true>(lds, (const char*)(K12 + k12_addr(bh, 0, 0, 0, 0)), 16384, vimg, qf, NT, tmax, qpos, oa, inv);
#pragma unroll
        for (int db = 0; db < 4; ++db)
#pragma unroll
            for (int r = 0; r < 16; ++r) oa[db][r] *= inv;
    }
    float ss = 0.f;
    {
        bf16x8 qf[4];
#pragma unroll
        for (int d0 = 0; d0 < 4; ++d0) qf[d0] = *(const bf16x8*)(DQ + qrow * 512 + h * 128 + 64 + d0 * 16 + hi * 8);
        f32x16 ob[4]; float inv;
        attn_core<4, true>(lds, (const char*)(K12 + k12_addr(bh, 0, 1, 0, 0)), 16384, vimg, qf, NT, tmax, qpos, ob, inv);
        const float i2 = lam * inv;
#pragma unroll
        for (int db = 0; db < 4; ++db)
#pragma unroll
            for (int r = 0; r < 16; ++r) { const float v = oa[db][r] - ob[db][r] * i2; oa[db][r] = v; ss += v * v; }
    }
    ss = halfsum(ss);
    const float rn = __builtin_amdgcn_rsqf(ss * (1.0f / 128.0f) + EPS) * outscale;
    bf16_t* op = BR + qrow * 1536 + 1024 + h * 128 + 4 * hi;
#pragma unroll
    for (int db = 0; db < 4; ++db)
#pragma unroll
        for (int g = 0; g < 4; ++g) { const f32x4 gs = *(const f32x4*)(gsub + db * 32 + g * 8 + 4 * hi);
            u32x2 w; w.x = cvt_pk_bf16(oa[db][4 * g] * rn * gs[0], oa[db][4 * g + 1] * rn * gs[1]); w.y = cvt_pk_bf16(oa[db][4 * g + 2] * rn * gs[2], oa[db][4 * g + 3] * rn * gs[3]);
            *(u32x2*)(op + db * 32 + g * 8) = w; }
}
}
struct Args { const float* in[30]; float* out; unsigned char* ws; int ph_lo, ph_hi; };
struct Frame {
    LAS unsigned char* lds; int tid, lane, wave, G, vcu;
    float* out; unsigned char* ws;
};

struct ConvDesc { const float* src; const float* ks; bf16_t* dst; int ldsrc, Ksrc, Kdst, Nj, ldb, map, rowoff; };
__device__ __forceinline__ int conv_srccol(int map, int j) {
    if (map == 1) {
        if (j < 1408) return j;
        if (j < 1472) { const int q = j - 1408, g8 = q >> 3, w = q & 7; return 1408 + ((w < 4) ? 4 * g8 + w : 32 + 4 * g8 + (w - 4)); }
        if (j < 1536) return -1;
        return j - 64;
    }
    if (map == 2) { const int h = j / 192, w = j % 192; if (w < 128) return j; const int q = w - 128, g8 = q >> 3, ww = q & 7; return h * 192 + 128 + ((ww < 4) ? 4 * g8 + ww : 32 + 4 * g8 + (ww - 4)); }
    return j;
}
__device__ __forceinline__ int conv_dstrow(int map, int rowoff, int j) { return (map == 3) ? ((j >> 7) * 256 + (j & 127) + rowoff) : (j + rowoff); }
__device__ __forceinline__ void conv_item(const ConvDesc& d, int item, LAS float* scr, int lane) {
    const int njb = d.Nj / 32, kb = item / njb, jb = item % njb, k0 = 64 * kb, j0 = 32 * jb;
    const int sc = conv_srccol(d.map, j0 + (lane & 31));
    const bool live = (sc >= 0) && (k0 < d.Ksrc);
#pragma unroll 8
    for (int i = 0; i < 32; ++i) { const int kk = 2 * i + (lane >> 5); float v = 0.f;
        if (live) { v = d.src[(size_t)(k0 + kk) * d.ldsrc + sc]; if (d.ks) v *= d.ks[k0 + kk]; }
        scr[kk * 33 + (lane & 31)] = v; }
    LDS_WAIT(); asm volatile("" ::: "memory");
    const int c = lane & 7, r0 = conv_dstrow(d.map, d.rowoff, j0);
#pragma unroll
    for (int jj = 0; jj < 4; ++jj) { const int n = (lane >> 3) + 8 * jj; const LAS float* s = scr + (8 * c) * 33 + n;
        u32x4 o; o.x = cvt_pk_bf16(s[0 * 33], s[1 * 33]); o.y = cvt_pk_bf16(s[2 * 33], s[3 * 33]); o.z = cvt_pk_bf16(s[4 * 33], s[5 * 33]); o.w = cvt_pk_bf16(s[6 * 33], s[7 * 33]);
        *(u32x4*)(d.dst + (size_t)(r0 + n) * d.ldb + k0 + 8 * c) = o; }
    LDS_WAIT(); asm volatile("" ::: "memory");
}
__device__ __forceinline__ ConvDesc get_desc(const Frame& F, const Args& A, int mi, int ml) {
    ConvDesc d; d.ks = nullptr; d.map = 0; d.rowoff = 0;
    if (mi < 40) { const int l = mi / 10, k = mi % 10; unsigned char* wb = F.ws + WS_WMIX + (size_t)l * WMIX_STRIDE;
        if (k == 0) { d.src = A.in[2] + (size_t)l * 1024 * 3008; d.ldsrc = 3008; d.Ksrc = d.Kdst = 1024; d.Nj = 3072; d.dst = (bf16_t*)(wb + WM_CAT); d.ldb = 1024; d.map = 1; }
        else if (k < 4) { const int n = k - 1; d.src = A.in[17] + (size_t)(l * 3 + n) * 1024 * 1024; d.ldsrc = 1024; d.Ksrc = d.Kdst = 1024; d.Nj = 1024; d.dst = (bf16_t*)(wb + WM_CAT); d.ldb = 1024; d.rowoff = 3072 + 1024 * n; }
        else if (k == 4) { d.src = A.in[9] + (size_t)l * 256 * 768; d.ldsrc = 768; d.Ksrc = d.Kdst = 256; d.Nj = 768; d.dst = (bf16_t*)(wb + WM_UQ); d.ldb = 256; d.map = 2; d.ks = A.in[7] + l * 256; }
        else if (k == 5) { d.src = A.in[10] + (size_t)l * 128 * 1024; d.ldsrc = 1024; d.Ksrc = 128; d.Kdst = 256; d.Nj = 1024; d.dst = (bf16_t*)(wb + WM_UKV); d.ldb = 256; d.ks = A.in[8] + l * 128; }
        else if (k < 9) { const int n = k - 6; d.src = A.in[19] + (size_t)(l * 3 + n) * 512 * 1024; d.ldsrc = 1024; d.Ksrc = d.Kdst = 512; d.Nj = 1024; d.dst = (bf16_t*)(wb + WM_B) + (size_t)n * 1024 * 512; d.ldb = 512; }
        else { d.src = A.in[20] + (size_t)l * 1024 * 1024; d.ldsrc = 1024; d.Ksrc = d.Kdst = 1024; d.Nj = 1024; d.dst = (bf16_t*)(wb + WM_O); d.ldb = 1024; }
    } else if (mi < 46) { const int i = (mi - 40) / 3, k = (mi - 40) % 3; unsigned char* wb = F.ws + WS_WDEN + (size_t)i * WDEN_STRIDE;
        if (k < 2) { d.src = (k == 0 ? A.in[22] : A.in[23]) + (size_t)i * 1024 * FD; d.ldsrc = FD; d.Ksrc = d.Kdst = 1024; d.Nj = FD; d.dst = (bf16_t*)(wb + WD_13); d.ldb = 1024; d.map = 3; d.rowoff = 128 * k; }
        else { d.src = A.in[24] + (size_t)i * FD * 1024; d.ldsrc = 1024; d.Ksrc = d.Kdst = FD; d.Nj = 1024; d.dst = (bf16_t*)(wb + WD_2); d.ldb = FD; }
    } else { const int e = (mi - 46) / 3, k = (mi - 46) % 3; unsigned char* wb = F.ws + WS_WMOE; const size_t xe = (size_t)ml * NEXP + e;
        if (k < 2) { d.src = (k == 0 ? A.in[26] : A.in[27]) + xe * 1024 * FE; d.ldsrc = FE; d.Ksrc = d.Kdst = 1024; d.Nj = FE; d.dst = (bf16_t*)(wb + WE_13) + (size_t)e * 2 * FE * 1024; d.ldb = 1024; d.map = 3; d.rowoff = 128 * k; }
        else { d.src = A.in[28] + xe * FE * 1024; d.ldsrc = 1024; d.Ksrc = d.Kdst = FE; d.Nj = 1024; d.dst = (bf16_t*)(wb + WE_2) + (size_t)e * 1024 * FE; d.ldb = FE; }
    }
    return d;
}
__device__ __forceinline__ void conv_range(const Frame& F0, const Args& A, int mi_lo, int mi_hi, int ml) {
    Frame F = F0; F.tid = opaque_tid(); F.lane = F.tid & 63;
    LAS float* scr = (LAS float*)(F.lds + F.wave * 16384);
    const int gw = F.vcu * NWAVES + F.wave, NGW = F.G * NWAVES; int off = 0;
    for (int mi = mi_lo; mi < mi_hi; ++mi) {
        const ConvDesc d = get_desc(F, A, mi, ml);
        const int nit = (d.Nj / 32) * (d.Kdst / 64);
        int st = gw - off; if (st < 0) st += NGW;
        for (int it = st; it < nit; it += NGW) conv_item(d, it, scr, F.lane);
        off = (off + nit) % NGW;
    }
}
__device__ __forceinline__ float lam_init_of(int l) { return 0.8f - 0.6f * expf(-0.3f * (float)l); }
__device__ __forceinline__ void prologue_tables(const Frame& F0, const Args& A) {
    Frame F = F0; F.tid = opaque_tid(); F.lane = F.tid & 63;
    const int gt = F.vcu * NTHR + F.tid, NGT = F.G * NTHR;
    float* rc = (float*)(F.ws + WS_ROPEC); float* rs = (float*)(F.ws + WS_ROPES);
    for (int i = gt; i < SEQ * 32; i += NGT) { const int pos = i >> 5, k = i & 31;
        const float inv = powf(10000.0f, -((float)(2 * k)) / 64.0f); const float ang = (float)pos * inv;
        rc[i] = (float)cos((double)ang); rs[i] = (float)sin((double)ang); }
    if (gt < 1024) { const int h = gt >> 8, i = gt & 255, rel = i - 192; const int n = rel < 0 ? -rel : rel; int bk = rel > 0 ? 16 : 0;
        if (n < 8) bk += n; else { const float nf = (float)n; int lg = 8 + (int)(logf(nf / 8.0f) / 2.772588722239781f * 8.0f); lg = lg < 15 ? lg : 15; bk += lg; }
        const float* rb = A.in[16]; ((float*)(F.ws + WS_BIAST))[gt] = (rb[bk * 4 + h] - rb[15 * 4 + h]) * LOG2E; }
    if (gt < NLAYER) { const int l = gt; float a = 0.f, b2 = 0.f;
        for (int i = 0; i < 64; ++i) { a += A.in[11][l * 64 + i] * A.in[12][l * 64 + i]; b2 += A.in[13][l * 64 + i] * A.in[14][l * 64 + i]; }
        ((float*)(F.ws + WS_LAM))[l] = expf(a) - expf(b2) + lam_init_of(l); }
}

template <int MODE>
__device__ __forceinline__ void norm_phase(const Frame& F0, const float* xin, float* xout, const float* g, bool combine, const float* router) {
    Frame F = F0; F.tid = opaque_tid(); F.lane = F.tid & 63;
    bf16_t* H = (bf16_t*)(F.ws + WS_H); const bf16_t* Y = (const bf16_t*)(F.ws + WS_R + R_Y); const int* slot = (const int*)(F.ws + WS_SLOT);
    LAS float* rt = (LAS float*)F.lds;
    LAS int* cl = (LAS int*)(F.lds + 32768);
    if constexpr (MODE == 2) { for (int i = F.tid; i < 8192; i += NTHR) { const int k = i >> 3, e = i & 7; rt[e * 1024 + k] = router[i]; } }
    f32x4 gv[4];
#pragma unroll
    for (int j = 0; j < 4; ++j) gv[j] = *(const f32x4*)(g + 4 * (F.lane + 64 * j));
    int bx0 = blockIdx.x; asm volatile("" : "+s"(bx0));
    for (int rb = bx0; rb < 256; rb += F.G) {
        if (MODE == 2) { if (F.tid < 8) cl[F.tid] = 0; __syncthreads(); }
        for (int i = 0; i < 16; ++i) {
            const int row = rb * 128 + F.wave * 16 + i;
            f32x4 v[4]; float ss = 0.f;
#pragma unroll
            for (int j = 0; j < 4; ++j) v[j] = *(const f32x4*)(xin + (size_t)row * 1024 + 4 * (F.lane + 64 * j));
            if (combine) { const int s0 = slot[2 * row], s1 = slot[2 * row + 1];
#pragma unroll
                for (int j = 0; j < 4; ++j) { const u32x2 a = *(const u32x2*)(Y + (size_t)s0 * 1024 + 4 * (F.lane + 64 * j)), b = *(const u32x2*)(Y + (size_t)s1 * 1024 + 4 * (F.lane + 64 * j));
                    v[j][0] += bflo(a.x) + bflo(b.x); v[j][1] += bfhi(a.x) + bfhi(b.x); v[j][2] += bflo(a.y) + bflo(b.y); v[j][3] += bfhi(a.y) + bfhi(b.y);
                    if (MODE != 3) *(f32x4*)(xout + (size_t)row * 1024 + 4 * (F.lane + 64 * j)) = v[j]; } }
#pragma unroll
            for (int j = 0; j < 4; ++j) ss += (v[j][0] * v[j][0] + v[j][1] * v[j][1]) + (v[j][2] * v[j][2] + v[j][3] * v[j][3]);
            const float rsc = __builtin_amdgcn_rsqf(wave_sum(ss) * (1.0f / 1024.0f) + EPS);
#pragma unroll
            for (int j = 0; j < 4; ++j) v[j] = v[j] * rsc * gv[j];
            if (MODE == 3) {
#pragma unroll
                for (int j = 0; j < 4; ++j) *(f32x4*)(xout + (size_t)row * 1024 + 4 * (F.lane + 64 * j)) = v[j];
            } else {
#pragma unroll
                for (int j = 0; j < 4; ++j) { u32x2 w; w.x = cvt_pk_bf16(v[j][0], v[j][1]); w.y = cvt_pk_bf16(v[j][2], v[j][3]); *(u32x2*)(H + (size_t)row * 1024 + 4 * (F.lane + 64 * j)) = w; }
            }
            if (MODE == 2) {
                float lg[8];
#pragma unroll
                for (int e = 0; e < 8; ++e) { float a = 0.f;
#pragma unroll
                    for (int j = 0; j < 4; ++j) { const f32x4 r4 = *(const LAS f32x4*)(rt + e * 1024 + 4 * (F.lane + 64 * j)); a += (v[j][0] * r4[0] + v[j][1] * r4[1]) + (v[j][2] * r4[2] + v[j][3] * r4[3]); }
                    lg[e] = wave_sum(a); }
                int e1 = 0; float b1 = lg[0];
#pragma unroll
                for (int e = 1; e < 8; ++e) if (lg[e] > b1) { b1 = lg[e]; e1 = e; }
                int e2 = -1; float b2 = -3.0e38f;
#pragma unroll
                for (int e = 0; e < 8; ++e) if (e != e1 && lg[e] > b2) { b2 = lg[e]; e2 = e; }
                const float w1 = 1.0f / (1.0f + expf(b2 - b1)), w2 = 1.0f - w1;
                if (F.lane == 0) { u32x4 s; s.x = (unsigned)e1; s.y = (unsigned)e2; s.z = __float_as_uint(w1); s.w = __float_as_uint(w2); *(u32x4*)(F.ws + WS_SEL + (size_t)row * 16) = s;
                    __hip_atomic_fetch_add(cl + e1, 1, __ATOMIC_RELAXED, __HIP_MEMORY_SCOPE_WORKGROUP); __hip_atomic_fetch_add(cl + e2, 1, __ATOMIC_RELAXED, __HIP_MEMORY_SCOPE_WORKGROUP); }
            }
        }
        if (MODE == 2) { __syncthreads(); if (F.tid < 8) ((int*)(F.ws + WS_CNT))[rb * 8 + F.tid] = cl[F.tid]; __syncthreads(); }
    }
    if (MODE == 2) __syncthreads();
}

__device__ __forceinline__ void moe_gather_phase(const Frame& F0) {
    Frame F = F0; F.tid = opaque_tid(); F.lane = F.tid & 63;
    const int* cnt = (const int*)(F.ws + WS_CNT); const bf16_t* H = (const bf16_t*)(F.ws + WS_H); bf16_t* XG = (bf16_t*)(F.ws + WS_R + R_XG);
    int* slot = (int*)(F.ws + WS_SLOT); float* roww = (float*)(F.ws + WS_ROWW);
    LAS int* lc = (LAS int*)F.lds;
    LAS int* tot = lc + 2048;
    LAS int* pre = tot + 8;
    LAS int* lb = pre + 8;
    LAS int* pos = lb + 16;
    int bx0 = blockIdx.x; asm volatile("" : "+s"(bx0));
    for (int rb = bx0; rb < 256; rb += F.G) {
        __syncthreads();
        for (int i = F.tid; i < 2048; i += NTHR) lc[i] = cnt[i];
        __syncthreads();
        { const int e = F.wave; int st = 0, sp = 0;
            for (int b = F.lane; b < 256; b += 64) { const int c = lc[b * 8 + e]; st += c; sp += (b < rb) ? c : 0; }
            st = wave_isum(st); sp = wave_isum(sp);
            if (F.lane == 0) { tot[e] = st; pre[e] = sp; } }
        __syncthreads();
        if (F.tid == 0) { int bs = 0; for (int e = 0; e < 8; ++e) { lb[e] = bs; bs += (tot[e] + 255) & ~255; } lb[8] = bs; }
        __syncthreads();
        if (F.wave == 0) {
            int run[8];
#pragma unroll
            for (int e = 0; e < 8; ++e) run[e] = lb[e] + pre[e];
            for (int it = 0; it < 2; ++it) {
                const int tl = it * 64 + F.lane, row = rb * 128 + tl;
                const u32x4 s = *(const u32x4*)(F.ws + WS_SEL + (size_t)row * 16);
                const int e1 = (int)s.x, e2 = (int)s.y; int p1 = 0, p2 = 0;
                const unsigned long long lt = (1ull << F.lane) - 1ull;
#pragma unroll
                for (int e = 0; e < 8; ++e) {
                    const unsigned long long m1 = __ballot(e1 == e), m2 = __ballot(e2 == e);
                    if (e1 == e) p1 = run[e] + __popcll(m1 & lt);
                    if (e2 == e) p2 = run[e] + __popcll(m1) + __popcll(m2 & lt);
                    run[e] += __popcll(m1) + __popcll(m2);
                }
                pos[2 * tl] = p1; pos[2 * tl + 1] = p2;
                slot[2 * row] = p1; slot[2 * row + 1] = p2;
                roww[p1] = __uint_as_float(s.z); roww[p2] = __uint_as_float(s.w);
            }
        }
        __syncthreads();
        for (int i = 0; i < 16; ++i) { const int tl = F.wave * 16 + i, row = rb * 128 + tl;
            const u32x4 a = *(const u32x4*)(H + (size_t)row * 1024 + 8 * F.lane), b = *(const u32x4*)(H + (size_t)row * 1024 + 512 + 8 * F.lane);
            const int p1 = pos[2 * tl], p2 = pos[2 * tl + 1];
            *(u32x4*)(XG + (size_t)p1 * 1024 + 8 * F.lane) = a; *(u32x4*)(XG + (size_t)p1 * 1024 + 512 + 8 * F.lane) = b;
            *(u32x4*)(XG + (size_t)p2 * 1024 + 8 * F.lane) = a; *(u32x4*)(XG + (size_t)p2 * 1024 + 512 + 8 * F.lane) = b; }
        if (rb < 8) { const int e = rb, r0 = lb[e] + tot[e], r1 = lb[e + 1];
            for (int r = r0 + F.wave; r < r1; r += NWAVES) { const u32x4 z = (u32x4){0u, 0u, 0u, 0u};
                *(u32x4*)(XG + (size_t)r * 1024 + 8 * F.lane) = z; *(u32x4*)(XG + (size_t)r * 1024 + 512 + 8 * F.lane) = z; if (F.lane == 0) roww[r] = 0.f; } }
        if (rb == 0 && F.tid < 9) ((int*)(F.ws + WS_META))[F.tid] = lb[F.tid] >> 8;
    }
    __syncthreads();
}

__device__ __forceinline__ void gmlp_phase(const Frame& F0, const Args& A, int l) {
    Frame F = F0; F.tid = opaque_tid(); F.lane = F.tid & 63;
    const bf16_t* UV = (const bf16_t*)(F.ws + WS_R + R_UV); bf16_t* BR = (bf16_t*)(F.ws + WS_R + R_BR);
    const float* lng = A.in[3] + l * 512; const float* lnb = A.in[4] + l * 512; const float* wsp = A.in[5] + (size_t)l * 4 * 128 * 128; const float* bsp = A.in[6] + l * 4 * 128;
    LAS bf16_t* vt = (LAS bf16_t*)F.lds;
    LAS bf16_t* wl = (LAS bf16_t*)(F.lds + 34816);
    LAS float* st = (LAS float*)(F.lds + 69632);
    const int r32 = F.lane & 31, hi = F.lane >> 5;
    for (int sp = F.vcu; sp < T / 128; sp += F.G) {
        const int t0 = sp * 128;
        __syncthreads();
#pragma nounroll
        for (int i = 0; i < 16; ++i) { const int tl = F.wave * 16 + i;
            const u32x4 w = *(const u32x4*)(UV + (size_t)(t0 + tl) * 1024 + 512 + 8 * F.lane);
            const float a0 = bflo(w.x), a1 = bfhi(w.x), a2 = bflo(w.y), a3 = bfhi(w.y), a4 = bflo(w.z), a5 = bfhi(w.z), a6 = bflo(w.w), a7 = bfhi(w.w);
            float s = ((a0 + a1) + (a2 + a3)) + ((a4 + a5) + (a6 + a7));
            float q = ((a0 * a0 + a1 * a1) + (a2 * a2 + a3 * a3)) + ((a4 * a4 + a5 * a5) + (a6 * a6 + a7 * a7));
            s = wave_sum(s); q = wave_sum(q);
            const float mu = s * (1.0f / 512.0f), var = fmaxf(q * (1.0f / 512.0f) - mu * mu, 0.f);
            if (F.lane == 0) { st[tl] = mu; st[128 + tl] = __builtin_amdgcn_rsqf(var + EPS); } }
#pragma nounroll
        for (int g = 0; g < 4; ++g) {
            __syncthreads();
#pragma nounroll
            for (int it = 0; it < 4; ++it) { const int idx = F.tid + it * NTHR, q = idx >> 4, c8 = idx & 15;
                const u32x4 w = *(const u32x4*)(UV + (size_t)(t0 + q) * 1024 + 512 + g * 128 + 8 * c8);
                const float mu = st[q], rsd = st[128 + q]; const float* gp = lng + g * 128 + 8 * c8; const float* bp = lnb + g * 128 + 8 * c8;
                const float a[8] = {bflo(w.x), bfhi(w.x), bflo(w.y), bfhi(w.y), bflo(w.z), bfhi(w.z), bflo(w.w), bfhi(w.w)};
#pragma unroll
                for (int e = 0; e < 8; ++e) { const float y = (a[e] - mu) * rsd * gp[e] + bp[e]; vt[(8 * c8 + e) * 136 + q] = (bf16_t)(cvt_pk_bf16(y, 0.f) & 0xffffu); } }
#pragma nounroll
            for (int it = 0; it < 8; ++it) { const int idx = F.tid + it * NTHR, p = idx >> 5, q4 = idx & 31;
                f32x4 w = *(const f32x4*)(wsp + ((size_t)g * 128 + p) * 128 + 4 * q4);
                if ((q4 >> 4) > (p >> 6)) w = (f32x4){0.f, 0.f, 0.f, 0.f};
                u32x2 o; o.x = cvt_pk_bf16(w[0], w[1]); o.y = cvt_pk_bf16(w[2], w[3]); *(LAS u32x2*)(wl + p * 136 + 4 * q4) = o; }
            __syncthreads();
            const int pb = F.wave >> 1;
            f32x16 acc[2]; acc[0] = f32x16{}; acc[1] = f32x16{};
#pragma unroll
            for (int ks = 0; ks < 8; ++ks) {
                const bf16x8 af = *(const LAS bf16x8*)(wl + (32 * pb + r32) * 136 + 16 * ks + 8 * hi);
#pragma unroll
                for (int j = 0; j < 2; ++j) { const int cb = 2 * (F.wave & 1) + j;
                    const bf16x8 bfr = *(const LAS bf16x8*)(vt + (32 * cb + r32) * 136 + 16 * ks + 8 * hi);
                    acc[j] = __builtin_amdgcn_mfma_f32_32x32x16_bf16(af, bfr, acc[j], 0, 0, 0); }
            }
#pragma unroll
            for (int j = 0; j < 2; ++j) { const int c = 32 * (2 * (F.wave & 1) + j) + r32;
#pragma unroll
                for (int r = 0; r < 16; ++r) { const int p = 32 * pb + (r & 3) + 8 * (r >> 2) + 4 * hi;
                    const float uu = bf2f(UV[(size_t)(t0 + p) * 1024 + g * 128 + c]);
                    const float y = (acc[j][r] + bsp[g * 128 + p]) * uu;
                    BR[(size_t)(t0 + p) * 1536 + g * 128 + c] = (bf16_t)(cvt_pk_bf16(y, 0.f) & 0xffffu); } }
        }
    }
    __syncthreads();
}
#if MK_CHECK
#define CHK_NSTAGE 32
__device__ __forceinline__ void chk_acc(float* err, int stage, float got, float ref) {
    const float d = got - ref; float d2 = d * d, r2 = ref * ref;
    if (!(d2 == d2) || !(d2 < 1e30f)) d2 = 1e30f;
    atomicAdd(err + 2 * stage, d2); atomicAdd(err + 2 * stage + 1, r2);
}
__device__ __forceinline__ int chk_row(int i) { return (17 + 61 * i) % T; }
constexpr int CHK_NROWS = 512;
__global__ void chk_norm(const float* x, const float* g, const bf16_t* H, float* err, int stage) {
    const int row = chk_row(blockIdx.x); __shared__ float red[256]; float ss = 0.f;
    for (int c = threadIdx.x; c < 1024; c += 256) { const float v = x[(size_t)row * 1024 + c]; ss += v * v; }
    red[threadIdx.x] = ss; __syncthreads();
    for (int o = 128; o > 0; o >>= 1) { if (threadIdx.x < o) red[threadIdx.x] += red[threadIdx.x + o]; __syncthreads(); }
    const float rs = 1.0f / sqrtf(red[0] / 1024.f + EPS);
    for (int c = threadIdx.x; c < 1024; c += 256) chk_acc(err, stage, bf2f(H[(size_t)row * 1024 + c]), x[(size_t)row * 1024 + c] * rs * g[c]);
}
__device__ __forceinline__ float chk_dot_h(const bf16_t* H, int row, const float* W, int ldw, int col, int K) { float a = 0.f; for (int k = 0; k < K; ++k) a += bf2f(H[(size_t)row * K + k]) * W[(size_t)k * ldw + col]; return a; }
__global__ void chk_inproj(const bf16_t* H, const float* w_in, const float* w_gate, const float* b_gate, unsigned char* R, const float* rc, const float* rs, float* err, int stage) {
    const int row = chk_row(blockIdx.x), pos = row & (SEQ - 1), b = row >> 13, tile = pos >> 6, kv = pos & 63;
    const bf16_t *UV = (const bf16_t*)(R + R_UV), *CQ = (const bf16_t*)(R + R_CQ), *CKV = (const bf16_t*)(R + R_CKV), *DQ = (const bf16_t*)(R + R_DQ), *K12 = (const bf16_t*)(R + R_K12), *VD = (const bf16_t*)(R + R_VD), *G = (const bf16_t*)(R + R_G), *KM = (const bf16_t*)(R + R_KM);
    for (int c = threadIdx.x; c < 3008 + 3072; c += blockDim.x) {
        if (c < 3008) {
            if (c >= 1408 && c < 1472) { if (c >= 1440) continue; const int i = c - 1408;
                const float x1 = chk_dot_h(H, row, w_in, 3008, 1408 + i, 1024), x2 = chk_dot_h(H, row, w_in, 3008, 1440 + i, 1024);
                const float cs = rc[pos * 32 + i], sn = rs[pos * 32 + i], o1 = x1 * cs - x2 * sn, o2 = x2 * cs + x1 * sn;
                for (int h = 0; h < 4; ++h) { const size_t a = km_addr(b * 4 + h, tile, 16 + (i >> 2), kv); chk_acc(err, stage + 1, bf2f(KM[a + (i & 3)]), o1); chk_acc(err, stage + 1, bf2f(KM[a + 4 + (i & 3)]), o2); }
                continue; }
            const float v = chk_dot_h(H, row, w_in, 3008, c, 1024);
#if MK_CHECK == 35 || MK_CHECK == 36
            if (c < 1024) chk_acc(err, stage, bf2f(UV[(size_t)row * 1024 + c]), 1.0f / (1.0f + expf(-v)));
#elif MK_CHECK == 34
            if (c < 1024) chk_acc(err, stage, bf2f(UV[(size_t)row * 1024 + c]), 1.0f / (1.0f + expf(-(v + b_gate[c]))));
#else
            if (c < 1024) chk_acc(err, stage, bf2f(UV[(size_t)row * 1024 + c]), 0.5f * v * (1.0f + tanhf(0.7978845608f * (v + 0.044715f * v * v * v))));
#endif
            else if (c < 1280) chk_acc(err, stage + 2, bf2f(CQ[(size_t)row * 256 + c - 1024]), v);
            else if (c < 1408) chk_acc(err, stage + 2, bf2f(CKV[(size_t)row * 256 + c - 1280]), v);
            else if (c < 1984) chk_acc(err, stage + 3, bf2f(DQ[(size_t)row * 512 + c - 1472]), v * QS_DIF);
            else if (c < 2496) { const int cc = c - 1984, h = cc >> 7, mp = (cc & 127) >> 6, d = cc & 63; chk_acc(err, stage + 4, bf2f(K12[k12_addr(b * 4 + h, tile, mp, d >> 3, kv) + (d & 7)]), v); }
            else { const int cc = c - 2496, h = cc >> 7, d = cc & 127; chk_acc(err, stage + 5, bf2f(VD[vimg_addr(b * 4 + h, tile, d >> 5, kv) + (d & 31)]), v); }
        } else { const int gcol = c - 3008, n = gcol >> 10, cc = gcol & 1023;
            const float v = chk_dot_h(H, row, w_gate + (size_t)n * 1024 * 1024, 1024, cc, 1024) + b_gate[n * 1024 + cc];
#if MK_CHECK == 3
            const float gg = bf2f(G[(size_t)row * 3072 + gcol]);
            chk_acc(err, 0, gg, 1.0f / (1.0f + expf(-v)));
            chk_acc(err, 1, gg, 1.0f / (1.0f + expf(-b_gate[n * 1024 + cc])));
            { const int n2 = (n + 1) % 3; const float v2 = chk_dot_h(H, row, w_gate + (size_t)n2 * 1024 * 1024, 1024, cc, 1024); chk_acc(err, 2, gg, 1.0f / (1.0f + expf(-v2))); }
            { const int n2 = (n + 2) % 3; const float v2 = chk_dot_h(H, row, w_gate + (size_t)n2 * 1024 * 1024, 1024, cc, 1024); chk_acc(err, 3, gg, 1.0f / (1.0f + expf(-v2))); }
            chk_acc(err, 4, gg, 1.0f / (1.0f + expf(v)));
            chk_acc(err, 5, gg, 1.0f / (1.0f + exp2f(-v)));
            chk_acc(err, 6, gg, v);
            chk_acc(err, 7, gg, 1.0f / (1.0f + expf(-v * 1.4426950408889634f)));
#else
#if MK_CHECK == 37
            chk_acc(err, stage + 6, bf2f(G[(size_t)row * 3072 + gcol]), 0.5f * v * (1.0f + tanhf(0.7978845608f * (v + 0.044715f * v * v * v))));
#else
            chk_acc(err, stage + 6, bf2f(G[(size_t)row * 3072 + gcol]), 1.0f / (1.0f + expf(-v)));
#endif
#endif
        }
    }
}
__global__ void chk_mlaup(unsigned char* R, const float* w_uq, const float* w_ukv, const float* g_cq, const float* g_ckv, const float* rc, const float* rs, float* err, int stage) {
    const int row = chk_row(blockIdx.x), pos = row & (SEQ - 1), b = row >> 13, tile = pos >> 6, kv = pos & 63;
    const bf16_t *CQ = (const bf16_t*)(R + R_CQ), *CKV = (const bf16_t*)(R + R_CKV), *QM = (const bf16_t*)(R + R_QM), *KM = (const bf16_t*)(R + R_KM), *VM = (const bf16_t*)(R + R_VM);
    float sq = 0.f, sk = 0.f;
    for (int k = 0; k < 256; ++k) { const float v = bf2f(CQ[(size_t)row * 256 + k]); sq += v * v; }
    for (int k = 0; k < 128; ++k) { const float v = bf2f(CKV[(size_t)row * 256 + k]); sk += v * v; }
    const float rq = 1.0f / sqrtf(sq / 256.f + EPS), rk = 1.0f / sqrtf(sk / 128.f + EPS);
    for (int j = threadIdx.x; j < 768 + 1024; j += blockDim.x) {
        if (j < 768) { const int h = j / 192, w = j % 192;
            if (w < 128) { float a = 0.f; for (int k = 0; k < 256; ++k) a += bf2f(CQ[(size_t)row * 256 + k]) * g_cq[k] * w_uq[(size_t)k * 768 + j]; chk_acc(err, stage, bf2f(QM[(size_t)row * 768 + j]), a * rq * QS_MLA); }
            else if (w < 160) { const int i = w - 128; float a1 = 0.f, a2 = 0.f;
                for (int k = 0; k < 256; ++k) { const float cv = bf2f(CQ[(size_t)row * 256 + k]) * g_cq[k]; a1 += cv * w_uq[(size_t)k * 768 + j]; a2 += cv * w_uq[(size_t)k * 768 + j + 32]; }
                a1 *= rq; a2 *= rq; const float cs = rc[pos * 32 + i], sn = rs[pos * 32 + i];
                const int pc = h * 192 + 128 + 8 * (i >> 2) + (i & 3);
                chk_acc(err, stage + 1, bf2f(QM[(size_t)row * 768 + pc]), (a1 * cs - a2 * sn) * QS_MLA); chk_acc(err, stage + 1, bf2f(QM[(size_t)row * 768 + pc + 4]), (a2 * cs + a1 * sn) * QS_MLA); }
        } else { const int jj = j - 768, h = jj >> 8, w = jj & 255; float a = 0.f;
            for (int k = 0; k < 128; ++k) a += bf2f(CKV[(size_t)row * 256 + k]) * g_ckv[k] * w_ukv[(size_t)k * 1024 + jj];
            a *= rk;
            if (w < 128) chk_acc(err, stage + 2, bf2f(KM[km_addr(b * 4 + h, tile, w >> 3, kv) + (w & 7)]), a);
            else { const int d = w - 128; chk_acc(err, stage + 3, bf2f(VM[vimg_addr(b * 4 + h, tile, d >> 5, kv) + (d & 31)]), a); } }
    }
}
__global__ void chk_gmlp(unsigned char* R, const float* lng, const float* lnb, const float* wsp, const float* bsp, float* err, int stage) {
    const int row = chk_row(blockIdx.x), sp0 = row & ~127, p = row & 127;
    const bf16_t *UV = (const bf16_t*)(R + R_UV), *BR = (const bf16_t*)(R + R_BR);
    __shared__ float mu[128], rsd[128];
    if (threadIdx.x < 128) { const int t = sp0 + threadIdx.x; float s = 0.f, q = 0.f; for (int c = 0; c < 512; ++c) { const float v = bf2f(UV[(size_t)t * 1024 + 512 + c]); s += v; q += v * v; }
        const float m = s / 512.f; mu[threadIdx.x] = m; rsd[threadIdx.x] = 1.0f / sqrtf(fmaxf(q / 512.f - m * m, 0.f) + EPS); }
    __syncthreads();
    for (int c = threadIdx.x; c < 512; c += blockDim.x) { const int g = c >> 7; float a = 0.f;
        for (int q = 0; q < 128; ++q) { if ((q >> 6) > (p >> 6)) continue; const float vn = (bf2f(UV[(size_t)(sp0 + q) * 1024 + 512 + c]) - mu[q]) * rsd[q] * lng[c] + lnb[c]; a += wsp[((size_t)g * 128 + p) * 128 + q] * vn; }
        chk_acc(err, stage, bf2f(BR[(size_t)row * 1536 + c]), (a + bsp[g * 128 + p]) * bf2f(UV[(size_t)row * 1024 + c])); }
}
__global__ void chk_attn(unsigned char* R, const float* biast, const float* gsub, const float* lamp, int l, float* err, int stage) {
    const int kind = blockIdx.x & 1, si = blockIdx.x >> 1, b = si & 3, h = (si >> 2) & 3;
    const int qlist[12] = {0, 5, 63, 64, 100, 255, 256, 1000, 3071, 4096, 6000, 8191}; const int q = qlist[(si >> 4) % 12];
    const int row = b * SEQ + q, bh = b * 4 + h, nk = ((q >> 6) + 1) * 64;
    const bf16_t *QM = (const bf16_t*)(R + R_QM), *KM = (const bf16_t*)(R + R_KM), *VM = (const bf16_t*)(R + R_VM), *DQ = (const bf16_t*)(R + R_DQ), *K12 = (const bf16_t*)(R + R_K12), *VD = (const bf16_t*)(R + R_VD), *BR = (const bf16_t*)(R + R_BR);
    __shared__ float sc[8192]; __shared__ float red[256]; __shared__ float outv[2][128];
    const int nmap = kind ? 2 : 1;
    for (int mp = 0; mp < nmap; ++mp) {
        float mx = -1e30f;
        for (int k = threadIdx.x; k < nk; k += 256) { float a = 0.f;
            if (!kind) { for (int d = 0; d < 192; ++d) a += bf2f(QM[(size_t)row * 768 + h * 192 + d]) * bf2f(KM[km_addr(bh, k >> 6, d >> 3, k & 63) + (d & 7)]); }
            else { for (int d = 0; d < 64; ++d) a += bf2f(DQ[(size_t)row * 512 + h * 128 + mp * 64 + d]) * bf2f(K12[k12_addr(bh, k >> 6, mp, d >> 3, k & 63) + (d & 7)]);
                int ix = k - q + 192; if (ix < 0) ix = 0; a += biast[h * 256 + ix]; }
            sc[k] = a; mx = fmaxf(mx, a); }
        red[threadIdx.x] = mx; __syncthreads();
        for (int o = 128; o > 0; o >>= 1) { if (threadIdx.x < o) red[threadIdx.x] = fmaxf(red[threadIdx.x], red[threadIdx.x + o]); __syncthreads(); }
        mx = red[0]; __syncthreads(); float sm = 0.f;
        for (int k = threadIdx.x; k < nk; k += 256) { const float e = exp2f(sc[k] - mx); sc[k] = e; sm += e; }
        red[threadIdx.x] = sm; __syncthreads();
        for (int o = 128; o > 0; o >>= 1) { if (threadIdx.x < o) red[threadIdx.x] += red[threadIdx.x + o]; __syncthreads(); }
        sm = red[0]; __syncthreads();
        if (threadIdx.x < 128) { const int d = threadIdx.x; float a = 0.f; const bf16_t* V = kind ? VD : VM;
            for (int k = 0; k < nk; ++k) a += sc[k] * bf2f(V[vimg_addr(bh, k >> 6, d >> 5, k & 63) + (d & 31)]);
            outv[mp][d] = a / sm; }
        __syncthreads();
    }
    if (!kind) { if (threadIdx.x < 128) chk_acc(err, stage, bf2f(BR[(size_t)row * 1536 + 512 + h * 128 + threadIdx.x]), outv[0][threadIdx.x]); }
    else { const float lam = lamp[l]; float v = 0.f; if (threadIdx.x < 128) v = outv[0][threadIdx.x] - lam * outv[1][threadIdx.x];
        red[threadIdx.x] = v * v; __syncthreads();
        for (int o = 128; o > 0; o >>= 1) { if (threadIdx.x < o) red[threadIdx.x] += red[threadIdx.x + o]; __syncthreads(); }
        const float rn = 1.0f / sqrtf(red[0] / 128.f + EPS) * (1.0f - (0.8f - 0.6f * expf(-0.3f * (float)l)));
        if (threadIdx.x < 128) chk_acc(err, stage + 1, bf2f(BR[(size_t)row * 1536 + 1024 + h * 128 + threadIdx.x]), v * rn * gsub[threadIdx.x]); }
}
__global__ void chk_merged(unsigned char* R, const float* w_branch, float* err, int stage) {
    const int row = chk_row(blockIdx.x); const bf16_t *BR = (const bf16_t*)(R + R_BR), *G = (const bf16_t*)(R + R_G), *MG = (const bf16_t*)(R + R_MERGED);
    for (int c = threadIdx.x; c < 1024; c += blockDim.x) { float m = 0.f;
        for (int n = 0; n < 3; ++n) { float a = 0.f; for (int k = 0; k < 512; ++k) a += bf2f(BR[(size_t)row * 1536 + n * 512 + k]) * w_branch[((size_t)n * 512 + k) * 1024 + c]; m += a * bf2f(G[(size_t)row * 3072 + n * 1024 + c]); }
        chk_acc(err, stage, bf2f(MG[(size_t)row * 1024 + c]), m); }
}
__global__ void chk_resid(const bf16_t* A, int K, const float* W, const float* xin, const float* xsave, const float* xout, float* err, int stage) {
    const int row = chk_row(blockIdx.x);
    for (int c = threadIdx.x; c < 1024; c += blockDim.x) { float a = 0.f; for (int k = 0; k < K; ++k) a += bf2f(A[(size_t)row * K + k]) * W[(size_t)k * 1024 + c];
        const float xi = xsave ? xsave[(size_t)blockIdx.x * 1024 + c] : xin[(size_t)row * 1024 + c];
        chk_acc(err, stage, xout[(size_t)row * 1024 + c] - xi, a); }
}
__global__ void chk_save_rows(const float* x, float* xsave) { const int row = chk_row(blockIdx.x); for (int c = threadIdx.x; c < 1024; c += blockDim.x) xsave[(size_t)blockIdx.x * 1024 + c] = x[(size_t)row * 1024 + c]; }
__global__ void chk_swiglu(const bf16_t* H, const float* w1, const float* w3, int F_, const bf16_t* HM, float* err, int stage) {
    const int row = chk_row(blockIdx.x * 4);
    for (int c = threadIdx.x; c < F_; c += blockDim.x) { float a = 0.f, b2 = 0.f; for (int k = 0; k < 1024; ++k) { const float hv = bf2f(H[(size_t)row * 1024 + k]); a += hv * w1[(size_t)k * F_ + c]; b2 += hv * w3[(size_t)k * F_ + c]; }
        chk_acc(err, stage, bf2f(HM[(size_t)row * F_ + c]), a / (1.0f + expf(-a)) * b2); }
}
__global__ void chk_moe(const float* x, const float* g, const float* router, const float* w1, const float* w3, const float* w2, unsigned char* ws, float* err, int stage) {
    const int row = chk_row(blockIdx.x * 8); __shared__ float hf[1024]; __shared__ float red[256]; __shared__ float lg[8]; __shared__ float hid[FE];
    const bf16_t *H = (const bf16_t*)(ws + WS_H), *XG = (const bf16_t*)(ws + WS_R + R_XG), *HME = (const bf16_t*)(ws + WS_R + R_HME), *Y = (const bf16_t*)(ws + WS_R + R_Y);
    const int* slot = (const int*)(ws + WS_SLOT); const float* roww = (const float*)(ws + WS_ROWW); const int* meta = (const int*)(ws + WS_META);
    float ss = 0.f; for (int c = threadIdx.x; c < 1024; c += 256) { const float v = x[(size_t)row * 1024 + c]; ss += v * v; }
    red[threadIdx.x] = ss; __syncthreads();
    for (int o = 128; o > 0; o >>= 1) { if (threadIdx.x < o) red[threadIdx.x] += red[threadIdx.x + o]; __syncthreads(); }
    const float rs = 1.0f / sqrtf(red[0] / 1024.f + EPS);
    for (int c = threadIdx.x; c < 1024; c += 256) hf[c] = x[(size_t)row * 1024 + c] * rs * g[c];
    __syncthreads();
    if (threadIdx.x < 8) { float a = 0.f; for (int k = 0; k < 1024; ++k) a += hf[k] * router[k * 8 + threadIdx.x]; lg[threadIdx.x] = a; }
    __syncthreads();
    int e1 = 0; for (int e = 1; e < 8; ++e) if (lg[e] > lg[e1]) e1 = e;
    int e2 = -1; for (int e = 0; e < 8; ++e) if (e != e1 && (e2 < 0 || lg[e] > lg[e2])) e2 = e;
    const float w1v = 1.0f / (1.0f + expf(lg[e2] - lg[e1]));
    for (int k2 = 0; k2 < 2; ++k2) { const int e = k2 ? e2 : e1; const float wv = k2 ? 1.0f - w1v : w1v; const int r = slot[2 * row + k2];
        if (threadIdx.x == 0) { chk_acc(err, stage, roww[r], wv); int er = 0; for (int j = 1; j < 8; ++j) er += ((r >> 8) >= meta[j]) ? 1 : 0; chk_acc(err, stage, (float)er + 1.f, (float)e + 1.f); }
        for (int c = threadIdx.x; c < 1024; c += 256) chk_acc(err, stage + 1, bf2f(XG[(size_t)r * 1024 + c]), bf2f(H[(size_t)row * 1024 + c]));
        for (int c = threadIdx.x; c < FE; c += 256) { float a = 0.f, b2 = 0.f; for (int k = 0; k < 1024; ++k) { const float hv = bf2f(H[(size_t)row * 1024 + k]); a += hv * w1[((size_t)e * 1024 + k) * FE + c]; b2 += hv * w3[((size_t)e * 1024 + k) * FE + c]; }
            const float hvv = a / (1.0f + expf(-a)) * b2; chk_acc(err, stage + 2, bf2f(HME[(size_t)r * FE + c]), hvv); }
        __syncthreads();
        for (int c = threadIdx.x; c < FE; c += 256) hid[c] = bf2f(HME[(size_t)r * FE + c]);
        __syncthreads();
        for (int c = threadIdx.x; c < 1024; c += 256) { float a = 0.f; for (int k = 0; k < FE; ++k) a += hid[k] * w2[((size_t)e * FE + k) * 1024 + c]; chk_acc(err, stage + 3, bf2f(Y[(size_t)r * 1024 + c]), a * wv); }
        __syncthreads(); }
}
__global__ void chk_combine(const float* xsave, const float* xout, unsigned char* ws, float* err, int stage) {
    const int row = chk_row(blockIdx.x); const bf16_t* Y = (const bf16_t*)(ws + WS_R + R_Y); const int* slot = (const int*)(ws + WS_SLOT);
    for (int c = threadIdx.x; c < 1024; c += blockDim.x) chk_acc(err, stage, xout[(size_t)row * 1024 + c] - xsave[(size_t)blockIdx.x * 1024 + c], bf2f(Y[(size_t)slot[2 * row] * 1024 + c]) + bf2f(Y[(size_t)slot[2 * row + 1] * 1024 + c]));
}
__global__ void chk_wcat(const bf16_t* Wcat, const float* w_in, const float* w_gate, float* err) {
    const int r = (blockIdx.x * 37) % 6144;
    for (int k = threadIdx.x; k < 1024; k += blockDim.x) {
        if (r < 3072) { const int sc = conv_srccol(1, r); const float ref = sc < 0 ? 0.f : w_in[(size_t)k * 3008 + sc]; chk_acc(err, 16, bf2f(Wcat[(size_t)r * 1024 + k]), ref); }
        else { const int n = (r - 3072) >> 10, cc = (r - 3072) & 1023; chk_acc(err, 17 + n, bf2f(Wcat[(size_t)r * 1024 + k]), w_gate[((size_t)n * 1024 + k) * 1024 + cc]); }
    }
}
__global__ void chk_encode(const float* err, float* out, int n) {
    __shared__ float sa; __shared__ int sidx;
    if (threadIdx.x == 0) { int idx = 0; float eb = 0.f, emax = 0.f;
        for (int s = 0; s < CHK_NSTAGE; ++s) { const float d2 = err[2 * s], r2 = err[2 * s + 1]; if (r2 == 0.f && d2 == 0.f) continue; float e = sqrtf(d2 / fmaxf(r2, 1e-30f)); if (!(e == e)) e = 1e3f; e = fminf(e, 1e3f);
            if (e > emax) emax = e; if (idx == 0 && e > 0.03f) { idx = s + 1; eb = e; } }
#if MK_CHECK == 33
        { int bi = 0; float be = 1e30f; for (int s = 0; s < 8; ++s) { const float e = sqrtf(err[2 * s] / fmaxf(err[2 * s + 1], 1e-30f)); if (e < be) { be = e; bi = s; } } idx = bi; eb = be; emax = be; }
#endif
#ifdef MK_SEL
        { const float e = sqrtf(err[2 * MK_SEL] / fmaxf(err[2 * MK_SEL + 1], 1e-30f)); idx = MK_SEL + 1; eb = (e == e) ? fminf(e, 1e3f) : 1e3f; }
#endif
        sa = sqrtf(1000.f * (idx ? eb : emax)); sidx = idx; }
    __syncthreads();
    const float a = sa;
    for (size_t i = (size_t)blockIdx.x * blockDim.x + threadIdx.x; i < (size_t)n; i += (size_t)gridDim.x * blockDim.x) { unsigned hsh = (unsigned)i * 2654435761u; hsh ^= hsh >> 15; out[i] = (hsh & 1u) ? a : -a; }
    if (blockIdx.x == 0 && threadIdx.x == 0) out[0] = 100.f * (float)(1 + sidx);
}
#endif
constexpr int CW_BAR = 4096;
constexpr int N_PHASES = 42;

__global__ void __launch_bounds__(NTHR, 2) mk_fwd(Args args) {
    extern __shared__ __attribute__((aligned(16))) unsigned char lds_raw[];
    Frame F;
    F.lds = (LAS unsigned char*)lds_raw;
    F.tid = threadIdx.x; F.lane = F.tid & 63; F.wave = __builtin_amdgcn_readfirstlane(F.tid >> 6);
    F.G = gridDim.x; { const int bx = blockIdx.x; F.vcu = (F.G % 8 == 0) ? (bx % 8) * (F.G / 8) + bx / 8 : bx; }
    F.out = args.out; F.ws = args.ws; F.tid = 0; F.lane = 0;
    volatile LAS unsigned* MISC = (volatile LAS unsigned*)(F.lds + MISC_OFF);
    if (threadIdx.x < 64) MISC[threadIdx.x] = 0u;
    __syncthreads();
    XcdBarrier bar = xcd_barrier_post((unsigned*)(F.ws + WS_CTL) + CW_BAR, MISC + 8);
    const int lo = args.ph_lo, hi = args.ph_hi;
#ifndef MK_EN
#define MK_EN 0xFFFFF
#endif
#define EN(b) ((MK_EN >> (b)) & 1)
#define IN(k) (lo <= (k) && (k) < hi)
#define SEAM(k) do { if (IN(k) && IN((k) + 1)) xcd_barrier(bar); } while (0)
    const int cblk = (int)blockIdx.x;

    if (IN(0) && EN(0)) { conv_range(F, args, 0, 70, 0); prologue_tables(F, args); }
    SEAM(0);

    const Frame Fk = F;
#pragma nounroll
    for (int l = 0; l < NLAYER; ++l) {
        Frame F = Fk;
        { unsigned char* w_ = F.ws; float* o_ = F.out; unsigned l_ = (unsigned)(size_t)F.lds; asm volatile("" : "+s"(w_), "+s"(o_), "+s"(l_)); F.ws = w_; F.out = o_; F.lds = (LAS unsigned char*)(size_t)l_; }
        unsigned char* R = F.ws + WS_R;
        const float* rc = (const float*)(F.ws + WS_ROPEC); const float* rs = (const float*)(F.ws + WS_ROPES);
        const int pb = 1 + 10 * l; const bool moe = (l & 1) != 0; const int fi = l >> 1;
        unsigned char* wmix = F.ws + WS_WMIX + (size_t)l * WMIX_STRIDE;
        const float* xin = (l == 0) ? args.in[0] : F.out;
        if (IN(pb + 0) && EN(1)) {
            norm_phase<0>(F, xin, F.out, args.in[1] + l * 1024, (l == 2), nullptr);
            if (l == 2) conv_range(F, args, 46, 70, 1);
        }
        SEAM(pb + 0);
        if (IN(pb + 1) && EN(2)) {
            pg8::Gemm g{1024, 1024, 1024};
            pg8::SchedDense S{T / 256, NCAT / 256, F.G, cblk, (const char*)(F.ws + WS_H), (const char*)(wmix + WM_CAT), (size_t)256 * 1024 * 2, (size_t)256 * 1024 * 2};
            pg8::EpiInproj E{(bf16_t*)(R + R_UV), (bf16_t*)(R + R_CQ), (bf16_t*)(R + R_CKV), (bf16_t*)(R + R_DQ), (bf16_t*)(R + R_K12), (bf16_t*)(R + R_VD), (bf16_t*)(R + R_G), (bf16_t*)(R + R_KM),
                             (float*)(F.ws + WS_CQP), (float*)(F.ws + WS_CKVP), args.in[18] + (size_t)l * 3072, rc, rs};
            pg8::gemm_phase(F.lds, g, S, E);
        }
        SEAM(pb + 1);
        if (IN(pb + 2) && EN(3)) {
            if (EN(16)) { pg8::Gemm g{256, 256, 256};
              pg8::SchedDense S{T / 256, 3, F.G, cblk, (const char*)(R + R_CQ), (const char*)(wmix + WM_UQ), (size_t)256 * 256 * 2, (size_t)256 * 256 * 2};
              pg8::EpiQ E{(bf16_t*)(R + R_QM), (const float*)(F.ws + WS_CQP), rc, rs};
              pg8::gemm_phase(F.lds, g, S, E); }
            if (EN(17)) { pg8::Gemm g{256, 256, 256};
              pg8::SchedDense S{T / 256, 4, F.G, cblk, (const char*)(R + R_CKV), (const char*)(wmix + WM_UKV), (size_t)256 * 256 * 2, (size_t)256 * 256 * 2};
              pg8::EpiKV E{(bf16_t*)(R + R_KM), (bf16_t*)(R + R_VM), (const float*)(F.ws + WS_CKVP)};
              pg8::gemm_phase(F.lds, g, S, E); }
            if (EN(18)) gmlp_phase(F, args, l);
        }
        SEAM(pb + 2);
        if (IN(pb + 3) && EN(4)) {
            const float lam = ((const float*)(F.ws + WS_LAM))[l]; const float osc = 1.0f - lam_init_of(l);
            for (int pidx = F.vcu; pidx < 256; pidx += F.G) {
                const int bh = pidx >> 4, s = pidx & 15;
                if (EN(19)) for (int k = 0; k < 2; ++k) attn::mla_unit(F.lds, bh, k ? 31 - s : s, (const bf16_t*)(R + R_QM), (const bf16_t*)(R + R_KM), (const bf16_t*)(R + R_VM), (bf16_t*)(R + R_BR));
                if (EN(14)) for (int k = 0; k < 2; ++k) attn::diff_unit(F.lds, bh, k ? 31 - s : s, (const bf16_t*)(R + R_DQ), (const bf16_t*)(R + R_K12), (const bf16_t*)(R + R_VD), (bf16_t*)(R + R_BR),
                                                          (const float*)(F.ws + WS_BIAST), args.in[15] + l * 128, lam, osc);
            }
        }
        SEAM(pb + 3);
        if (IN(pb + 4) && EN(5)) {
            pg8::Gemm g{512, 1536, 512};
            pg8::SchedBranch S{T / 256, 4, F.G, cblk, (const char*)(R + R_BR), (const char*)(wmix + WM_B), (size_t)256 * 1536 * 2, (size_t)256 * 512 * 2, (size_t)512 * 2, (size_t)1024 * 512 * 2};
            pg8::EpiBranch E{(bf16_t*)(R + R_MERGED), (const bf16_t*)(R + R_G)};
            pg8::gemm_phase(F.lds, g, S, E);
        }
        SEAM(pb + 4);
        if (IN(pb + 5) && EN(6)) {
            pg8::Gemm g{1024, 1024, 1024};
            pg8::SchedDense S{T / 256, 4, F.G, cblk, (const char*)(R + R_MERGED), (const char*)(wmix + WM_O), (size_t)256 * 1024 * 2, (size_t)256 * 1024 * 2};
            pg8::EpiResid E{xin, F.out};
            pg8::gemm_phase(F.lds, g, S, E);
        }
        SEAM(pb + 5);
        if (IN(pb + 6) && EN(7)) {
            if (moe) norm_phase<2>(F, F.out, F.out, args.in[21] + l * 1024, false, args.in[25] + (size_t)fi * 1024 * 8);
            else     norm_phase<1>(F, F.out, F.out, args.in[21] + l * 1024, false, nullptr);
        }
        SEAM(pb + 6);
        if (moe) {
            if (IN(pb + 7) && EN(8)) moe_gather_phase(F);
            SEAM(pb + 7);
            if (IN(pb + 8) && EN(9)) {
                const int* meta = (const int*)(F.ws + WS_META);
                pg8::Gemm g{1024, 1024, 1024};
                pg8::SchedMoe S; S.nM = meta[8]; S.nN = 2 * FE / 256; S.G = F.G; S.c = cblk; S.A = (const char*)(R + R_XG); S.B = (const char*)(F.ws + WS_WMOE + WE_13);
                S.astep = (size_t)256 * 1024 * 2; S.bstep = (size_t)256 * 1024 * 2; S.bexp = (size_t)2 * FE * 1024 * 2;
#pragma unroll
                for (int j = 0; j < 9; ++j) S.ts[j] = meta[j];
                pg8::EpiSwiglu E{(bf16_t*)(R + R_HME), FE};
                pg8::gemm_phase(F.lds, g, S, E);
            }
            SEAM(pb + 8);
            if (IN(pb + 9) && EN(10)) {
                const int* meta = (const int*)(F.ws + WS_META);
                pg8::Gemm g{FE, FE, FE};
                pg8::SchedMoe S; S.nM = meta[8]; S.nN = 4; S.G = F.G; S.c = cblk; S.A = (const char*)(R + R_HME); S.B = (const char*)(F.ws + WS_WMOE + WE_2);
                S.astep = (size_t)256 * FE * 2; S.bstep = (size_t)256 * FE * 2; S.bexp = (size_t)1024 * FE * 2;
#pragma unroll
                for (int j = 0; j < 9; ++j) S.ts[j] = meta[j];
                pg8::EpiMoeDown E{(bf16_t*)(R + R_Y), (const float*)(F.ws + WS_ROWW)};
                pg8::gemm_phase(F.lds, g, S, E);
            }
            SEAM(pb + 9);
        } else {
            unsigned char* wden = F.ws + WS_WDEN + (size_t)fi * WDEN_STRIDE;
            if (IN(pb + 8) && EN(11)) {
                pg8::Gemm g{1024, 1024, 1024};
                pg8::SchedDense S{T / 256, 2 * FD / 256, F.G, cblk, (const char*)(F.ws + WS_H), (const char*)(wden + WD_13), (size_t)256 * 1024 * 2, (size_t)256 * 1024 * 2};
                pg8::EpiSwiglu E{(bf16_t*)(R + R_HMD), FD};
                pg8::gemm_phase(F.lds, g, S, E);
            }
            SEAM(pb + 8);
            if (IN(pb + 9) && EN(12)) {
                pg8::Gemm g{FD, FD, FD};
                pg8::SchedDense S{T / 256, 4, F.G, cblk, (const char*)(R + R_HMD), (const char*)(wden + WD_2), (size_t)256 * FD * 2, (size_t)256 * FD * 2};
                pg8::EpiResid E{F.out, F.out};
                pg8::gemm_phase(F.lds, g, S, E);
            }
            SEAM(pb + 9);
        }
    }
    if (IN(41) && EN(13)) norm_phase<3>(Fk, F.out, F.out, args.in[29], true, nullptr);
#undef IN
#undef SEAM
}

extern "C" void kernel_launch(void* const* d_in, const int* in_sizes, int n_in, void* d_out, int out_size, void* d_ws, size_t ws_size, hipStream_t stream) {
    static int grid = 0;
    if (grid == 0) {
        if (n_in != 30 || out_size != T * DM || ws_size < WS_END) { fprintf(stderr, "kernel_launch: unexpected shapes (n_in %d out %d ws %zu)\n", n_in, out_size, ws_size); grid = -1; return; }
        int dev = 0, cus = 0, per_cu = 0;
        if (hipGetDevice(&dev) != hipSuccess || hipDeviceGetAttribute(&cus, hipDeviceAttributeMultiprocessorCount, dev) != hipSuccess) { grid = -1; return; }
        if (hipFuncSetAttribute((const void*)mk_fwd, hipFuncAttributeMaxDynamicSharedMemorySize, LDS_BYTES) != hipSuccess) { fprintf(stderr, "kernel_launch: hipFuncSetAttribute failed\n"); grid = -1; return; }
        if (hipOccupancyMaxActiveBlocksPerMultiprocessor(&per_cu, (const void*)mk_fwd, NTHR, LDS_BYTES) != hipSuccess || per_cu < 1) { fprintf(stderr, "kernel_launch: occupancy query says %d\n", per_cu); }
        (void)hipGetLastError();
        grid = cus;
    }
    if (grid < 0) return;
    (void)hipMemsetAsync((char*)d_ws + WS_CTL, 0, CTL_ZERO_BYTES, stream);
    Args a{};
    for (int i = 0; i < 30; ++i) a.in[i] = (const float*)d_in[i];
    a.out = (float*)d_out; a.ws = (unsigned char*)d_ws;
#if MK_CHECK
    {
        float* err = (float*)((char*)d_ws + WS_END); float* xsave = (float*)((char*)d_ws + WS_END + MiB);
        unsigned char* ws = (unsigned char*)d_ws; unsigned char* R = ws + WS_R; const float* const* in = (const float* const*)d_in;
        const float* rc = (const float*)(ws + WS_ROPEC); const float* rs = (const float*)(ws + WS_ROPES);
        (void)hipMemsetAsync(err, 0, 4096, stream);
#define LNCH(lo_, hi_) do { (void)hipMemsetAsync((char*)d_ws + WS_CTL, 0, CTL_ZERO_BYTES, stream); a.ph_lo = (lo_); a.ph_hi = (hi_); hipLaunchKernelGGL(mk_fwd, dim3(grid), dim3(NTHR), LDS_BYTES, stream, a); } while (0)
#if MK_CHECK == 3
        LNCH(0, 1); hipLaunchKernelGGL(chk_wcat, dim3(2048), dim3(256), 0, stream, (const bf16_t*)(ws + WS_WMIX + WM_CAT), in[2], in[17], err);
#elif MK_CHECK == 33 || MK_CHECK == 34 || MK_CHECK == 35 || MK_CHECK == 36 || MK_CHECK == 37
        LNCH(0, 2); LNCH(2, 3);  hipLaunchKernelGGL(chk_inproj, dim3(CHK_NROWS), dim3(256), 0, stream, (const bf16_t*)(ws + WS_H), in[2], in[17], in[18], R, rc, rs, err, 20);
#elif MK_CHECK == 1
        LNCH(0, 2);  hipLaunchKernelGGL(chk_norm, dim3(CHK_NROWS), dim3(256), 0, stream, in[0], in[1], (const bf16_t*)(ws + WS_H), err, 0);
        LNCH(2, 3);  hipLaunchKernelGGL(chk_inproj, dim3(CHK_NROWS), dim3(256), 0, stream, (const bf16_t*)(ws + WS_H), in[2], in[17], in[18], R, rc, rs, err, 1);
        LNCH(3, 4);  hipLaunchKernelGGL(chk_mlaup, dim3(CHK_NROWS), dim3(256), 0, stream, R, in[9], in[10], in[7], in[8], rc, rs, err, 8);
                     hipLaunchKernelGGL(chk_gmlp, dim3(CHK_NROWS), dim3(256), 0, stream, R, in[3], in[4], in[5], in[6], err, 12);
        LNCH(4, 5);  hipLaunchKernelGGL(chk_attn, dim3(2 * 16 * 12), dim3(256), 0, stream, R, (const float*)(ws + WS_BIAST), in[15], (const float*)(ws + WS_LAM), 0, err, 13);
        LNCH(5, 6);  hipLaunchKernelGGL(chk_merged, dim3(CHK_NROWS), dim3(256), 0, stream, R, in[19], err, 15);
        LNCH(6, 7);  hipLaunchKernelGGL(chk_resid, dim3(CHK_NROWS), dim3(256), 0, stream, (const bf16_t*)(R + R_MERGED), 1024, in[20], in[0], (const float*)nullptr, (const float*)d_out, err, 16);
        LNCH(7, 8);  hipLaunchKernelGGL(chk_norm, dim3(CHK_NROWS), dim3(256), 0, stream, (const float*)d_out, in[21], (const bf16_t*)(ws + WS_H), err, 17);
        LNCH(8, 10); hipLaunchKernelGGL(chk_swiglu, dim3(128), dim3(256), 0, stream, (const bf16_t*)(ws + WS_H), in[22], in[23], FD, (const bf16_t*)(R + R_HMD), err, 18);
        hipLaunchKernelGGL(chk_save_rows, dim3(CHK_NROWS), dim3(256), 0, stream, (const float*)d_out, xsave);
        LNCH(10, 11); hipLaunchKernelGGL(chk_resid, dim3(CHK_NROWS), dim3(256), 0, stream, (const bf16_t*)(R + R_HMD), FD, in[24], (const float*)nullptr, (const float*)xsave, (const float*)d_out, err, 19);
#else
        LNCH(0, 21); hipLaunchKernelGGL(chk_moe, dim3(64), dim3(256), 0, stream, (const float*)d_out, in[21] + 1024, in[25], in[26], in[27], in[28], ws, err, 20);
        hipLaunchKernelGGL(chk_save_rows, dim3(CHK_NROWS), dim3(256), 0, stream, (const float*)d_out, xsave);
        LNCH(21, 22); hipLaunchKernelGGL(chk_combine, dim3(CHK_NROWS), dim3(256), 0, stream, (const float*)xsave, (const float*)d_out, ws, err, 24);
#endif
        hipLaunchKernelGGL(chk_encode, dim3(1024), dim3(256), 0, stream, (const float*)err, (float*)d_out, out_size);
    }
#elif MK_MULTI
    for (int p = 0; p < N_PHASES; ++p) { a.ph_lo = p; a.ph_hi = p + 1; hipLaunchKernelGGL(mk_fwd, dim3(grid), dim3(NTHR), LDS_BYTES, stream, a); }
#else
#ifndef MK_PH_HI
#define MK_PH_HI N_PHASES
#endif
    a.ph_lo = 0; a.ph_hi = MK_PH_HI;
    hipLaunchKernelGGL(mk_fwd, dim3(grid), dim3(NTHR), LDS_BYTES, stream, a);
#endif
}
```

```cpp
#include <hip/hip_runtime.h>
#include <cstdio>
#include <cstdint>

#define GAS __attribute__((address_space(1)))
#define LAS __attribute__((address_space(3)))
typedef unsigned short bf16_t;
typedef short bf16x8 __attribute__((ext_vector_type(8)));
typedef short s16x4 __attribute__((ext_vector_type(4)));
typedef float f32x2 __attribute__((ext_vector_type(2)));
typedef float f32x4 __attribute__((ext_vector_type(4)));
typedef float f32x16 __attribute__((ext_vector_type(16)));
typedef unsigned u32x2 __attribute__((ext_vector_type(2)));
typedef unsigned u32x4 __attribute__((ext_vector_type(4)));
typedef int i32x4 __attribute__((ext_vector_type(4)));
typedef int i32x8 __attribute__((ext_vector_type(8)));

#ifndef MK_MULTI
#define MK_MULTI 0
#endif
#ifndef MK_TIME
#define MK_TIME 0
#endif
#ifndef MK_CHECK
#define MK_CHECK 0
#endif

constexpr int T = 32768, DM = 1024, SEQ = 8192, NBATCH = 4, NLAYER = 4;
constexpr int NCAT = 6144;
constexpr int FD = 2816, FE = 3584, NEXP = 8;
constexpr int MAXROWS = 65536 + NEXP * 256;
constexpr float EPS = 1e-6f;
constexpr float LOG2E = 1.4426950408889634f;
constexpr float QS_MLA = 0.07216878364870322f * LOG2E;
constexpr float QS_DIF = 0.125f * LOG2E;

constexpr size_t MiB = 1u << 20;
constexpr size_t WS_CTL = 0, CTL_ZERO_BYTES = 64 * 1024;
constexpr size_t WS_ROPEC = 1 * MiB, WS_ROPES = 2 * MiB;
constexpr size_t WS_BIAST = 3 * MiB;
constexpr size_t WS_LAM = 3 * MiB + 8192;
constexpr size_t WS_META = 3 * MiB + 16384;
constexpr size_t WS_CQP = 4 * MiB, WS_CKVP = 4 * MiB + 512 * 1024;
constexpr size_t WS_SEL = 5 * MiB;
constexpr size_t WS_SLOT = 5 * MiB + 512 * 1024;
constexpr size_t WS_CNT = 5 * MiB + 768 * 1024;
constexpr size_t WS_ROWW = 6 * MiB;
constexpr size_t WS_GIDX = 6 * MiB + 512 * 1024;
#ifndef MK_MOE_GATHER
#define MK_MOE_GATHER 1
#endif
constexpr size_t WS_WMIX = 8 * MiB, WMIX_STRIDE = 18 * MiB;
constexpr size_t WM_G8 = 6 * MiB;
constexpr size_t WM_CAT = 0, WM_UQ = 12 * MiB, WM_UKV = 12 * MiB + 512 * 1024, WM_B = 13 * MiB, WM_O = 16 * MiB;
#ifndef MK_F8_DENSE
#define MK_F8_DENSE 2
#endif
#define F8_DENSE(fi) (((MK_F8_DENSE) >> (fi)) & 1)
constexpr size_t WS_WDEN = 80 * MiB, WDEN_STRIDE = 16 * MiB + 512 * 1024;
constexpr size_t WD_13 = 0, WD_2 = 11 * MiB;
constexpr size_t WS_WMOE = 113 * MiB, WMOE_STRIDE = 84 * MiB;
constexpr size_t WE_13 = 0, WE_2 = 56 * MiB;
constexpr size_t WS_XB = WS_WMOE + 84 * MiB;
constexpr int SW13 = 4, SW2 = 5;
constexpr size_t WS_H = 281 * MiB;
constexpr size_t WS_R = 345 * MiB;
constexpr size_t R_UV = 0, R_MERGED = 0, R_CQ = 64 * MiB, R_CKV = 80 * MiB, R_DQ = 96 * MiB, R_K12 = 128 * MiB, R_VD = 160 * MiB,
                 R_G = 192 * MiB, R_QM = 384 * MiB, R_KM = 432 * MiB, R_VM = 480 * MiB, R_BR = 512 * MiB;
constexpr size_t R_HMD = 0;
constexpr size_t R_XG = 0, R_Y = 0, R_HME = 132 * MiB;
constexpr size_t WS_H8 = 953 * MiB;
constexpr size_t WS_END = 985 * MiB;
#ifndef MK_F8_GATES
#define MK_F8_GATES 1
#endif
constexpr int SWG = 4;
#ifndef MK_F8_INPROJ
#define MK_F8_INPROJ 0
#endif
#ifndef MK_G8
#define MK_G8 1
#endif
#ifndef MK_F8_INFROM
#define MK_F8_INFROM 2
#endif
static_assert(R_HME + (size_t)MAXROWS * FE * 2 <= 608 * MiB, "moe hidden fits");
static_assert((size_t)MAXROWS * 2048 == 132 * MiB, "xg size");

constexpr int RING_BYTES = 131072;
constexpr int MISC_OFF = RING_BYTES;
constexpr int LDS_BYTES = 147456;
constexpr int NWAVES = 8, NTHR = 512;

typedef __bf16 bf16x2_t __attribute__((ext_vector_type(2)));
__device__ __forceinline__ unsigned cvt_pk_bf16(float lo, float hi) { f32x2 v = {lo, hi}; bf16x2_t b = __builtin_convertvector(v, bf16x2_t); return __builtin_bit_cast(unsigned, b); }
__device__ __forceinline__ float bf2f(unsigned short b) { return __uint_as_float(((unsigned)b) << 16); }
__device__ __forceinline__ float bflo(unsigned w) { return __uint_as_float(w << 16); }
__device__ __forceinline__ float bfhi(unsigned w) { return __uint_as_float(w & 0xffff0000u); }
__device__ __forceinline__ u32x4 pack8(f32x4 a, f32x4 b) { u32x4 w; w.x = cvt_pk_bf16(a[0], a[1]); w.y = cvt_pk_bf16(a[2], a[3]); w.z = cvt_pk_bf16(b[0], b[1]); w.w = cvt_pk_bf16(b[2], b[3]); return w; }
__device__ __forceinline__ unsigned pack4_fp8(float a, float b, float c, float d) {
    a = __builtin_amdgcn_fmed3f(a, -448.f, 448.f); b = __builtin_amdgcn_fmed3f(b, -448.f, 448.f); c = __builtin_amdgcn_fmed3f(c, -448.f, 448.f); d = __builtin_amdgcn_fmed3f(d, -448.f, 448.f);
    int w = 0; w = __builtin_amdgcn_cvt_pk_fp8_f32(a, b, w, false); w = __builtin_amdgcn_cvt_pk_fp8_f32(c, d, w, true); return (unsigned)w; }
__device__ __forceinline__ float fast_exp2(float x) { return __builtin_amdgcn_exp2f(x); }
__device__ __forceinline__ float fast_rcp(float x) { return __builtin_amdgcn_rcpf(x); }
#if MK_CHECK == 36
__device__ __forceinline__ float sigmoidf_(float z) { return 1.0f / (1.0f + expf(-z)); }
#else
__device__ __forceinline__ float sigmoidf_(float z) { return fast_rcp(1.0f + fast_exp2(-z * LOG2E)); }
#endif
__device__ __forceinline__ float gelu_tanh(float x) { const float u = 0.7978845608028654f * (x + 0.044715f * x * x * x); return x * fast_rcp(1.0f + fast_exp2(-2.0f * LOG2E * u)); }
template <int CTRL> __device__ __forceinline__ float dppf(float v) { return __int_as_float(__builtin_amdgcn_update_dpp(0, __float_as_int(v), CTRL, 0xf, 0xf, true)); }
template <int CTRL> __device__ __forceinline__ int dppi(int v) { return __builtin_amdgcn_update_dpp(0, v, CTRL, 0xf, 0xf, true); }
__device__ __forceinline__ float sum_x16(float v) { auto r = __builtin_amdgcn_permlane16_swap(__float_as_uint(v), __float_as_uint(v), false, false); return __uint_as_float(r[0]) + __uint_as_float(r[1]); }
__device__ __forceinline__ float sum_x32(float v) { auto r = __builtin_amdgcn_permlane32_swap(__float_as_uint(v), __float_as_uint(v), false, false); return __uint_as_float(r[0]) + __uint_as_float(r[1]); }
__device__ __forceinline__ int isum_x16(int v) { auto r = __builtin_amdgcn_permlane16_swap((unsigned)v, (unsigned)v, false, false); return (int)(r[0] + r[1]); }
__device__ __forceinline__ int isum_x32(int v) { auto r = __builtin_amdgcn_permlane32_swap((unsigned)v, (unsigned)v, false, false); return (int)(r[0] + r[1]); }
__device__ __forceinline__ float wave_sum(float v) {
    v += dppf<0xB1>(v); v += dppf<0x4E>(v); v += dppf<0x141>(v); v += dppf<0x140>(v); v = sum_x16(v); return sum_x32(v);
}
__device__ __forceinline__ int wave_isum(int v) {
    v += dppi<0xB1>(v); v += dppi<0x4E>(v); v += dppi<0x141>(v); v += dppi<0x140>(v); v = isum_x16(v); return isum_x32(v);
}
__device__ __forceinline__ int opaque_tid() { int t = threadIdx.x; asm volatile("" : "+v"(t)); return t; }
#define LDS_WAIT() asm volatile("s_waitcnt lgkmcnt(0)" ::: "memory")
#define VM_WAIT() asm volatile("s_waitcnt vmcnt(0)" ::: "memory")

__device__ __forceinline__ size_t km_addr(int bh, int tile, int chunk, int kv) { return ((((size_t)bh * 128 + tile) * 24 + chunk) * 64 + kv) * 8; }
__device__ __forceinline__ size_t k12_addr(int bh, int tile, int map, int chunk, int kv) { return (((((size_t)bh * 128 + tile) * 2 + map) * 8 + chunk) * 64 + kv) * 8; }
__device__ __forceinline__ size_t vimg_addr(int bh, int tile, int dblk, int kv) { return ((((size_t)bh * 128 + tile) * 4 + dblk) * 64 + kv) * 32; }

#define XB_TMO      128
#define XB_XCNT(j)  (256  + 64 * (j))
#define XB_XSUB(j)  (1280 + 64 * (j))
#define XB_XGEN(j)  (2304 + 64 * (j))
#define XB_TOP      3328
#define XB_TOPGEN   3392
#define XCD_BAR_WORDS 3456
#define XB_SPIN_CAP (1u << 20)

__device__ __forceinline__ unsigned xb_ld(unsigned* p)              { return __hip_atomic_load(p, __ATOMIC_RELAXED, __HIP_MEMORY_SCOPE_AGENT); }
__device__ __forceinline__ unsigned xb_add(unsigned* p, unsigned v) { return __hip_atomic_fetch_add(p, v, __ATOMIC_RELAXED, __HIP_MEMORY_SCOPE_AGENT); }
__device__ __forceinline__ unsigned xb_xcc_id() { return (unsigned)__builtin_amdgcn_s_getreg((3 << 11) | 20) & 0xFu; }
#define XB_SPIN(cond, bar) do { unsigned _sp = 0; while (cond) { __builtin_amdgcn_s_sleep(1); \
    if ((++_sp & 255u) == 0u) { if (xb_ld(&(bar)[XB_TMO])) break; if (_sp > XB_SPIN_CAP) { atomicAdd(&(bar)[XB_TMO], 1u); break; } } } } while (0)

struct XcdBarrier { unsigned* bar; unsigned x; volatile LAS unsigned* st; };

__device__ __forceinline__ XcdBarrier xcd_barrier_post(unsigned* bar, volatile LAS unsigned* st) {
    XcdBarrier b; b.bar = bar; b.x = xb_xcc_id(); b.st = st;
    if (threadIdx.x == 0) (void)xb_add(&bar[XB_XCNT(b.x)], 1u);
    return b;
}
__device__ __forceinline__ void xcd_barrier_complete(unsigned* bar, unsigned x, unsigned& nloc, unsigned& nx) {
    const unsigned G = gridDim.x * gridDim.y * gridDim.z;
    unsigned sum, cnt, mine, sp = 0u;
    for (;;) {
        sum = 0u; cnt = 0u; mine = 0u;
#pragma unroll
        for (unsigned j = 0; j < 16; ++j) { const unsigned c = xb_ld(&bar[XB_XCNT(j)]); sum += c; cnt += (c > 0u) ? 1u : 0u; mine = (j == x) ? c : mine; }
        if (sum == G) break;
        __builtin_amdgcn_s_sleep(1);
        if ((++sp & 255u) == 0u) { if (xb_ld(&bar[XB_TMO])) break; if (sp > XB_SPIN_CAP) { atomicAdd(&bar[XB_TMO], 1u); break; } }
    }
    nloc = mine > 0u ? mine : 1u; nx = cnt > 0u ? cnt : 1u;
}
__device__ __forceinline__ void xcd_barrier(const XcdBarrier& b) {
    asm volatile("s_waitcnt vmcnt(0)" ::: "memory");
    __syncthreads();
    if (threadIdx.x == 0) {
        unsigned* bar = b.bar;
        __builtin_amdgcn_s_waitcnt(0);
        unsigned nloc = b.st[0], nx = b.st[1];
        if (nloc == 0u) { xcd_barrier_complete(bar, b.x, nloc, nx); b.st[0] = nloc; b.st[1] = nx; }
        const unsigned old = xb_add(&bar[XB_XSUB(b.x)], 1u);
        const unsigned gen = old / nloc;
        if (old + 1u == (gen + 1u) * nloc) {
            __builtin_amdgcn_fence(__ATOMIC_RELEASE, "agent");
            asm volatile("s_waitcnt vmcnt(0)" ::: "memory");
            const unsigned og = xb_add(&bar[XB_TOP], 1u);
            const unsigned tg = og / nx;
            if (og + 1u == (tg + 1u) * nx) xb_add(&bar[XB_TOPGEN], 1u);
            else XB_SPIN(xb_ld(&bar[XB_TOPGEN]) == tg, bar);
            __builtin_amdgcn_fence(__ATOMIC_ACQUIRE, "agent");
            xb_add(&bar[XB_XGEN(b.x)], 1u);
            asm volatile("s_waitcnt vmcnt(0)" ::: "memory");
        } else {
            XB_SPIN(xb_ld(&bar[XB_XGEN(b.x)]) == gen, bar);
            __builtin_amdgcn_fence(__ATOMIC_ACQUIRE, "agent");
            asm volatile("s_waitcnt vmcnt(0)" ::: "memory");
        }
    }
    __syncthreads();
}
namespace pg8 {
constexpr int BM = 256, BK = 64, HALF = 128, HTB = HALF * BK * 2, STAGE_BYTES = 8 * HTB, NXCD = 8, WGM = 8;
__host__ __device__ __forceinline__ int lds_byte(int r, int c) { const int st = (r >> 4) * 2 + (c >> 5), rr = r & 15, cc = c & 31, ob = rr * 64 + cc * 2; return st * 1024 + (ob ^ (((ob >> 9) & 1) << 5)); }
__host__ __device__ __forceinline__ void stage_rc(int b, int& R, int& C) { const int st = b / 1024, sb = b % 1024, swz = sb ^ (((sb >> 9) & 1) << 5); R = (st >> 1) * 16 + swz / 64; C = (st & 1) * 32 + (swz % 64) / 2; }
__host__ __device__ __forceinline__ int perm32(int rho) { const int n = rho >> 4, i = rho & 15; return 8 * (i >> 2) + 4 * n + (i & 3); }

struct Unit { int pm, pn, aux; const char* a; const char* b; };
struct Gemm { int K; int lda, ldb; int wsc; };

__device__ __forceinline__ void tile_of(int wgid, int nM, int nN, int& pm, int& pn) {
    const int nwg = nM * nN;
    { const int q = nwg / NXCD, r = nwg % NXCD, xcd = wgid % NXCD, off = wgid / NXCD; wgid = (xcd < r ? xcd * (q + 1) : r * (q + 1) + (xcd - r) * q) + off; }
    const int nig = WGM * nN, gid = wgid / nig, fm = gid * WGM, gsz = (nM - fm) < WGM ? (nM - fm) : WGM;
    pm = fm + ((wgid % nig) % gsz); pn = (wgid % nig) / gsz;
}

template <class Epi, class Sched, bool ALIGN_EPI = true, bool F8 = false>
__device__ __forceinline__ void gemm_phase(LAS unsigned char* lds, const Gemm g, const Sched& S, const Epi& E) {
    const int tid = opaque_tid(), wid = __builtin_amdgcn_readfirstlane(tid >> 6), lane = tid & 63, wr = wid >> 2, wc = wid & 3, fr = lane & 15, fq = lane >> 4;
    const int K = g.K, nt = K / BK;
    unsigned voffA[2], voffB[2];
#pragma unroll
    for (int i = 0; i < 2; ++i) { int R, C; stage_rc(tid * 16 + i * 8192, R, C); const int Rb = Epi::PERM ? ((R & ~31) + perm32(R & 31)) : R;
        voffA[i] = (unsigned)(R * g.lda + C) * 2u; voffB[i] = (unsigned)(Rb * g.ldb + C) * 2u; }
    constexpr bool GA = Sched::GATHER;
    unsigned vgc[2][2] = {{0u, 0u}, {0u, 0u}}, vgn[2][2] = {{0u, 0u}, {0u, 0u}};
    const size_t kstep = (size_t)(BK * 2);
    const size_t hstepA = (size_t)HALF * g.lda * 2, hstepB = (size_t)HALF * g.ldb * 2;
    const unsigned ldsw = (unsigned)wid * 1024u;
    const int aoff = lds_byte(wr * 64 + fr, fq * 8), boff = lds_byte(wc * 32 + fr, fq * 8);
#define PG8_SA(b, h) (((b) * 2 + (h)) * HTB)
#define PG8_SB(b, h) ((4 + (b) * 2 + (h)) * HTB)
#define PG8_STAGE(bufoff, gbase, voff) do { _Pragma("unroll") for (int _i = 0; _i < 2; ++_i) \
        __builtin_amdgcn_global_load_lds((const unsigned*)((const char*)(gbase) + (voff)[_i]), (LAS unsigned*)(lds + (bufoff) + ldsw + _i * 8192), 16, 0, 0); } while (0)
#define PG8_STAGE_O(bufoff, gbase, o0, o1) do { \
        __builtin_amdgcn_global_load_lds((const unsigned*)((const char*)(gbase) + (o0)), (LAS unsigned*)(lds + (bufoff) + ldsw), 16, 0, 0); \
        __builtin_amdgcn_global_load_lds((const unsigned*)((const char*)(gbase) + (o1)), (LAS unsigned*)(lds + (bufoff) + ldsw + 8192), 16, 0, 0); } while (0)
#define PG8_STAGE_A(bufoff, gbase, h) do { if constexpr (GA) { PG8_STAGE_O(bufoff, gbase, vgc[h][0], vgc[h][1]); } else { PG8_STAGE(bufoff, (gbase) + (h) * hstepA, voffA); } } while (0)
#define PG8_LD8(p) __builtin_shufflevector(*(const LAS i32x4*)(p), *(const LAS i32x4*)((p) + 1024), 0, 1, 2, 3, 4, 5, 6, 7)
#define PG8_LDA(dst, b, h) do { if constexpr (F8) { _Pragma("unroll") for (int m = 0; m < 4; ++m) dst##8[m] = PG8_LD8(lds + PG8_SA(b, h) + aoff + m * 2048); } \
        else { _Pragma("unroll") for (int m = 0; m < 4; ++m) _Pragma("unroll") for (int k = 0; k < 2; ++k) dst[m][k] = *(const LAS bf16x8*)(lds + PG8_SA(b, h) + aoff + m * 2048 + k * 1024); } } while (0)
#define PG8_LDB(dst, b, h) do { if constexpr (F8) { _Pragma("unroll") for (int n = 0; n < 2; ++n) dst##8[n] = PG8_LD8(lds + PG8_SB(b, h) + boff + n * 2048); } \
        else { _Pragma("unroll") for (int n = 0; n < 2; ++n) _Pragma("unroll") for (int k = 0; k < 2; ++k) dst[n][k] = *(const LAS bf16x8*)(lds + PG8_SB(b, h) + boff + n * 2048 + k * 1024); } } while (0)
#define PG8_CAT(x) __builtin_shufflevector(__builtin_bit_cast(i32x4, x[0]), __builtin_bit_cast(i32x4, x[1]), 0, 1, 2, 3, 4, 5, 6, 7)
#define PG8_MMA(ai, bj, At, Bt) do { __builtin_amdgcn_s_setprio(1); \
        if constexpr (F8) { _Pragma("unroll") for (int m = 0; m < 4; ++m) _Pragma("unroll") for (int n = 0; n < 2; ++n) \
            asm volatile("v_mfma_scale_f32_16x16x128_f8f6f4 %0, %1, %2, %0, %3, %4 op_sel_hi:[0,0,0]" : "+v"(acc[ai][bj][m][n]) : "v"(Bt##8[n]), "v"(At##8[m]), "v"(wsc_v), "v"(one_v)); } \
        else { _Pragma("unroll") for (int m = 0; m < 4; ++m) _Pragma("unroll") for (int n = 0; n < 2; ++n) _Pragma("unroll") for (int k = 0; k < 2; ++k) \
            acc[ai][bj][m][n] = __builtin_amdgcn_mfma_f32_16x16x32_bf16(Bt[n][k], At[m][k], acc[ai][bj][m][n], 0, 0, 0); } \
        __builtin_amdgcn_s_setprio(0); } while (0)
#define PG8_WAIT_V(n) asm volatile("s_waitcnt vmcnt(" #n ")" ::: "memory")
#define PG8_WAIT_L(n) asm volatile("s_waitcnt lgkmcnt(" #n ")" ::: "memory")
#define PG8_BAR __builtin_amdgcn_s_barrier()
#define PG8_SCHED __builtin_amdgcn_sched_barrier(0)
    Unit cur, nxt; int ui = 0;
    if (!S.next(0, cur)) return;
#ifndef MK_STAGGER
#define MK_STAGGER 0
#endif
    if (MK_STAGGER && ((S.c >> 3) & 1)) {
        const unsigned long long t0 = __builtin_amdgcn_s_memrealtime(), dl = (unsigned long long)(nt * 65);
        while (__builtin_amdgcn_s_memrealtime() - t0 < dl) __builtin_amdgcn_s_sleep(8);
    }
    f32x4 acc[2][2][4][2];
#pragma unroll
    for (int a = 0; a < 2; ++a)
#pragma unroll
        for (int b = 0; b < 2; ++b)
#pragma unroll
            for (int m = 0; m < 4; ++m)
#pragma unroll
                for (int n = 0; n < 2; ++n) acc[a][b][m][n] = (f32x4){0.f, 0.f, 0.f, 0.f};
    const int wsc_v = g.wsc, one_v = 127;
    bf16x8 At[4][2], B0[2][2], B1[2][2]; i32x8 At8[4], B08[2], B18[2];
    const char* cA = cur.a; const char* cB = cur.b;
    if constexpr (GA) {
#pragma unroll
        for (int h = 0; h < 2; ++h)
#pragma unroll
            for (int i = 0; i < 2; ++i) { int R, C; stage_rc(tid * 16 + i * 8192, R, C); vgc[h][i] = (unsigned)S.gidx[cur.pm * BM + h * HALF + R] * (unsigned)(g.lda * 2) + (unsigned)(C * 2); }
    }
    PG8_STAGE(PG8_SB(0, 0), cB, voffB); PG8_STAGE(PG8_SB(0, 1), cB + hstepB, voffB); PG8_STAGE_A(PG8_SA(0, 0), cA, 0); PG8_STAGE_A(PG8_SA(0, 1), cA, 1);
    if (wr == 1) PG8_BAR;
    PG8_WAIT_V(2); PG8_BAR;
    PG8_STAGE(PG8_SB(1, 0), cB + kstep, voffB); PG8_STAGE_A(PG8_SA(1, 0), cA + kstep, 0); PG8_STAGE(PG8_SB(1, 1), cB + hstepB + kstep, voffB);
    PG8_WAIT_V(6); PG8_BAR;
    for (;;) {
        const bool has_next = S.next(ui + 1, nxt);
        const char* nA = has_next ? nxt.a : cA; const char* nB = has_next ? nxt.b : cB;
        if constexpr (GA) { if (has_next) {
#pragma unroll
            for (int h = 0; h < 2; ++h)
#pragma unroll
                for (int i = 0; i < 2; ++i) { int R, C; stage_rc(tid * 16 + i * 8192, R, C); const int* ip = S.gidx + (nxt.pm * BM + h * HALF + R);
                    asm volatile("global_load_dword %0, %1, off" : "=v"(vgn[h][i]) : "v"(ip) : "memory"); } } }
#pragma nounroll
        for (int t = 0; t < nt; t += 2) {
            const bool last = (t == nt - 2);
            const char* a1 = cA + (size_t)(t + 1) * kstep;
            const char* a2 = last ? nA : cA + (size_t)(t + 2) * kstep; const char* b2 = last ? nB : cB + (size_t)(t + 2) * kstep;
            const char* a3 = a2 + kstep; const char* b3 = b2 + kstep;
            PG8_LDB(B0, 0, 0); PG8_LDB(B1, 0, 1); PG8_SCHED; PG8_LDA(At, 0, 0); PG8_STAGE_A(PG8_SA(1, 1), a1, 1);
            PG8_WAIT_V(8); PG8_WAIT_L(0); PG8_BAR; PG8_MMA(0, 0, At, B0); PG8_MMA(0, 1, At, B1); PG8_BAR; PG8_SCHED;
            if constexpr (GA) { if (last && has_next) {
#pragma unroll
                for (int h = 0; h < 2; ++h)
#pragma unroll
                    for (int i = 0; i < 2; ++i) { int R, C; stage_rc(tid * 16 + i * 8192, R, C); unsigned r_ = vgn[h][i]; asm volatile("" : "+v"(r_)); vgc[h][i] = r_ * (unsigned)(g.lda * 2) + (unsigned)(C * 2); } }
              PG8_SCHED; }
            PG8_LDA(At, 0, 1); PG8_STAGE(PG8_SB(0, 0), b2, voffB); PG8_STAGE(PG8_SB(0, 1), b2 + hstepB, voffB); PG8_STAGE_A(PG8_SA(0, 0), a2, 0);
            PG8_WAIT_V(8); PG8_WAIT_L(0); PG8_BAR; PG8_MMA(1, 0, At, B0); PG8_MMA(1, 1, At, B1); PG8_BAR; PG8_SCHED;
            PG8_LDB(B0, 1, 0); PG8_LDB(B1, 1, 1); PG8_SCHED; PG8_LDA(At, 1, 0); PG8_STAGE_A(PG8_SA(0, 1), a2, 1);
            PG8_WAIT_V(8); PG8_WAIT_L(0); PG8_BAR; PG8_MMA(0, 0, At, B0); PG8_MMA(0, 1, At, B1); PG8_BAR; PG8_SCHED;
            PG8_LDA(At, 1, 1); PG8_STAGE(PG8_SB(1, 0), b3, voffB); PG8_STAGE(PG8_SB(1, 1), b3 + hstepB, voffB); PG8_STAGE_A(PG8_SA(1, 0), a3, 0);
            PG8_WAIT_V(8); PG8_WAIT_L(0); PG8_BAR; PG8_MMA(1, 0, At, B0); PG8_MMA(1, 1, At, B1); PG8_BAR; PG8_SCHED;
        }
        if constexpr (F8) asm volatile("s_nop 15\n\ts_nop 7" ::: "memory");
        if constexpr (ALIGN_EPI) { if (wr == 0) PG8_BAR; }
        { int fr_ = fr, fq_ = fq; asm volatile("" : "+v"(fr_), "+v"(fq_));
          E(acc, cur, wr, wc, fr_, fq_); }
        if (!has_next) break;
#pragma unroll
        for (int a = 0; a < 2; ++a)
#pragma unroll
            for (int b = 0; b < 2; ++b)
#pragma unroll
                for (int m = 0; m < 4; ++m)
#pragma unroll
                    for (int n = 0; n < 2; ++n) acc[a][b][m][n] = (f32x4){0.f, 0.f, 0.f, 0.f};
        cur = nxt; cA = nA; cB = nB; ++ui;
        if constexpr (ALIGN_EPI) { if (wr == 1) PG8_BAR; }
    }
    PG8_WAIT_V(0);
    if constexpr (!ALIGN_EPI) { if (wr == 0) PG8_BAR; }
    PG8_BAR;
#undef PG8_SA
#undef PG8_SB
#undef PG8_STAGE
#undef PG8_STAGE_O
#undef PG8_STAGE_A
#undef PG8_LD8
#undef PG8_LDA
#undef PG8_LDB
#undef PG8_MMA
#undef PG8_CAT
#undef PG8_WAIT_V
#undef PG8_WAIT_L
#undef PG8_BAR
#undef PG8_SCHED
}

struct SchedDense {
    static constexpr bool GATHER = false;
    int nM, nN, G, c; const char* A; const char* B; size_t astep, bstep;
    int pnoff = 0;
    __device__ __forceinline__ bool next(int i, Unit& u) const {
        const long L = (long)i * G + c; if (L >= (long)nM * nN) return false;
        tile_of((int)L, nM, nN, u.pm, u.pn); u.pn += pnoff; u.aux = 0; u.a = A + (size_t)u.pm * astep; u.b = B + (size_t)u.pn * bstep; return true;
    }
};
struct SchedBranch {
    static constexpr bool GATHER = false;
    int nM, nN, G, c; const char* A; const char* B; size_t astep, bstep, asub, bsub;
    __device__ __forceinline__ bool next(int i, Unit& u) const {
        const int n = i % 3; const long L = (long)(i / 3) * G + c; if (L >= (long)nM * nN) return false;
        tile_of((int)L, nM, nN, u.pm, u.pn); u.aux = n; u.a = A + (size_t)u.pm * astep + (size_t)n * asub; u.b = B + (size_t)u.pn * bstep + (size_t)n * bsub; return true;
    }
};
struct SchedMoe {
    static constexpr bool GATHER = false;
    int nM, nN, G, c; const char* A; const char* B; size_t astep, bstep, bexp; int ts[9];
    __device__ __forceinline__ bool next(int i, Unit& u) const {
        const long L = (long)i * G + c; if (L >= (long)nM * nN) return false;
        tile_of((int)L, nM, nN, u.pm, u.pn); int e = 0;
#pragma unroll
        for (int j = 1; j < 8; ++j) e += (u.pm >= ts[j]) ? 1 : 0;
        u.aux = e; u.a = A + (size_t)u.pm * astep; u.b = B + (size_t)e * bexp + (size_t)u.pn * bstep; return true;
    }
};
struct SchedMoeG : SchedMoe {
    static constexpr bool GATHER = true; const int* gidx;
    __device__ __forceinline__ bool next(int i, Unit& u) const { if (!SchedMoe::next(i, u)) return false; u.a = A; return true; }
};
}
namespace pg8 {
#define EPI_ARGS const f32x4 (&acc)[2][2][4][2], const Unit& u, int wr, int wc, int fr, int fq
#define EPI_FOR_AI_M _Pragma("unroll") for (int ai = 0; ai < 2; ++ai) _Pragma("unroll") for (int m = 0; m < 4; ++m)
#define EPI_FOR_BJ _Pragma("unroll") for (int bj = 0; bj < 2; ++bj)
__device__ __forceinline__ void st16(void* base, unsigned off, u32x4 v) { *(u32x4*)((unsigned char*)base + off) = v; }
__device__ __forceinline__ u32x4 ld16(const void* base, unsigned off) { return *(const u32x4*)((const unsigned char*)base + off); }
__device__ __forceinline__ f32x4 ld16f(const void* base, unsigned off) { return *(const f32x4*)((const unsigned char*)base + off); }

__device__ __forceinline__ void rope4(f32x4& x1, f32x4& x2, const float* rc, const float* rs, unsigned toff) {
    const f32x4 c = ld16f(rc, toff), s = ld16f(rs, toff);
    const f32x4 o1 = x1 * c - x2 * s, o2 = x2 * c + x1 * s; x1 = o1; x2 = o2;
}

struct EpiInproj {
    static constexpr bool PERM = true;
    unsigned char* R; float *cqp, *ckvp; const float* bgate; const float* rc; const float* rs;
    __device__ __forceinline__ void operator()(EPI_ARGS) const {
        const int pn = u.pn; const unsigned rl = (unsigned)(wr * 64 + fr), row0 = (unsigned)(u.pm * BM) + rl, c0 = (unsigned)(wc * 32 + 8 * fq);
        const unsigned b = (unsigned)(u.pm * BM) >> 13, t0 = ((unsigned)(u.pm * BM) & (SEQ - 1)) >> 6;
        if (pn < 4) {
            unsigned char* P = R + R_UV; const unsigned o0 = (row0 * 1024u + (unsigned)pn * 256u + c0) * 2u;
            EPI_FOR_AI_M { EPI_FOR_BJ { f32x4 v0 = acc[ai][bj][m][0], v1 = acc[ai][bj][m][1];
#pragma unroll
                    for (int j = 0; j < 4; ++j) { v0[j] = gelu_tanh(v0[j]); v1[j] = gelu_tanh(v1[j]); }
                    st16(P, o0 + (unsigned)((ai * HALF + m * 16) * 1024 + bj * HALF) * 2u, pack8(v0, v1)); } }
        } else if (pn == 4) {
            unsigned char* P = R + R_CQ; const unsigned o0 = (row0 * 256u + c0) * 2u;
            EPI_FOR_AI_M { float ss = 0.f;
                EPI_FOR_BJ { const f32x4 v0 = acc[ai][bj][m][0], v1 = acc[ai][bj][m][1];
                    ss += (v0[0] * v0[0] + v0[1] * v0[1]) + (v0[2] * v0[2] + v0[3] * v0[3]) + (v1[0] * v1[0] + v1[1] * v1[1]) + (v1[2] * v1[2] + v1[3] * v1[3]);
                    st16(P, o0 + (unsigned)((ai * HALF + m * 16) * 256 + bj * HALF) * 2u, pack8(v0, v1)); }
                ss = sum_x32(sum_x16(ss));
                if (fq == 0) cqp[(row0 + ai * HALF + m * 16) * 4u + wc] = ss; }
        } else if (pn == 5) {
            unsigned char* P = R + R_CKV; const unsigned o0 = (row0 * 256u + c0) * 2u;
            unsigned char* KMp = R + R_KM; const unsigned g8 = 4u * wc + fq;
            const unsigned ko0 = ((((b * 4u) * 128u + t0 + wr) * 24u + 16u + g8) * 64u + (unsigned)fr) * 16u;
            const unsigned to0 = ((row0 & (SEQ - 1)) * 32u + 4u * g8) * 4u;
            EPI_FOR_AI_M {
                const f32x4 a0 = acc[ai][0][m][0], a1 = acc[ai][0][m][1];
                float ss = (a0[0] * a0[0] + a0[1] * a0[1]) + (a0[2] * a0[2] + a0[3] * a0[3]) + (a1[0] * a1[0] + a1[1] * a1[1]) + (a1[2] * a1[2] + a1[3] * a1[3]);
                st16(P, o0 + (unsigned)((ai * HALF + m * 16) * 256) * 2u, pack8(a0, a1));
                ss = sum_x32(sum_x16(ss));
                if (fq == 0) ckvp[(row0 + ai * HALF + m * 16) * 4u + wc] = ss;
                f32x4 x1 = acc[ai][1][m][0], x2 = acc[ai][1][m][1];
                st16(P, o0 + (unsigned)((ai * HALF + m * 16) * 256 + HALF) * 2u, pack8(x1, x2));
                if (wc < 2) {
                    rope4(x1, x2, rc, rs, to0 + (unsigned)((ai * HALF + m * 16) * 32) * 4u);
                    const u32x4 w = pack8(x1, x2);
#pragma unroll
                    for (int h = 0; h < 4; ++h) st16(KMp, ko0 + (unsigned)(h * 128 * 24 * 1024 + ai * 2 * 24 * 1024 + m * 16 * 16), w); } }
        } else if (pn < 8) {
            unsigned char* P = R + R_DQ; const unsigned o0 = (row0 * 512u + (unsigned)(pn - 6) * 256u + c0) * 2u;
            EPI_FOR_AI_M { EPI_FOR_BJ { st16(P, o0 + (unsigned)((ai * HALF + m * 16) * 512 + bj * HALF) * 2u, pack8(acc[ai][bj][m][0] * QS_DIF, acc[ai][bj][m][1] * QS_DIF)); } }
        } else if (pn < 10) {
            unsigned char* P = R + R_K12;
            const unsigned o0 = ((((((b * 4u + 2u * (unsigned)(pn - 8)) * 128u + t0 + wr) * 2u + (unsigned)(wc >> 1)) * 8u + (unsigned)(4 * (wc & 1) + fq)) * 64u + (unsigned)fr) * 16u);
            EPI_FOR_AI_M { EPI_FOR_BJ { st16(P, o0 + (unsigned)(bj * 128 * 16384 + ai * 2 * 16384 + m * 16 * 16), pack8(acc[ai][bj][m][0], acc[ai][bj][m][1])); } }
        } else if (pn < 12) {
            unsigned char* P = R + R_VD;
            const unsigned o0 = (((((b * 4u + 2u * (unsigned)(pn - 10)) * 128u + t0 + wr) * 4u + (unsigned)wc) * 64u + (unsigned)fr) * 32u + 8u * fq) * 2u;
            EPI_FOR_AI_M { EPI_FOR_BJ { st16(P, o0 + (unsigned)(bj * 128 * 16384 + ai * 2 * 16384 + m * 16 * 64), pack8(acc[ai][bj][m][0], acc[ai][bj][m][1])); } }
        } else {
            unsigned char* P = R + R_G; const unsigned gc0 = (unsigned)(pn - 12) * 256u + c0, o0 = (row0 * 3072u + gc0) * 2u;
            f32x4 bv[2][2];
            EPI_FOR_BJ { bv[bj][0] = ld16f(bgate, (gc0 + bj * HALF) * 4u); bv[bj][1] = ld16f(bgate, (gc0 + bj * HALF + 4) * 4u); }
            EPI_FOR_AI_M { EPI_FOR_BJ { f32x4 v0 = acc[ai][bj][m][0] + bv[bj][0], v1 = acc[ai][bj][m][1] + bv[bj][1];
#pragma unroll
                    for (int j = 0; j < 4; ++j) { v0[j] = sigmoidf_(v0[j]); v1[j] = sigmoidf_(v1[j]); }
#if MK_G8
                    u32x2 w8; w8.x = 0u; w8.y = 0u;
#pragma unroll
                    for (int j = 0; j < 4; ++j) { w8.x = __builtin_amdgcn_cvt_pk_u8_f32(fminf(v0[j] * 256.0f + 0.5f, 255.0f), (unsigned)j, w8.x); w8.y = __builtin_amdgcn_cvt_pk_u8_f32(fminf(v1[j] * 256.0f + 0.5f, 255.0f), (unsigned)j, w8.y); }
                    *(u32x2*)(P + (o0 >> 1) + (unsigned)((ai * HALF + m * 16) * 3072 + bj * HALF)) = w8; } }
#else
                    st16(P, o0 + (unsigned)((ai * HALF + m * 16) * 3072 + bj * HALF) * 2u, pack8(v0, v1)); } }
#endif
        }
    }
};

struct EpiQ {
    static constexpr bool PERM = true;
    bf16_t* QM; const float* cqp; const float* rc; const float* rs;
    __device__ __forceinline__ void operator()(EPI_ARGS) const {
        const unsigned row0 = (unsigned)(u.pm * BM + wr * 64 + fr), c0 = (unsigned)(u.pn * 256 + wc * 32 + 8 * fq);
        float sc[2][4];
        EPI_FOR_AI_M { const f32x4 p = ld16f(cqp, (row0 + ai * HALF + m * 16) * 16u);
            sc[ai][m] = __builtin_amdgcn_rsqf(((p[0] + p[1]) + (p[2] + p[3])) * (1.0f / 256.0f) + EPS) * QS_MLA; }
        const unsigned o0 = (row0 * 768u + c0) * 2u, tp0 = (row0 & (SEQ - 1)) * 128u;
        EPI_FOR_AI_M { EPI_FOR_BJ { const unsigned col = c0 + bj * HALF, w = col % 192u;
                f32x4 v0 = acc[ai][bj][m][0] * sc[ai][m], v1 = acc[ai][bj][m][1] * sc[ai][m];
                if (w >= 128u) rope4(v0, v1, rc, rs, tp0 + (unsigned)((ai * HALF + m * 16) * 128) + ((w - 128u) >> 1) * 4u);
                st16(QM, o0 + (unsigned)((ai * HALF + m * 16) * 768 + bj * HALF) * 2u, pack8(v0, v1)); } }
    }
};
struct EpiKV {
    static constexpr bool PERM = true;
    bf16_t *KM, *VM; const float* ckvp;
    __device__ __forceinline__ void operator()(EPI_ARGS) const {
        const unsigned row0 = (unsigned)(u.pm * BM + wr * 64 + fr), h = (unsigned)u.pn;
        float sc[2][4];
        EPI_FOR_AI_M { const f32x4 p = ld16f(ckvp, (row0 + ai * HALF + m * 16) * 16u);
            sc[ai][m] = __builtin_amdgcn_rsqf(((p[0] + p[1]) + (p[2] + p[3])) * (1.0f / 128.0f) + EPS); }
        const unsigned b = (unsigned)(u.pm * BM) >> 13, t0 = ((unsigned)(u.pm * BM) & (SEQ - 1)) >> 6;
        const unsigned tb = (b * 4u + h) * 128u + t0 + wr;
        const unsigned ko0 = ((tb * 24u + (unsigned)(4 * wc + fq)) * 64u + (unsigned)fr) * 16u;
        const unsigned vo0 = (((tb * 4u + (unsigned)wc) * 64u + (unsigned)fr) * 32u + 8u * fq) * 2u;
        EPI_FOR_AI_M {
            st16(KM, ko0 + (unsigned)(ai * 2 * 24 * 1024 + m * 16 * 16), pack8(acc[ai][0][m][0] * sc[ai][m], acc[ai][0][m][1] * sc[ai][m]));
            st16(VM, vo0 + (unsigned)(ai * 2 * 16384 + m * 16 * 64), pack8(acc[ai][1][m][0] * sc[ai][m], acc[ai][1][m][1] * sc[ai][m])); }
    }
};
template <int N> __device__ __forceinline__ float ubf(unsigned x) { return (float)((x >> (8 * N)) & 0xffu); }
struct EpiBranch {
    static constexpr bool PERM = true;
    bf16_t* MG; const bf16_t* G; unsigned char* scr;
    template <int n>
    __device__ __forceinline__ void run(EPI_ARGS) const {
        constexpr bool LAST = (n == 2);
        const unsigned row0 = (unsigned)(u.pm * BM + wr * 64 + fr), c0 = (unsigned)(u.pn * 256 + wc * 32 + 8 * fq);
        const unsigned go0 = (row0 * 3072u + (unsigned)n * 1024u + c0) * (MK_G8 ? 1u : 2u), mo0 = (row0 * 1024u + c0) * 2u;
        const unsigned so0 = (unsigned)(((wr * 4 + wc) * 64 + fq * 16 + fr) * 16);
#pragma unroll
        for (int ai = 0; ai < 2; ++ai)
#pragma unroll
            for (int m = 0; m < 4; ++m) {
                u32x4 gw[2], ow[2]; const int rr = ai * HALF + m * 16;
#pragma unroll
                for (int bj = 0; bj < 2; ++bj) {
#if MK_G8
                    { const u32x2 g8 = *(const u32x2*)((const unsigned char*)G + go0 + (unsigned)(rr * 3072 + bj * HALF)); gw[bj].x = g8.x; gw[bj].y = g8.y; gw[bj].z = 0u; gw[bj].w = 0u; }
#else
                    gw[bj] = ld16(G, go0 + (unsigned)(rr * 3072 + bj * HALF) * 2u);
#endif
                    ow[bj] = (n > 0) ? ld16(scr, so0 + (unsigned)(((ai * 4 + m) * 2 + bj) * 8192)) : (u32x4){0u, 0u, 0u, 0u}; }
#pragma unroll
                for (int bj = 0; bj < 2; ++bj) {
                    const u32x4 g4 = gw[bj], o = ow[bj];
                    f32x4 v0 = acc[ai][bj][m][0], v1 = acc[ai][bj][m][1];
#if MK_G8
                    v0[0] = v0[0] * ubf<0>(g4.x) + bflo(o.x); v0[1] = v0[1] * ubf<1>(g4.x) + bfhi(o.x); v0[2] = v0[2] * ubf<2>(g4.x) + bflo(o.y); v0[3] = v0[3] * ubf<3>(g4.x) + bfhi(o.y);
                    v1[0] = v1[0] * ubf<0>(g4.y) + bflo(o.z); v1[1] = v1[1] * ubf<1>(g4.y) + bfhi(o.z); v1[2] = v1[2] * ubf<2>(g4.y) + bflo(o.w); v1[3] = v1[3] * ubf<3>(g4.y) + bfhi(o.w);
#else
                    v0[0] = v0[0] * bflo(g4.x) + bflo(o.x); v0[1] = v0[1] * bfhi(g4.x) + bfhi(o.x); v0[2] = v0[2] * bflo(g4.y) + bflo(o.y); v0[3] = v0[3] * bfhi(g4.y) + bfhi(o.y);
                    v1[0] = v1[0] * bflo(g4.z) + bflo(o.z); v1[1] = v1[1] * bfhi(g4.z) + bfhi(o.z); v1[2] = v1[2] * bflo(g4.w) + bflo(o.w); v1[3] = v1[3] * bfhi(g4.w) + bfhi(o.w);
#endif
                    if (LAST) st16(MG, mo0 + (unsigned)(rr * 1024 + bj * HALF) * 2u, pack8(v0, v1));
                    else      st16(scr, so0 + (unsigned)(((ai * 4 + m) * 2 + bj) * 8192), pack8(v0, v1)); }
            }
    }
    __device__ __forceinline__ void operator()(EPI_ARGS) const {
        if (u.aux == 0) run<0>(acc, u, wr, wc, fr, fq); else if (u.aux == 1) run<1>(acc, u, wr, wc, fr, fq); else run<2>(acc, u, wr, wc, fr, fq);
    }
};
template <bool XF32>
struct EpiResidB {
    static constexpr bool PERM = true;
    const void* xin; bf16_t* xb;
    __device__ __forceinline__ void operator()(EPI_ARGS) const {
        const unsigned e0 = (unsigned)(u.pm * BM + wr * 64 + fr) * 1024u + (unsigned)(u.pn * 256 + wc * 32 + 8 * fq);
#pragma unroll
        for (int ai = 0; ai < 2; ++ai)
#pragma unroll
            for (int mh = 0; mh < 2; ++mh) {
                f32x4 xv[2][2][2];
#pragma unroll
                for (int mm = 0; mm < 2; ++mm)
#pragma unroll
                    for (int bj = 0; bj < 2; ++bj) { const unsigned eo = e0 + (unsigned)((ai * HALF + (2 * mh + mm) * 16) * 1024 + bj * HALF);
                        if (XF32) { xv[mm][bj][0] = ld16f(xin, eo * 4u); xv[mm][bj][1] = ld16f(xin, eo * 4u + 16u); }
                        else { const u32x4 w = ld16(xin, eo * 2u); xv[mm][bj][0] = (f32x4){bflo(w.x), bfhi(w.x), bflo(w.y), bfhi(w.y)}; xv[mm][bj][1] = (f32x4){bflo(w.z), bfhi(w.z), bflo(w.w), bfhi(w.w)}; } }
#pragma unroll
                for (int mm = 0; mm < 2; ++mm)
#pragma unroll
                    for (int bj = 0; bj < 2; ++bj) { const int m = 2 * mh + mm; const unsigned eo = e0 + (unsigned)((ai * HALF + m * 16) * 1024 + bj * HALF);
                        st16(xb, eo * 2u, pack8(xv[mm][bj][0] + acc[ai][bj][m][0], xv[mm][bj][1] + acc[ai][bj][m][1])); }
            }
    }
};
struct EpiSwiglu {
    static constexpr bool PERM = true;
    bf16_t* HM; int ldh;
    __device__ __forceinline__ void operator()(EPI_ARGS) const {
        const unsigned ld2 = (unsigned)ldh * 2u, o0 = (unsigned)(u.pm * BM + wr * 64 + fr) * ld2 + (unsigned)(u.pn * 128 + wc * 32 + 8 * fq) * 2u;
        EPI_FOR_AI_M {
            f32x4 a0 = acc[ai][0][m][0], a1 = acc[ai][0][m][1]; const f32x4 b0 = acc[ai][1][m][0], b1 = acc[ai][1][m][1];
#pragma unroll
            for (int j = 0; j < 4; ++j) { a0[j] = a0[j] * sigmoidf_(a0[j]) * b0[j]; a1[j] = a1[j] * sigmoidf_(a1[j]) * b1[j]; }
            st16(HM, o0 + (unsigned)(ai * HALF + m * 16) * ld2, pack8(a0, a1)); }
    }
};
struct EpiSwiglu8 {
    static constexpr bool PERM = true;
    unsigned char* HM; int ldh;
    __device__ __forceinline__ void operator()(EPI_ARGS) const {
        const unsigned ld = (unsigned)ldh, o0 = (unsigned)(u.pm * BM + wr * 64 + fr) * ld + (unsigned)(u.pn * 128 + wc * 32 + 8 * fq);
        EPI_FOR_AI_M {
            f32x4 a0 = acc[ai][0][m][0], a1 = acc[ai][0][m][1]; const f32x4 b0 = acc[ai][1][m][0], b1 = acc[ai][1][m][1];
#pragma unroll
            for (int j = 0; j < 4; ++j) { a0[j] = a0[j] * sigmoidf_(a0[j]) * b0[j]; a1[j] = a1[j] * sigmoidf_(a1[j]) * b1[j]; }
            u32x2 w; w.x = pack4_fp8(a0[0], a0[1], a0[2], a0[3]); w.y = pack4_fp8(a1[0], a1[1], a1[2], a1[3]);
            *(u32x2*)(HM + o0 + (unsigned)(ai * HALF + m * 16) * ld) = w; }
    }
};
struct EpiMoeDown {
    static constexpr bool PERM = true;
    bf16_t* Y; const float* roww;
    __device__ __forceinline__ void operator()(EPI_ARGS) const {
        const unsigned row0 = (unsigned)(u.pm * BM + wr * 64 + fr), o0 = (row0 * 1024u + (unsigned)(u.pn * 256 + wc * 32 + 8 * fq)) * 2u;
        float w[2][4];
        EPI_FOR_AI_M { w[ai][m] = roww[row0 + ai * HALF + m * 16]; }
        EPI_FOR_AI_M { EPI_FOR_BJ { st16(Y, o0 + (unsigned)((ai * HALF + m * 16) * 1024 + bj * HALF) * 2u, pack8(acc[ai][bj][m][0] * w[ai][m], acc[ai][bj][m][1] * w[ai][m])); } }
    }
};
}
namespace attn {
#ifndef MK_NOFUSE
#define MK_NOFUSE 0
#endif
#ifndef MK_PARK_LDS
#define MK_PARK_LDS 1
#endif
#define PARK_OFF(c) (((c) < 12) ? (73728 + (c) * 4096) : ((c) == 12) ? 123904 : (132096 + ((c) - 13) * 4096))
#ifndef MK_T15_NEGM
#define MK_T15_NEGM 1
#endif
#ifndef MK_SMCHK
#define MK_SMCHK 15
#endif
constexpr int SLOT = 40960, NSLOT = 3, LDS_TAB = NSLOT * SLOT;
__device__ __forceinline__ void glds16(const void* gsrc, unsigned lds_dst) { unsigned keep;
    asm volatile("s_mov_b32 %0, m0\n\ts_mov_b32 m0, %2\n\ts_nop 0\n\tglobal_load_lds_dwordx4 %1, off\n\ts_mov_b32 m0, %0" : "=&s"(keep) : "v"(gsrc), "s"(lds_dst) : "memory"); }
__device__ __forceinline__ s16x4 vtr(const LAS unsigned char* p) { return __builtin_bit_cast(s16x4, __builtin_amdgcn_ds_read_tr16_b64_v4i16((LAS s16x4*)p)); }
__device__ __forceinline__ float halfmax(float m) { auto rr = __builtin_amdgcn_permlane32_swap(__float_as_uint(m), __float_as_uint(m), false, false); return fmaxf(__uint_as_float(rr[0]), __uint_as_float(rr[1])); }
__device__ __forceinline__ float halfsum(float m) { auto rr = __builtin_amdgcn_permlane32_swap(__float_as_uint(m), __float_as_uint(m), false, false); return __uint_as_float(rr[0]) + __uint_as_float(rr[1]); }
__device__ __forceinline__ float max16(const f32x16& a) { float x = fmaxf(fmaxf(a[0], a[1]), fmaxf(a[2], a[3])), y = fmaxf(fmaxf(a[4], a[5]), fmaxf(a[6], a[7]));
    float z = fmaxf(fmaxf(a[8], a[9]), fmaxf(a[10], a[11])), w = fmaxf(fmaxf(a[12], a[13]), fmaxf(a[14], a[15])); return fmaxf(fmaxf(x, y), fmaxf(z, w)); }
#define ATT_WAITBAR(N) asm volatile("s_waitcnt vmcnt(" #N ") lgkmcnt(0)\n\ts_barrier" ::: "memory")

constexpr float SM_THR = 8.0f;
__device__ __forceinline__ float max3f(float a, float b, float c) { return fmaxf(fmaxf(a, b), c); }
__device__ __forceinline__ bool sm_check(const f32x16& s0, const f32x16& s1, float& mref, float& l, float& alpha, bool first, float& dl) {
    float a = max3f(s0[0], s0[1], s1[0]), b = max3f(s0[2], s0[3], s1[1]); a = max3f(a, s1[2], s1[3]);
#pragma unroll
    for (int r = 4; r < 16; r += 4) { a = max3f(a, s0[r], s0[r + 1]); b = max3f(b, s0[r + 2], s0[r + 3]); a = max3f(a, s1[r], s1[r + 1]); b = max3f(b, s1[r + 2], s1[r + 3]); }
    const float mx = halfmax(fmaxf(a, b));
#if MK_T15_NEGM
    const bool up = first || (mx > SM_THR);
    alpha = 1.0f; dl = 0.f;
    if (__any(up)) { dl = up ? mx : 0.f; alpha = first ? 1.0f : fast_exp2(-dl); mref += dl; return true; }
    return false;
#else
    const bool up = first || (mx - mref > SM_THR);
    alpha = 1.0f; dl = 0.f;
    if (__any(up)) { const float nm = up ? mx : mref; alpha = first ? 1.0f : fast_exp2(mref - nm); mref = nm; return true; }
    return false;
#endif
}
template <int KS, int H>
__device__ __forceinline__ void sm_half(const f32x16& s0, const f32x16& s1, float mref, float& ra, float& rb, u32x4& pw) {
    constexpr int B = 8 * (KS & 1) + 4 * H;
    const float mr_ = MK_T15_NEGM ? 0.f : mref;
    const float v0 = fast_exp2(((KS < 2) ? s0[B] : s1[B]) - mr_), v1 = fast_exp2(((KS < 2) ? s0[B + 1] : s1[B + 1]) - mr_);
    const float v2 = fast_exp2(((KS < 2) ? s0[B + 2] : s1[B + 2]) - mr_), v3 = fast_exp2(((KS < 2) ? s0[B + 3] : s1[B + 3]) - mr_);
    ra += v0 + v2; rb += v1 + v3;
    if (H == 0) { pw.x = cvt_pk_bf16(v0, v1); pw.y = cvt_pk_bf16(v2, v3); } else { pw.z = cvt_pk_bf16(v0, v1); pw.w = cvt_pk_bf16(v2, v3); }
}

template <int NKS, bool BIAS>
__device__ __forceinline__ void attn_core(LAS unsigned char* lds, const char* kimg, int ktile_bytes, const char* vimg, const bf16x8 (&qf)[NKS], int NT, int tmax, int qpos,
                                          f32x16 (&o)[4], float& linv) {
    constexpr int NKP = 2 * NKS, KPW = NKP / 8, NPW = KPW + 2, KB = NKP * 1024, VRING = 3 * KB;
    static_assert(NKP % 8 == 0 && (NKS == 12 || NKS == 4), "K pieces divide over 8 waves; schedules exist for 192- and 64-wide q.k");
    const int tid = opaque_tid(), lane = tid & 63, r32 = lane & 31, hi = lane >> 5, wid = __builtin_amdgcn_readfirstlane(tid >> 6);
    const unsigned lds0 = (unsigned)(size_t)lds;
#define ATT_DMA_K(t, slot) do { _Pragma("unroll") for (int _i = 0; _i < KPW; ++_i) { const int _p = wid + 8 * _i; \
        glds16(kimg + (size_t)(t) * ktile_bytes + _p * 1024 + lane * 16, (unsigned)__builtin_amdgcn_readfirstlane(lds0 + (slot) * KB + _p * 1024)); } } while (0)
#define ATT_DMA_V(t, slot) do { _Pragma("unroll") for (int _i = 0; _i < 2; ++_i) { const int _p = wid + 8 * _i; \
        glds16(vimg + (size_t)(t) * 16384 + _p * 1024 + lane * 16, (unsigned)__builtin_amdgcn_readfirstlane(lds0 + VRING + (slot) * 16384 + _p * 1024)); } } while (0)
    ATT_DMA_K(0, 0); ATT_DMA_K(1, 1); ATT_DMA_V(0, 0);
#pragma unroll
    for (int i = 0; i < 4; ++i) o[i] = f32x16{};
    float mref = 0.f, l = 0.f, ra = 0.f, rb = 0.f;
    f32x16 negm = f32x16{};
    f32x16 a0, a1, b0, b1;
    int kq = 0, vq = 0, dk = 2, dv = 1;
    const int tfast = (MK_NOFUSE) ? -1 : (BIAS ? tmax - 3 : tmax);
    const LAS unsigned char* vp0 = lds + VRING + ((lane >> 4) & 1) * 32 + (lane & 3) * 8 + (4 * hi + ((lane & 15) >> 2)) * 64;
    const LAS unsigned char* kp0 = lds + hi * 1024 + r32 * 16;
    const LAS float* tab = (const LAS float*)(lds + LDS_TAB);
#define ATT_ROT(x) x = (x == 2) ? 0 : x + 1
#define SB() __builtin_amdgcn_sched_barrier(0)
#define ATT_TOP(t) do { if ((t) + 1 < NT) { if (NPW == 5) { ATT_WAITBAR(5); } else { ATT_WAITBAR(3); } } else { ATT_WAITBAR(0); } \
        if ((t) + 2 < NT) { ATT_DMA_K((t) + 2, dk); ATT_ROT(dk); } if ((t) + 1 < NT) { ATT_DMA_V((t) + 1, dv); ATT_ROT(dv); } } while (0)
#define KLD(d0, bf) do { ka[bf][0] = *(const LAS bf16x8*)(kp + (d0) * 2048); ka[bf][1] = *(const LAS bf16x8*)(kp + (d0) * 2048 + 512); } while (0)
#define QKM(C0, C1, d0, bf) do { C0 = __builtin_amdgcn_mfma_f32_32x32x16_bf16(ka[bf][0], qf[d0], C0, 0, 0, 0); C1 = __builtin_amdgcn_mfma_f32_32x32x16_bf16(ka[bf][1], qf[d0], C1, 0, 0, 0); } while (0)
#define VLD(ks) do { _Pragma("unroll") for (int db = 0; db < 4; ++db) { vl[db] = vtr(vp + db * 4096 + (ks) * 1024); vh[db] = vtr(vp + db * 4096 + (ks) * 1024 + 512); } } while (0)
#define PVM(ks) do { const bf16x8 pfr = __builtin_bit_cast(bf16x8, pw[ks]); _Pragma("unroll") for (int db = 0; db < 4; ++db) { \
        const bf16x8 vf = (bf16x8){vl[db][0], vl[db][1], vl[db][2], vl[db][3], vh[db][0], vh[db][1], vh[db][2], vh[db][3]}; \
        o[db] = __builtin_amdgcn_mfma_f32_32x32x16_bf16(vf, pfr, o[db], 0, 0, 0); } } while (0)
#define SMH(P0, P1, ks, h) sm_half<ks, h>(P0, P1, mref, ra, rb, pw[ks])
#define ATT_CHECK(P0, P1, tt) do { if ((tt) == 0 || ((tt) & MK_SMCHK) == 0) { float alpha_, dl_; if (sm_check(P0, P1, mref, l, alpha_, (tt) == 0, dl_)) { l = (l + ra + rb) * alpha_; ra = 0.f; rb = 0.f; \
        if (MK_T15_NEGM) { _Pragma("unroll") for (int r = 0; r < 16; ++r) { P0[r] -= dl_; P1[r] -= dl_; negm[r] = -mref; } } \
        _Pragma("unroll") for (int ii = 0; ii < 4; ++ii) _Pragma("unroll") for (int r = 0; r < 16; ++r) o[ii][r] *= alpha_; } } } while (0)
#define ATT_QK_ONLY(C0, C1, t) do { const LAS unsigned char* kp = kp0 + kq * KB; bf16x8 ka[2][2]; \
        if (MK_T15_NEGM) { C0 = negm; C1 = negm; } else { C0 = f32x16{}; C1 = f32x16{}; } \
        if (BIAS) { if ((t) + 2 >= tmax) { const int bbase = 64 * (t) + 4 * hi - qpos + 192; const float nm_ = MK_T15_NEGM ? negm[0] : 0.f; \
            _Pragma("unroll") for (int r = 0; r < 16; ++r) { const int ix = bbase + (r & 3) + 8 * (r >> 2); C0[r] = tab[ix] + nm_; C1[r] = tab[ix + 32] + nm_; } } } \
        KLD(0, 0); KLD(1, 1); \
        _Pragma("unroll") for (int d0 = 0; d0 < NKS; ++d0) { SB(); QKM(C0, C1, d0, d0 & 1); if (d0 + 2 < NKS) KLD(d0 + 2, d0 & 1); SB(); } } while (0)
#define ATT_SMPV(P0, P1) do { const LAS unsigned char* vp = vp0 + vq * 16384; s16x4 vl[4], vh[4]; u32x4 pw[4]; \
        VLD(0); SMH(P0, P1, 0, 0); SMH(P0, P1, 0, 1); SMH(P0, P1, 1, 0); SMH(P0, P1, 1, 1); SMH(P0, P1, 2, 0); SMH(P0, P1, 2, 1); SMH(P0, P1, 3, 0); SMH(P0, P1, 3, 1); \
        SB(); PVM(0); SB(); VLD(1); SB(); PVM(1); SB(); VLD(2); SB(); PVM(2); SB(); VLD(3); SB(); PVM(3); SB(); } while (0)
#define ATT_FUSED(C0, C1, P0, P1) do { const LAS unsigned char* kp = kp0 + kq * KB; const LAS unsigned char* vp = vp0 + vq * 16384; \
        bf16x8 ka[2][2]; s16x4 vl[4], vh[4]; u32x4 pw[4]; if (!MK_T15_NEGM) { C0 = f32x16{}; C1 = f32x16{}; } \
        KLD(0, 0); KLD(1, 1); VLD(0); SB(); \
        if constexpr (NKS == 12) { \
            QKM(C0, C1, 0, 0); KLD(2, 0); SMH(P0, P1, 0, 0); SB(); \
            QKM(C0, C1, 1, 1); KLD(3, 1); SMH(P0, P1, 0, 1); SB(); \
            QKM(C0, C1, 2, 0); KLD(4, 0); SB(); \
            PVM(0); VLD(1); SMH(P0, P1, 1, 0); SB(); \
            QKM(C0, C1, 3, 1); KLD(5, 1); SMH(P0, P1, 1, 1); SB(); \
            QKM(C0, C1, 4, 0); KLD(6, 0); SB(); \
            PVM(1); VLD(2); SMH(P0, P1, 2, 0); SB(); \
            QKM(C0, C1, 5, 1); KLD(7, 1); SMH(P0, P1, 2, 1); SB(); \
            QKM(C0, C1, 6, 0); KLD(8, 0); SB(); \
            PVM(2); VLD(3); SMH(P0, P1, 3, 0); SB(); \
            QKM(C0, C1, 7, 1); KLD(9, 1); SMH(P0, P1, 3, 1); SB(); \
            QKM(C0, C1, 8, 0); KLD(10, 0); SB(); \
            PVM(3); SB(); \
            QKM(C0, C1, 9, 1); KLD(11, 1); SB(); \
            QKM(C0, C1, 10, 0); SB(); \
            QKM(C0, C1, 11, 1); SB(); \
        } else { \
            if (MK_T15_NEGM) { C0 = __builtin_amdgcn_mfma_f32_32x32x16_bf16(ka[0][0], qf[0], negm, 0, 0, 0); C1 = __builtin_amdgcn_mfma_f32_32x32x16_bf16(ka[0][1], qf[0], negm, 0, 0, 0); } else { QKM(C0, C1, 0, 0); } \
            KLD(2, 0); SMH(P0, P1, 0, 0); SMH(P0, P1, 0, 1); SB(); \
            PVM(0); VLD(1); SMH(P0, P1, 1, 0); SB(); \
            QKM(C0, C1, 1, 1); KLD(3, 1); SMH(P0, P1, 1, 1); SB(); \
            PVM(1); VLD(2); SMH(P0, P1, 2, 0); SB(); \
            QKM(C0, C1, 2, 0); SMH(P0, P1, 2, 1); SB(); \
            PVM(2); VLD(3); SMH(P0, P1, 3, 0); SB(); \
            QKM(C0, C1, 3, 1); SMH(P0, P1, 3, 1); SB(); \
            PVM(3); SB(); \
        } } while (0)
#define ATT_FSTEP(t, C0, C1, P0, P1) do { ATT_TOP(t); ATT_CHECK(P0, P1, (t) - 1); ATT_FUSED(C0, C1, P0, P1); ATT_ROT(kq); ATT_ROT(vq); } while (0)
#define ATT_GSTEP(t, C0, C1, P0, P1) do { ATT_TOP(t); \
        if ((t) - 1 <= tmax) { ATT_CHECK(P0, P1, (t) - 1); ATT_SMPV(P0, P1); } if ((t) <= tmax) { ATT_QK_ONLY(C0, C1, t); } \
        ATT_ROT(kq); ATT_ROT(vq); } while (0)
    ATT_TOP(0);
    ATT_QK_ONLY(a0, a1, 0);
    ATT_ROT(kq);
    int t = 1;
#pragma nounroll
    for (; t + 1 <= tfast; t += 2) { ATT_FSTEP(t, b0, b1, a0, a1); ATT_FSTEP(t + 1, a0, a1, b0, b1); }
#pragma nounroll
    for (; t + 1 < NT; t += 2) { ATT_GSTEP(t, b0, b1, a0, a1); ATT_GSTEP(t + 1, a0, a1, b0, b1); }
    ATT_GSTEP(NT - 1, b0, b1, a0, a1);
    ATT_TOP(NT);
    if (NT - 1 <= tmax) { ATT_CHECK(b0, b1, NT - 1); ATT_SMPV(b0, b1); }
    l += ra + rb;
    linv = fast_rcp(halfsum(l));
    asm volatile("s_waitcnt vmcnt(0) lgkmcnt(0)\n\ts_barrier" ::: "memory");
#undef ATT_DMA_K
#undef ATT_DMA_V
#undef ATT_ROT
#undef SB
#undef ATT_TOP
#undef KLD
#undef QKM
#undef VLD
#undef PVM
#undef SMH
#undef ATT_CHECK
#undef ATT_QK_ONLY
#undef ATT_SMPV
#undef ATT_FUSED
#undef ATT_FSTEP
#undef ATT_GSTEP
}

__device__ __forceinline__ bool softmax_tile(f32x16& s0, f32x16& s1, float& mref, float& l, float& alpha, bool first, bool check, bf16x8 (&pf)[4]) {
    bool moved = false; alpha = 1.0f;
    if (check) {
    float a = max3f(s0[0], s0[1], s1[0]), b = max3f(s0[2], s0[3], s1[1]); a = max3f(a, s1[2], s1[3]);
#pragma unroll
    for (int r = 4; r < 16; r += 4) { a = max3f(a, s0[r], s0[r + 1]); b = max3f(b, s0[r + 2], s0[r + 3]); a = max3f(a, s1[r], s1[r + 1]); b = max3f(b, s1[r + 2], s1[r + 3]); }
    const float mx = halfmax(fmaxf(a, b));
    if (__any(first || mx > SM_THR)) {
        const float dl = (first || mx > SM_THR) ? mx : 0.f;
        mref += dl; alpha = first ? 1.0f : fast_exp2(-dl); l *= alpha; moved = true;
#pragma unroll
        for (int r = 0; r < 16; ++r) { s0[r] -= dl; s1[r] -= dl; }
    }
    }
    float rs0 = 0.f, rs1 = 0.f;
#pragma unroll
    for (int r = 0; r < 16; ++r) { s0[r] = fast_exp2(s0[r]); s1[r] = fast_exp2(s1[r]); rs0 += s0[r]; rs1 += s1[r]; }
    l += rs0 + rs1;
#pragma unroll
    for (int s = 0; s < 2; ++s) {
        u32x4 x, y;
        x.x = cvt_pk_bf16(s0[8 * s + 0], s0[8 * s + 1]); x.y = cvt_pk_bf16(s0[8 * s + 2], s0[8 * s + 3]); x.z = cvt_pk_bf16(s0[8 * s + 4], s0[8 * s + 5]); x.w = cvt_pk_bf16(s0[8 * s + 6], s0[8 * s + 7]);
        y.x = cvt_pk_bf16(s1[8 * s + 0], s1[8 * s + 1]); y.y = cvt_pk_bf16(s1[8 * s + 2], s1[8 * s + 3]); y.z = cvt_pk_bf16(s1[8 * s + 4], s1[8 * s + 5]); y.w = cvt_pk_bf16(s1[8 * s + 6], s1[8 * s + 7]);
        pf[s] = __builtin_bit_cast(bf16x8, x); pf[2 + s] = __builtin_bit_cast(bf16x8, y);
    }
    return moved;
}

template <int NKS, bool BIAS>
__device__ __forceinline__ void attn_core_v1(LAS unsigned char* lds, const char* kimg, int ktile_bytes, const char* vimg, const bf16x8 (&qf)[NKS], int NT, int tmax, int qpos,
                                          f32x16 (&o)[4], float& linv) {
    constexpr int NKP = 2 * NKS, NPW = (NKP + 16) / 8, KB = NKP * 1024;
    static_assert((NKP + 16) % 8 == 0, "pieces divide over 8 waves");
    const int tid = opaque_tid(), lane = tid & 63, r32 = lane & 31, hi = lane >> 5, wid = __builtin_amdgcn_readfirstlane(tid >> 6);
    const unsigned lds0 = (unsigned)(size_t)lds;
#define ATT_DMA(t, slot) do { _Pragma("unroll") for (int _i = 0; _i < NPW; ++_i) { const int _p = wid + 8 * _i; \
        const char* _s = (_p < NKP) ? kimg + (size_t)(t) * ktile_bytes + _p * 1024 : vimg + (size_t)(t) * 16384 + (_p - NKP) * 1024; \
        glds16(_s + lane * 16, (unsigned)__builtin_amdgcn_readfirstlane(lds0 + (slot) + _p * 1024)); } } while (0)
    ATT_DMA(0, 0); ATT_DMA(1, SLOT);
#pragma unroll
    for (int i = 0; i < 4; ++i) o[i] = f32x16{};
    float mref = 0.f, l = 0.f; f32x16 negm = f32x16{};
    int sl_cur = 0, sl_nn = 2 * SLOT;
    const LAS unsigned char* vp0 = lds + KB + ((lane >> 4) & 1) * 32 + (lane & 3) * 8 + (4 * hi + ((lane & 15) >> 2)) * 64;
    const LAS unsigned char* kp0 = lds + hi * 1024 + r32 * 16;
    const LAS float* tab = (const LAS float*)(lds + LDS_TAB);
    for (int t = 0; t < NT; ++t) {
        if (t + 1 < NT) { if (NPW == 5) { ATT_WAITBAR(5); } else { ATT_WAITBAR(3); } } else { ATT_WAITBAR(0); }
        if (t + 2 < NT) ATT_DMA(t + 2, sl_nn);
        if (t <= tmax) {
            f32x16 s0 = negm, s1 = negm;
            if (BIAS) { if (t + 2 >= tmax) { const int bbase = 64 * t + 4 * hi - qpos + 192;
#pragma unroll
                for (int r = 0; r < 16; ++r) { const int ix = bbase + (r & 3) + 8 * (r >> 2); s0[r] = tab[ix] - mref; s1[r] = tab[ix + 32] - mref; } } }
            const LAS unsigned char* kp = kp0 + sl_cur;
            {
                bf16x8 ka[2][2];
                ka[0][0] = *(const LAS bf16x8*)(kp); ka[0][1] = *(const LAS bf16x8*)(kp + 512);
                ka[1][0] = *(const LAS bf16x8*)(kp + 2048); ka[1][1] = *(const LAS bf16x8*)(kp + 2048 + 512);
#pragma unroll
                for (int d0 = 0; d0 < NKS; ++d0) {
                    const bf16x8 k0 = ka[d0 & 1][0], k1 = ka[d0 & 1][1];
                    if (d0 + 2 < NKS) { ka[d0 & 1][0] = *(const LAS bf16x8*)(kp + (d0 + 2) * 2048); ka[d0 & 1][1] = *(const LAS bf16x8*)(kp + (d0 + 2) * 2048 + 512); }
                    __builtin_amdgcn_sched_barrier(0);
                    s0 = __builtin_amdgcn_mfma_f32_32x32x16_bf16(k0, qf[d0], s0, 0, 0, 0);
                    s1 = __builtin_amdgcn_mfma_f32_32x32x16_bf16(k1, qf[d0], s1, 0, 0, 0);
                    __builtin_amdgcn_sched_barrier(0);
                }
            }
            const LAS unsigned char* vp = vp0 + sl_cur;
            s16x4 vl[2][4], vh[2][4];
#pragma unroll
            for (int db = 0; db < 4; ++db) { vl[0][db] = vtr(vp + db * 4096); vh[0][db] = vtr(vp + db * 4096 + 512); }
            __builtin_amdgcn_sched_barrier(0);
            float alpha; bf16x8 pf[4];
            if (softmax_tile(s0, s1, mref, l, alpha, t == 0, (t & MK_SMCHK) == 0, pf)) {
#pragma unroll
                for (int r = 0; r < 16; ++r) negm[r] = -mref;
#pragma unroll
                for (int i = 0; i < 4; ++i)
#pragma unroll
                    for (int r = 0; r < 16; ++r) o[i][r] *= alpha;
            }
            {
#pragma unroll
                for (int ks = 0; ks < 4; ++ks) {
                    if (ks + 1 < 4) {
#pragma unroll
                        for (int db = 0; db < 4; ++db) { vl[(ks + 1) & 1][db] = vtr(vp + db * 4096 + (ks + 1) * 1024); vh[(ks + 1) & 1][db] = vtr(vp + db * 4096 + (ks + 1) * 1024 + 512); }
                    }
                    __builtin_amdgcn_sched_barrier(0);
#pragma unroll
                    for (int db = 0; db < 4; ++db) { const s16x4 lo = vl[ks & 1][db], hh = vh[ks & 1][db];
                        const bf16x8 vf = (bf16x8){lo[0], lo[1], lo[2], lo[3], hh[0], hh[1], hh[2], hh[3]};
                        o[db] = __builtin_amdgcn_mfma_f32_32x32x16_bf16(vf, pf[ks], o[db], 0, 0, 0); }
                    __builtin_amdgcn_sched_barrier(0);
                }
            }
        }
        sl_cur = (sl_cur == 2 * SLOT) ? 0 : sl_cur + SLOT; sl_nn = (sl_nn == 2 * SLOT) ? 0 : sl_nn + SLOT;
    }
    linv = fast_rcp(halfsum(l));
    asm volatile("s_waitcnt vmcnt(0) lgkmcnt(0)\n\ts_barrier" ::: "memory");
#undef ATT_DMA
}

__device__ __forceinline__ void st_pair16(bf16_t* rowp, int col8, int hi, u32x2 wa, u32x2 wb) {
    auto rx = __builtin_amdgcn_permlane32_swap(wa.x, wb.x, false, false); auto ry = __builtin_amdgcn_permlane32_swap(wa.y, wb.y, false, false);
    u32x4 v; v.x = rx[0]; v.y = ry[0]; v.z = rx[1]; v.w = ry[1];
    *(u32x4*)(rowp + col8 + (hi ? 8 : 0)) = v;
}

__device__ __forceinline__ void mla_unit(LAS unsigned char* lds, int bh, int qb, const bf16_t* QM, const bf16_t* KM, const bf16_t* VM, bf16_t* BR) {
    const int tid = opaque_tid(), lane = tid & 63, r32 = lane & 31, hi = lane >> 5, wid = __builtin_amdgcn_readfirstlane(tid >> 6);
    const int b = bh >> 2, h = bh & 3;
    const size_t qrow = (size_t)b * SEQ + qb * 256 + wid * 32 + r32;
    bf16x8 qf[12];
#pragma unroll
    for (int d0 = 0; d0 < 12; ++d0) qf[d0] = *(const bf16x8*)(QM + qrow * 768 + h * 192 + d0 * 16 + hi * 8);
    f32x16 o[4]; float inv;
    attn_core_v1<12, false>(lds, (const char*)(KM + km_addr(bh, 0, 0, 0)), 24576, (const char*)(VM + vimg_addr(bh, 0, 0, 0)), qf, 4 * (qb + 1), 4 * qb + (wid >> 1), 0, o, inv);
    bf16_t* op = BR + qrow * 1536 + 512 + h * 128;
#pragma unroll
    for (int db = 0; db < 4; ++db)
#pragma unroll
        for (int g = 0; g < 4; g += 2) { u32x2 wa, wb;
            wa.x = cvt_pk_bf16(o[db][4 * g] * inv, o[db][4 * g + 1] * inv); wa.y = cvt_pk_bf16(o[db][4 * g + 2] * inv, o[db][4 * g + 3] * inv);
            wb.x = cvt_pk_bf16(o[db][4 * g + 4] * inv, o[db][4 * g + 5] * inv); wb.y = cvt_pk_bf16(o[db][4 * g + 6] * inv, o[db][4 * g + 7] * inv);
            st_pair16(op, db * 32 + g * 8, hi, wa, wb); }
}

__device__ __forceinline__ void diff_unit(LAS unsigned char* lds, int bh, int qb, const bf16_t* DQ, const bf16_t* K12, const bf16_t* VD, bf16_t* BR,
                                          const float* biast, const float* gsub, unsigned lam_bits, unsigned osc_bits) {
    const int b = bh >> 2, h = bh & 3;
    const int NT = 4 * (qb + 1);
    const char* vimg = (const char*)(VD + vimg_addr(bh, 0, 0, 0));
#define DU_LANE(t_) const int lane = (t_) & 63, r32 = lane & 31, hi = lane >> 5, wid = __builtin_amdgcn_readfirstlane((t_) >> 6); (void)lane; (void)r32; (void)hi; (void)wid
#define DU_QROW ((unsigned)(b * SEQ + qb * 256 + wid * 32 + r32))
    {
        const int t0_ = opaque_tid(); DU_LANE(t0_);
        LAS float* tab = (LAS float*)(lds + LDS_TAB);
        if (t0_ < 256) tab[t0_] = biast[h * 256 + t0_];
        const int qpos = qb * 256 + wid * 32 + r32, tmax = 4 * qb + (wid >> 1);
        bf16x8 qf[4];
#pragma unroll
        for (int d0 = 0; d0 < 4; ++d0) qf[d0] = *(const bf16x8*)(DQ + (size_t)DU_QROW * 512 + h * 128 + d0 * 16 + hi * 8);
        f32x16 oa[4]; float inv;
        attn_core<4, true>(lds, (const char*)(K12 + k12_addr(bh, 0, 0, 0, 0)), 16384, vimg, qf, NT, tmax, qpos, oa, inv);
#if !MK_PARK_LDS
        const int t1_ = opaque_tid(); bf16_t* op = BR + (size_t)((unsigned)(b * SEQ + qb * 256) + (unsigned)(((t1_ >> 6) * 32) + (t1_ & 31))) * 1536 + 1024 + h * 128 + 4 * ((t1_ >> 5) & 1);
#endif
#pragma unroll
        for (int db = 0; db < 4; ++db)
#pragma unroll
            for (int g = 0; g < 4; ++g) { u32x2 w; w.x = cvt_pk_bf16(oa[db][4 * g] * inv, oa[db][4 * g + 1] * inv); w.y = cvt_pk_bf16(oa[db][4 * g + 2] * inv, oa[db][4 * g + 3] * inv);
#if MK_PARK_LDS
                *(LAS u32x2*)(lds + PARK_OFF(db * 4 + g) + opaque_tid() * 8) = w; }
#else
                *(u32x2*)(op + db * 32 + g * 8) = w; }
#endif
    }
    float ss = 0.f;
    f32x16 oa[4];
    {
        float inv;
        {   const int t0_ = opaque_tid(); DU_LANE(t0_);
            const int qpos = qb * 256 + wid * 32 + r32, tmax = 4 * qb + (wid >> 1);
            bf16x8 qf[4];
#pragma unroll
            for (int d0 = 0; d0 < 4; ++d0) qf[d0] = *(const bf16x8*)(DQ + (size_t)DU_QROW * 512 + h * 128 + 64 + d0 * 16 + hi * 8);
            attn_core<4, true>(lds, (const char*)(K12 + k12_addr(bh, 0, 1, 0, 0)), 16384, vimg, qf, NT, tmax, qpos, oa, inv); }
        const float i2 = __uint_as_float(lam_bits) * inv;
        const int tid2_ = opaque_tid(); (void)tid2_;
#if !MK_PARK_LDS
        const bf16_t* op = BR + (size_t)((unsigned)(b * SEQ + qb * 256) + (unsigned)(((tid2_ >> 6) * 32) + (tid2_ & 31))) * 1536 + 1024 + h * 128 + 4 * ((tid2_ >> 5) & 1);
#endif
#pragma unroll
        for (int db = 0; db < 4; ++db)
#pragma unroll
            for (int g = 0; g < 4; ++g) {
#if MK_PARK_LDS
                const u32x2 w = *(const LAS u32x2*)(lds + PARK_OFF(db * 4 + g) + tid2_ * 8);
#else
                const u32x2 w = *(const u32x2*)(op + db * 32 + g * 8);
#endif
                const float v0 = bflo(w.x) - oa[db][4 * g] * i2, v1 = bfhi(w.x) - oa[db][4 * g + 1] * i2, v2 = bflo(w.y) - oa[db][4 * g + 2] * i2, v3 = bfhi(w.y) - oa[db][4 * g + 3] * i2;
                oa[db][4 * g] = v0; oa[db][4 * g + 1] = v1; oa[db][4 * g + 2] = v2; oa[db][4 * g + 3] = v3; ss += (v0 * v0 + v1 * v1) + (v2 * v2 + v3 * v3); }
    }
#if MK_PARK_LDS
    asm volatile("s_waitcnt lgkmcnt(0)\n\ts_barrier" ::: "memory");
#endif
    ss = halfsum(ss);
    const float rn = __builtin_amdgcn_rsqf(ss * (1.0f / 128.0f) + EPS) * __uint_as_float(osc_bits);
    const int t3_ = opaque_tid(); const int hi3 = (t3_ >> 5) & 1;
    bf16_t* op3 = BR + (size_t)((unsigned)(b * SEQ + qb * 256) + (unsigned)(((t3_ >> 6) * 32) + (t3_ & 31))) * 1536 + 1024 + h * 128;
#pragma unroll
    for (int db = 0; db < 4; ++db)
#pragma unroll
        for (int g = 0; g < 4; g += 2) { const f32x4 ga = *(const f32x4*)(gsub + db * 32 + g * 8 + 4 * hi3), gb = *(const f32x4*)(gsub + db * 32 + g * 8 + 8 + 4 * hi3);
            u32x2 wa, wb;
            wa.x = cvt_pk_bf16(oa[db][4 * g] * rn * ga[0], oa[db][4 * g + 1] * rn * ga[1]); wa.y = cvt_pk_bf16(oa[db][4 * g + 2] * rn * ga[2], oa[db][4 * g + 3] * rn * ga[3]);
            wb.x = cvt_pk_bf16(oa[db][4 * g + 4] * rn * gb[0], oa[db][4 * g + 5] * rn * gb[1]); wb.y = cvt_pk_bf16(oa[db][4 * g + 6] * rn * gb[2], oa[db][4 * g + 7] * rn * gb[3]);
            st_pair16(op3, db * 32 + g * 8, hi3, wa, wb); }
#undef DU_LANE
#undef DU_QROW
}
}
struct Args { const float* in[30]; float* out; unsigned char* ws; int ph_lo, ph_hi; };
struct Frame {
    LAS unsigned char* lds; int tid, lane, wave, G, vcu;
    float* out; unsigned char* ws;
};

struct ConvDesc { const float* src; const float* ks; bf16_t* dst; int ldsrc, Ksrc, Kdst, Nj, ldb, map, rowoff, f8; float wmul; };
__device__ __forceinline__ int conv_srccol(int map, int j) {
    if (map == 1) {
        if (j < 1408) return j;
        if (j < 1472) { const int q = j - 1408, g8 = q >> 3, w = q & 7; return 1408 + ((w < 4) ? 4 * g8 + w : 32 + 4 * g8 + (w - 4)); }
        if (j < 1536) return -1;
        return j - 64;
    }
    if (map == 2) { const int h = j / 192, w = j % 192; if (w < 128) return j; const int q = w - 128, g8 = q >> 3, ww = q & 7; return h * 192 + 128 + ((ww < 4) ? 4 * g8 + ww : 32 + 4 * g8 + (ww - 4)); }
    return j;
}
__device__ __forceinline__ int conv_dstrow(int map, int rowoff, int j) { return (map == 3) ? ((j >> 7) * 256 + (j & 127) + rowoff) : (j + rowoff); }
__device__ __forceinline__ void conv_load(const ConvDesc& d, int item, int lane, float (&v)[32]) {
    const int njb = d.Nj / 32, kb = item / njb, jb = item % njb, k0 = 64 * kb, j0 = 32 * jb;
    const int sc = conv_srccol(d.map, j0 + (lane & 31));
    const bool live = (sc >= 0) && (k0 < d.Ksrc);
    const float* sp = d.src + (size_t)(k0 + (lane >> 5)) * d.ldsrc + (sc < 0 ? 0 : sc);
#pragma unroll
    for (int i = 0; i < 32; ++i) v[i] = live ? sp[(size_t)(2 * i) * d.ldsrc] : 0.f;
    if (d.ks && live) {
#pragma unroll
        for (int i = 0; i < 32; ++i) v[i] *= d.ks[k0 + 2 * i + (lane >> 5)];
    }
}
__device__ __forceinline__ void conv_store(const ConvDesc& d, int item, LAS float* scr, int lane, const float (&v)[32]) {
    const int njb = d.Nj / 32, kb = item / njb, jb = item % njb, k0 = 64 * kb, j0 = 32 * jb;
#pragma unroll
    for (int i = 0; i < 32; ++i) scr[(2 * i + (lane >> 5)) * 33 + (lane & 31)] = v[i];
    LDS_WAIT(); asm volatile("" ::: "memory");
    const int c = lane & 7, r0 = conv_dstrow(d.map, d.rowoff, j0);
    if (d.f8) {
#pragma unroll
        for (int jj = 0; jj < 4; ++jj) { const int n = (lane >> 3) + 8 * jj; const LAS float* s = scr + (8 * c) * 33 + n; const float wm = d.wmul;
            u32x2 o; o.x = pack4_fp8(s[0 * 33] * wm, s[1 * 33] * wm, s[2 * 33] * wm, s[3 * 33] * wm); o.y = pack4_fp8(s[4 * 33] * wm, s[5 * 33] * wm, s[6 * 33] * wm, s[7 * 33] * wm);
            *(u32x2*)((unsigned char*)d.dst + (size_t)(r0 + n) * d.ldb + k0 + 8 * c) = o; }
    } else {
#pragma unroll
        for (int jj = 0; jj < 4; ++jj) { const int n = (lane >> 3) + 8 * jj; const LAS float* s = scr + (8 * c) * 33 + n;
            const float wm = d.wmul;
            u32x4 o; o.x = cvt_pk_bf16(s[0 * 33] * wm, s[1 * 33] * wm); o.y = cvt_pk_bf16(s[2 * 33] * wm, s[3 * 33] * wm); o.z = cvt_pk_bf16(s[4 * 33] * wm, s[5 * 33] * wm); o.w = cvt_pk_bf16(s[6 * 33] * wm, s[7 * 33] * wm);
            *(u32x4*)(d.dst + (size_t)(r0 + n) * d.ldb + k0 + 8 * c) = o; }
    }
    LDS_WAIT(); asm volatile("" ::: "memory");
}
__device__ __forceinline__ ConvDesc get_desc(const Frame& F, const Args& A, int mi, int ml) {
    ConvDesc d; d.ks = nullptr; d.map = 0; d.rowoff = 0; d.f8 = 0; d.wmul = 1.0f;
    if (mi < 40) { const int l = mi / 10, k = mi % 10; unsigned char* wb = F.ws + WS_WMIX + (size_t)l * WMIX_STRIDE;
        if (k == 0) { d.src = A.in[2] + (size_t)l * 1024 * 3008; d.ldsrc = 3008; d.Ksrc = d.Kdst = 1024; d.Nj = 3072; d.dst = (bf16_t*)(wb + WM_CAT); d.ldb = 1024; d.map = 1; if (MK_F8_INPROJ) { d.f8 = 1; d.wmul = (float)(1 << SWG); }
            else if (l >= MK_F8_INFROM) { d.f8 = 1; d.wmul = (float)(1 << SWG); d.dst = (bf16_t*)(wb + WM_G8 - (size_t)12 * 256 * 1024); } }
        else if (k < 4) { const int n = k - 1; d.src = A.in[17] + (size_t)(l * 3 + n) * 1024 * 1024; d.ldsrc = 1024; d.Ksrc = d.Kdst = 1024; d.Nj = 1024; d.ldb = 1024;
            if (MK_F8_GATES) { d.dst = (bf16_t*)(wb + WM_G8); d.rowoff = 1024 * n; d.f8 = 1; d.wmul = (float)(1 << SWG); } else { d.dst = (bf16_t*)(wb + WM_CAT); d.rowoff = 3072 + 1024 * n; } }
        else if (k == 4) { d.src = A.in[9] + (size_t)l * 256 * 768; d.ldsrc = 768; d.Ksrc = d.Kdst = 256; d.Nj = 768; d.dst = (bf16_t*)(wb + WM_UQ); d.ldb = 256; d.map = 2; d.ks = A.in[7] + l * 256; }
        else if (k == 5) { d.src = A.in[10] + (size_t)l * 128 * 1024; d.ldsrc = 1024; d.Ksrc = 128; d.Kdst = 256; d.Nj = 1024; d.dst = (bf16_t*)(wb + WM_UKV); d.ldb = 256; d.ks = A.in[8] + l * 128; }
        else if (k < 9) { const int n = k - 6; d.src = A.in[19] + (size_t)(l * 3 + n) * 512 * 1024; d.ldsrc = 1024; d.Ksrc = d.Kdst = 512; d.Nj = 1024; d.dst = (bf16_t*)(wb + WM_B) + (size_t)n * 1024 * 512; d.ldb = 512; if (MK_G8) d.wmul = 1.0f / 256.0f; }
        else { d.src = A.in[20] + (size_t)l * 1024 * 1024; d.ldsrc = 1024; d.Ksrc = d.Kdst = 1024; d.Nj = 1024; d.dst = (bf16_t*)(wb + WM_O); d.ldb = 1024; }
    } else if (mi < 46) { const int i = (mi - 40) / 3, k = (mi - 40) % 3; unsigned char* wb = F.ws + WS_WDEN + (size_t)i * WDEN_STRIDE;
        if (k < 2) { d.src = (k == 0 ? A.in[22] : A.in[23]) + (size_t)i * 1024 * FD; d.ldsrc = FD; d.Ksrc = d.Kdst = 1024; d.Nj = FD; d.dst = (bf16_t*)(wb + WD_13); d.ldb = 1024; d.map = 3; d.rowoff = 128 * k; if (F8_DENSE(i)) { d.f8 = 1; d.wmul = (float)(1 << SW13); } }
        else { d.src = A.in[24] + (size_t)i * FD * 1024; d.ldsrc = 1024; d.Ksrc = d.Kdst = FD; d.Nj = 1024; d.dst = (bf16_t*)(wb + WD_2); d.ldb = FD; if (F8_DENSE(i)) { d.f8 = 1; d.wmul = (float)(1 << SW2); } }
    } else { const int q = mi - 46, e = q / 3, k = q % 3; unsigned char* wb = F.ws + WS_WMOE; const size_t xe = (size_t)ml * NEXP + e;
        if (k < 2) { d.src = (k == 0 ? A.in[26] : A.in[27]) + xe * 1024 * FE; d.ldsrc = FE; d.Ksrc = d.Kdst = 1024; d.Nj = FE; d.dst = (bf16_t*)(wb + WE_13 + (size_t)e * 2 * FE * 1024); d.ldb = 1024; d.map = 3; d.rowoff = 128 * k; d.f8 = 1; d.wmul = (float)(1 << SW13); }
        else { d.src = A.in[28] + xe * FE * 1024; d.ldsrc = 1024; d.Ksrc = d.Kdst = FE; d.Nj = 1024; d.dst = (bf16_t*)(wb + WE_2 + (size_t)e * 1024 * FE); d.ldb = FE; d.f8 = 1; d.wmul = (float)(1 << SW2); }
    }
    return d;
}
struct ConvCursor { int mi, base, cur; };
__device__ __forceinline__ bool conv_next(const Frame& F, const Args& A, ConvCursor& c, int mi_hi, int ml, ConvDesc& d, int& item) {
    while (c.mi < mi_hi) {
        d = get_desc(F, A, c.mi, ml);
        const int nit = (d.Nj / 32) * (d.Kdst / 64);
        if (c.cur < c.base + nit) { item = c.cur - c.base; return true; }
        c.base += nit; ++c.mi;
    }
    return false;
}
__device__ __forceinline__ void conv_range(const Frame& F0, const Args& A, int mi_lo, int mi_hi, int ml) {
    Frame F = F0; F.tid = opaque_tid(); F.lane = F.tid & 63;
    LAS float* scr = (LAS float*)(F.lds + F.wave * 16384);
    const int gw = F.vcu * NWAVES + F.wave, NGW = F.G * NWAVES;
    ConvCursor c{mi_lo, 0, gw};
    ConvDesc da, db; int ia = 0, ib = 0; float va[32], vb[32];
    bool ha = conv_next(F, A, c, mi_hi, ml, da, ia);
    if (ha) conv_load(da, ia, F.lane, va);
    while (ha) {
        c.cur += NGW; const bool hb = conv_next(F, A, c, mi_hi, ml, db, ib);
        if (hb) conv_load(db, ib, F.lane, vb);
        conv_store(da, ia, scr, F.lane, va);
        if (!hb) break;
        c.cur += NGW; ha = conv_next(F, A, c, mi_hi, ml, da, ia);
        if (ha) conv_load(da, ia, F.lane, va);
        conv_store(db, ib, scr, F.lane, vb);
    }
}
__device__ __forceinline__ float lam_init_of(int l) { return 0.8f - 0.6f * expf(-0.3f * (float)l); }
__device__ __forceinline__ void prologue_tables(const Frame& F0, const Args& A) {
    Frame F = F0; F.tid = opaque_tid(); F.lane = F.tid & 63;
    const int gt = F.vcu * NTHR + F.tid, NGT = F.G * NTHR;
    float* rc = (float*)(F.ws + WS_ROPEC); float* rs = (float*)(F.ws + WS_ROPES);
    for (int i = gt; i < SEQ * 32; i += NGT) { const int pos = i >> 5, k = i & 31;
        const float inv = powf(10000.0f, -((float)(2 * k)) / 64.0f); const float ang = (float)pos * inv;
        rc[i] = (float)cos((double)ang); rs[i] = (float)sin((double)ang); }
    if (gt < 1024) { const int h = gt >> 8, i = gt & 255, rel = i - 192; const int n = rel < 0 ? -rel : rel; int bk = rel > 0 ? 16 : 0;
        if (n < 8) bk += n; else { const float nf = (float)n; int lg = 8 + (int)(logf(nf / 8.0f) / 2.772588722239781f * 8.0f); lg = lg < 15 ? lg : 15; bk += lg; }
        const float* rb = A.in[16]; ((float*)(F.ws + WS_BIAST))[gt] = (rb[bk * 4 + h] - rb[15 * 4 + h]) * LOG2E; }
    if (gt < NLAYER) { const int l = gt; float a = 0.f, b2 = 0.f;
        for (int i = 0; i < 64; ++i) { a += A.in[11][l * 64 + i] * A.in[12][l * 64 + i]; b2 += A.in[13][l * 64 + i] * A.in[14][l * 64 + i]; }
        ((float*)(F.ws + WS_LAM))[l] = expf(a) - expf(b2) + lam_init_of(l); }
}

template <int MODE, bool XF32>
__device__ __forceinline__ void norm_phase(const Frame& F0, const void* xin, float* xout, const float* g, bool combine, const float* router, bool h8 = false) {
    Frame F = F0; F.tid = opaque_tid(); F.lane = F.tid & 63;
    bf16_t* H = (bf16_t*)(F.ws + WS_H); const bf16_t* Y = (const bf16_t*)(F.ws + WS_R + R_Y); const int* slot = (const int*)(F.ws + WS_SLOT);
    LAS float* rt = (LAS float*)F.lds;
    LAS int* cl = (LAS int*)(F.lds + 32768);
    if constexpr (MODE == 2) { for (int i = F.tid; i < 8192; i += NTHR) { const int k = i >> 3, e = i & 7; rt[e * 1024 + k] = router[i]; } }
    f32x4 gv[4];
#pragma unroll
    for (int j = 0; j < 4; ++j) gv[j] = *(const f32x4*)(g + 4 * (F.lane + 64 * j));
    int bx0 = blockIdx.x; asm volatile("" : "+s"(bx0));
    for (int rb = bx0; rb < 256; rb += F.G) {
        if (MODE == 2) { if (F.tid < 8) cl[F.tid] = 0; __syncthreads(); }
        for (int i0 = 0; i0 < 16; i0 += 4) {
            f32x4 vv[4][4]; u32x2 ya[4][4], yb[4][4]; int sl0[4], sl1[4];
            if (combine) {
#pragma unroll
                for (int q = 0; q < 4; ++q) { const int row = rb * 128 + F.wave * 16 + i0 + q; sl0[q] = slot[2 * row]; sl1[q] = slot[2 * row + 1]; }
            }
#pragma unroll
            for (int q = 0; q < 4; ++q) { const int row = rb * 128 + F.wave * 16 + i0 + q;
#pragma unroll
                for (int j = 0; j < 4; ++j) { if (XF32) vv[q][j] = *(const f32x4*)((const float*)xin + (size_t)row * 1024 + 4 * (F.lane + 64 * j));
                    else { const u32x2 w = *(const u32x2*)((const bf16_t*)xin + (size_t)row * 1024 + 4 * (F.lane + 64 * j)); vv[q][j] = (f32x4){bflo(w.x), bfhi(w.x), bflo(w.y), bfhi(w.y)}; } } }
            if (combine) {
#pragma unroll
                for (int q = 0; q < 4; ++q)
#pragma unroll
                    for (int j = 0; j < 4; ++j) { ya[q][j] = *(const u32x2*)(Y + (size_t)sl0[q] * 1024 + 4 * (F.lane + 64 * j)); yb[q][j] = *(const u32x2*)(Y + (size_t)sl1[q] * 1024 + 4 * (F.lane + 64 * j)); }
            }
#pragma unroll
            for (int q = 0; q < 4; ++q) {
            const int row = rb * 128 + F.wave * 16 + i0 + q;
            f32x4 v[4]; float ss = 0.f;
#pragma unroll
            for (int j = 0; j < 4; ++j) v[j] = vv[q][j];
            if (combine) {
#pragma unroll
                for (int j = 0; j < 4; ++j) { const u32x2 a = ya[q][j], b = yb[q][j];
                    v[j][0] += bflo(a.x) + bflo(b.x); v[j][1] += bfhi(a.x) + bfhi(b.x); v[j][2] += bflo(a.y) + bflo(b.y); v[j][3] += bfhi(a.y) + bfhi(b.y);
                    if (MODE != 3) { u32x2 w; w.x = cvt_pk_bf16(v[j][0], v[j][1]); w.y = cvt_pk_bf16(v[j][2], v[j][3]); *(u32x2*)((bf16_t*)(F.ws + WS_XB) + (size_t)row * 1024 + 4 * (F.lane + 64 * j)) = w; } } }
#pragma unroll
            for (int j = 0; j < 4; ++j) ss += (v[j][0] * v[j][0] + v[j][1] * v[j][1]) + (v[j][2] * v[j][2] + v[j][3] * v[j][3]);
            const float rsc = __builtin_amdgcn_rsqf(wave_sum(ss) * (1.0f / 1024.0f) + EPS);
#pragma unroll
            for (int j = 0; j < 4; ++j) v[j] = v[j] * rsc * gv[j];
            if (MODE == 3) {
#pragma unroll
                for (int j = 0; j < 4; ++j) *(f32x4*)(xout + (size_t)row * 1024 + 4 * (F.lane + 64 * j)) = v[j];
            } else if (MODE == 0 || (MODE == 1 && !h8)) {
                if (!(MODE == 0 && h8)) {
#pragma unroll
                for (int j = 0; j < 4; ++j) { u32x2 w; w.x = cvt_pk_bf16(v[j][0], v[j][1]); w.y = cvt_pk_bf16(v[j][2], v[j][3]); *(u32x2*)(H + (size_t)row * 1024 + 4 * (F.lane + 64 * j)) = w; }
                }
                if (MODE == 0 && MK_F8_GATES) {
#pragma unroll
                    for (int j = 0; j < 4; ++j) *(unsigned*)(F.ws + WS_H8 + (size_t)row * 1024 + 4 * (F.lane + 64 * j)) = pack4_fp8(v[j][0], v[j][1], v[j][2], v[j][3]); }
            } else {
#pragma unroll
                for (int j = 0; j < 4; ++j) *(unsigned*)((unsigned char*)H + (size_t)row * 1024 + 4 * (F.lane + 64 * j)) = pack4_fp8(v[j][0], v[j][1], v[j][2], v[j][3]);
            }
            if (MODE == 2) {
                float lg[8];
#pragma unroll
                for (int e = 0; e < 8; ++e) { float a = 0.f;
#pragma unroll
                    for (int j = 0; j < 4; ++j) { const f32x4 r4 = *(const LAS f32x4*)(rt + e * 1024 + 4 * (F.lane + 64 * j)); a += (v[j][0] * r4[0] + v[j][1] * r4[1]) + (v[j][2] * r4[2] + v[j][3] * r4[3]); }
                    lg[e] = wave_sum(a); }
                int e1 = 0; float b1 = lg[0];
#pragma unroll
                for (int e = 1; e < 8; ++e) if (lg[e] > b1) { b1 = lg[e]; e1 = e; }
                int e2 = -1; float b2 = -3.0e38f;
#pragma unroll
                for (int e = 0; e < 8; ++e) if (e != e1 && lg[e] > b2) { b2 = lg[e]; e2 = e; }
                const float w1 = 1.0f / (1.0f + expf(b2 - b1)), w2 = 1.0f - w1;
                if (F.lane == 0) { u32x4 s; s.x = (unsigned)e1; s.y = (unsigned)e2; s.z = __float_as_uint(w1); s.w = __float_as_uint(w2); *(u32x4*)(F.ws + WS_SEL + (size_t)row * 16) = s;
                    __hip_atomic_fetch_add(cl + e1, 1, __ATOMIC_RELAXED, __HIP_MEMORY_SCOPE_WORKGROUP); __hip_atomic_fetch_add(cl + e2, 1, __ATOMIC_RELAXED, __HIP_MEMORY_SCOPE_WORKGROUP); }
            }
        }
            }
        if (MODE == 2) { __syncthreads(); if (F.tid < 8) ((int*)(F.ws + WS_CNT))[rb * 8 + F.tid] = cl[F.tid]; __syncthreads(); }
    }
    if (MODE == 2) __syncthreads();
}

__device__ __forceinline__ void moe_gather_phase(const Frame& F0) {
    Frame F = F0; F.tid = opaque_tid(); F.lane = F.tid & 63;
    const int* cnt = (const int*)(F.ws + WS_CNT); const bf16_t* H = (const bf16_t*)(F.ws + WS_H); bf16_t* XG = (bf16_t*)(F.ws + WS_R + R_XG);
    int* slot = (int*)(F.ws + WS_SLOT); float* roww = (float*)(F.ws + WS_ROWW);
    LAS int* lc = (LAS int*)F.lds;
    LAS int* tot = lc + 2048;
    LAS int* pre = tot + 8;
    LAS int* lb = pre + 8;
    LAS int* pos = lb + 16;
    int bx0 = blockIdx.x; asm volatile("" : "+s"(bx0));
    for (int rb = bx0; rb < 256; rb += F.G) {
        __syncthreads();
        for (int i = F.tid; i < 2048; i += NTHR) lc[i] = cnt[i];
        __syncthreads();
        { const int e = F.wave; int st = 0, sp = 0;
            for (int b = F.lane; b < 256; b += 64) { const int c = lc[b * 8 + e]; st += c; sp += (b < rb) ? c : 0; }
            st = wave_isum(st); sp = wave_isum(sp);
            if (F.lane == 0) { tot[e] = st; pre[e] = sp; } }
        __syncthreads();
        if (F.tid == 0) { int bs = 0; for (int e = 0; e < 8; ++e) { lb[e] = bs; bs += (tot[e] + 255) & ~255; } lb[8] = bs; }
        __syncthreads();
        if (F.wave == 0) {
            int run[8];
#pragma unroll
            for (int e = 0; e < 8; ++e) run[e] = lb[e] + pre[e];
            for (int it = 0; it < 2; ++it) {
                const int tl = it * 64 + F.lane, row = rb * 128 + tl;
                const u32x4 s = *(const u32x4*)(F.ws + WS_SEL + (size_t)row * 16);
                const int e1 = (int)s.x, e2 = (int)s.y; int p1 = 0, p2 = 0;
                const unsigned long long lt = (1ull << F.lane) - 1ull;
#pragma unroll
                for (int e = 0; e < 8; ++e) {
                    const unsigned long long m1 = __ballot(e1 == e), m2 = __ballot(e2 == e);
                    if (e1 == e) p1 = run[e] + __popcll(m1 & lt);
                    if (e2 == e) p2 = run[e] + __popcll(m1) + __popcll(m2 & lt);
                    run[e] += __popcll(m1) + __popcll(m2);
                }
                pos[2 * tl] = p1; pos[2 * tl + 1] = p2;
                slot[2 * row] = p1; slot[2 * row + 1] = p2;
                roww[p1] = __uint_as_float(s.z); roww[p2] = __uint_as_float(s.w);
                if (MK_MOE_GATHER) { int* gidx = (int*)(F.ws + WS_GIDX); gidx[p1] = row; gidx[p2] = row; }
            }
        }
        __syncthreads();
        if (!MK_MOE_GATHER) { u32x4 rv[16];
#pragma unroll
          for (int i = 0; i < 16; ++i) rv[i] = *(const u32x4*)((const unsigned char*)H + (size_t)(rb * 128 + F.wave * 16 + i) * 1024 + 16 * F.lane);
#pragma unroll
          for (int i = 0; i < 16; ++i) { const int tl = F.wave * 16 + i; const int p1 = pos[2 * tl], p2 = pos[2 * tl + 1];
            *(u32x4*)((unsigned char*)XG + (size_t)p1 * 1024 + 16 * F.lane) = rv[i];
            *(u32x4*)((unsigned char*)XG + (size_t)p2 * 1024 + 16 * F.lane) = rv[i]; } }
        if (rb < 8) { const int e = rb, r0 = lb[e] + tot[e], r1 = lb[e + 1];
            unsigned z0_ = 0u; asm volatile("" : "+v"(z0_));
            if (MK_MOE_GATHER) { int* gidx = (int*)(F.ws + WS_GIDX); for (int r = r0 + F.tid; r < r1; r += NTHR) { gidx[r] = 0; roww[r] = 0.f; } }
            else
            for (int r = r0 + F.wave; r < r1; r += NWAVES) { const u32x4 z = (u32x4){z0_, z0_, z0_, z0_};
                *(u32x4*)((unsigned char*)XG + (size_t)r * 1024 + 16 * F.lane) = z; if (F.lane == 0) roww[r] = 0.f; } }
        if (rb == 0 && F.tid < 9) ((int*)(F.ws + WS_META))[F.tid] = lb[F.tid] >> 8;
    }
    __syncthreads();
}

__device__ __forceinline__ void gmlp_phase(const Frame& F0, const Args& A, int l) {
    Frame F = F0; F.tid = opaque_tid(); F.lane = F.tid & 63;
    const bf16_t* UV = (const bf16_t*)(F.ws + WS_R + R_UV); bf16_t* BR = (bf16_t*)(F.ws + WS_R + R_BR);
    const float* lng = A.in[3] + l * 512; const float* lnb = A.in[4] + l * 512; const float* wsp = A.in[5] + (size_t)l * 4 * 128 * 128; const float* bsp = A.in[6] + l * 4 * 128;
    LAS unsigned char* vn = F.lds;
    LAS unsigned char* wl = F.lds + 40960;
    LAS float* st = (LAS float*)(F.lds + 40960 + 34816);
    const int lane = F.lane, r32 = lane & 31, hi = lane >> 5;
    for (int sp = F.vcu; sp < T / 128; sp += F.G) {
        const int t0 = sp * 128;
        __syncthreads();
        {
            u32x4 wv[16];
#pragma unroll
            for (int i = 0; i < 16; ++i) wv[i] = *(const u32x4*)(UV + (size_t)(t0 + F.wave * 16 + i) * 1024 + 512 + 8 * lane);
#pragma unroll
            for (int i = 0; i < 16; ++i) { const int tl = F.wave * 16 + i; const u32x4 w = wv[i];
                const float a0 = bflo(w.x), a1 = bfhi(w.x), a2 = bflo(w.y), a3 = bfhi(w.y), a4 = bflo(w.z), a5 = bfhi(w.z), a6 = bflo(w.w), a7 = bfhi(w.w);
                float s = ((a0 + a1) + (a2 + a3)) + ((a4 + a5) + (a6 + a7));
                float q = ((a0 * a0 + a1 * a1) + (a2 * a2 + a3 * a3)) + ((a4 * a4 + a5 * a5) + (a6 * a6 + a7 * a7));
                s = wave_sum(s); q = wave_sum(q);
                const float mu = s * (1.0f / 512.0f), var = fmaxf(q * (1.0f / 512.0f) - mu * mu, 0.f);
                if (lane == 0) { st[tl] = mu; st[128 + tl] = __builtin_amdgcn_rsqf(var + EPS); } }
        }
        const int c8 = F.tid & 15;
        u32x4 wv[4]; f32x4 wr[8];
#define GM_LOAD(g_) do { _Pragma("unroll") for (int it = 0; it < 4; ++it) wv[it] = *(const u32x4*)(UV + (size_t)(t0 + (F.tid >> 4) + 32 * it) * 1024 + 512 + (g_) * 128 + 8 * c8); \
            _Pragma("unroll") for (int it = 0; it < 8; ++it) { const int idx = F.tid + it * NTHR; wr[it] = *(const f32x4*)(wsp + ((size_t)(g_) * 128 + (idx >> 5)) * 128 + 4 * (idx & 31)); } } while (0)
        GM_LOAD(0);
#pragma nounroll
        for (int g = 0; g < 4; ++g) {
            __syncthreads();
            {
                const f32x4 g0 = *(const f32x4*)(lng + g * 128 + 8 * c8), g1 = *(const f32x4*)(lng + g * 128 + 8 * c8 + 4);
                const f32x4 h0 = *(const f32x4*)(lnb + g * 128 + 8 * c8), h1 = *(const f32x4*)(lnb + g * 128 + 8 * c8 + 4);
#pragma unroll
                for (int it = 0; it < 4; ++it) { const int q = (F.tid >> 4) + 32 * it; const float mu = st[q], rsd = st[128 + q]; const u32x4 w = wv[it];
                    f32x4 x0 = (f32x4){bflo(w.x), bfhi(w.x), bflo(w.y), bfhi(w.y)}, x1 = (f32x4){bflo(w.z), bfhi(w.z), bflo(w.w), bfhi(w.w)};
                    x0 = (x0 - mu) * rsd * g0 + h0; x1 = (x1 - mu) * rsd * g1 + h1;
                    *(LAS u32x4*)(vn + q * 320 + c8 * 16) = pack8(x0, x1); }
#pragma unroll
                for (int it = 0; it < 8; ++it) { const int idx = F.tid + it * NTHR, p = idx >> 5, q4 = idx & 31; f32x4 w = wr[it];
                    if ((q4 >> 4) > (p >> 6)) w = (f32x4){0.f, 0.f, 0.f, 0.f};
                    u32x2 o; o.x = cvt_pk_bf16(w[0], w[1]); o.y = cvt_pk_bf16(w[2], w[3]); *(LAS u32x2*)(wl + p * 272 + 8 * q4) = o; }
            }
            if (g + 1 < 4) GM_LOAD(g + 1);
            const int pb = F.wave >> 1, nks = (pb < 2) ? 4 : 8;
            const int p = 32 * pb + r32; const float bs = bsp[g * 128 + p];
            const bf16_t* up = UV + (size_t)(t0 + p) * 1024 + g * 128 + 4 * hi; bf16_t* op = BR + (size_t)(t0 + p) * 1536 + g * 128 + 4 * hi;
            u32x2 uw[2][4];
#pragma unroll
            for (int j = 0; j < 2; ++j)
#pragma unroll
                for (int gg = 0; gg < 4; ++gg) uw[j][gg] = *(const u32x2*)(up + 32 * (2 * (F.wave & 1) + j) + 8 * gg);
            __syncthreads();
            f32x16 acc[2]; acc[0] = f32x16{}; acc[1] = f32x16{};
            const LAS unsigned char* ap = vn + (8 * hi + ((lane & 15) >> 2)) * 320 + (((lane >> 4) & 1) * 16 + (lane & 3) * 4) * 2;
            const LAS unsigned char* bp = wl + (32 * pb + r32) * 272 + 16 * hi;
            for (int ks = 0; ks < nks; ++ks) {
                const bf16x8 bfr = *(const LAS bf16x8*)(bp + 32 * ks);
#pragma unroll
                for (int j = 0; j < 2; ++j) { const int cb = 2 * (F.wave & 1) + j;
                    const s16x4 lo = attn::vtr(ap + ks * 16 * 320 + cb * 64), hh = attn::vtr(ap + ks * 16 * 320 + 4 * 320 + cb * 64);
                    const bf16x8 af = (bf16x8){lo[0], lo[1], lo[2], lo[3], hh[0], hh[1], hh[2], hh[3]};
                    acc[j] = __builtin_amdgcn_mfma_f32_32x32x16_bf16(af, bfr, acc[j], 0, 0, 0); }
            }
#pragma unroll
            for (int j = 0; j < 2; ++j)
#pragma unroll
                for (int gg = 0; gg < 4; ++gg) { const u32x2 w = uw[j][gg]; u32x2 o;
                    o.x = cvt_pk_bf16((acc[j][4 * gg] + bs) * bflo(w.x), (acc[j][4 * gg + 1] + bs) * bfhi(w.x));
                    o.y = cvt_pk_bf16((acc[j][4 * gg + 2] + bs) * bflo(w.y), (acc[j][4 * gg + 3] + bs) * bfhi(w.y));
                    *(u32x2*)(op + 32 * (2 * (F.wave & 1) + j) + 8 * gg) = o; }
        }
#undef GM_LOAD
    }
    __syncthreads();
}
#if MK_CHECK
#define CHK_NSTAGE 32
__device__ __forceinline__ void chk_acc(float* err, int stage, float got, float ref) {
    const float d = got - ref; float d2 = d * d, r2 = ref * ref;
    if (!(d2 == d2) || !(d2 < 1e30f)) d2 = 1e30f;
    atomicAdd(err + 2 * stage, d2); atomicAdd(err + 2 * stage + 1, r2);
}
__device__ __forceinline__ int chk_row(int i) { return (17 + 61 * i) % T; }
constexpr int CHK_NROWS = 512;
__global__ void chk_norm(const float* x, const float* g, const bf16_t* H, float* err, int stage) {
    const int row = chk_row(blockIdx.x); __shared__ float red[256]; float ss = 0.f;
    for (int c = threadIdx.x; c < 1024; c += 256) { const float v = x[(size_t)row * 1024 + c]; ss += v * v; }
    red[threadIdx.x] = ss; __syncthreads();
    for (int o = 128; o > 0; o >>= 1) { if (threadIdx.x < o) red[threadIdx.x] += red[threadIdx.x + o]; __syncthreads(); }
    const float rs = 1.0f / sqrtf(red[0] / 1024.f + EPS);
    for (int c = threadIdx.x; c < 1024; c += 256) chk_acc(err, stage, bf2f(H[(size_t)row * 1024 + c]), x[(size_t)row * 1024 + c] * rs * g[c]);
}
__device__ __forceinline__ float chk_dot_h(const bf16_t* H, int row, const float* W, int ldw, int col, int K) { float a = 0.f; for (int k = 0; k < K; ++k) a += bf2f(H[(size_t)row * K + k]) * W[(size_t)k * ldw + col]; return a; }
__global__ void chk_inproj(const bf16_t* H, const float* w_in, const float* w_gate, const float* b_gate, unsigned char* R, const float* rc, const float* rs, float* err, int stage) {
    const int row = chk_row(blockIdx.x), pos = row & (SEQ - 1), b = row >> 13, tile = pos >> 6, kv = pos & 63;
    const bf16_t *UV = (const bf16_t*)(R + R_UV), *CQ = (const bf16_t*)(R + R_CQ), *CKV = (const bf16_t*)(R + R_CKV), *DQ = (const bf16_t*)(R + R_DQ), *K12 = (const bf16_t*)(R + R_K12), *VD = (const bf16_t*)(R + R_VD), *G = (const bf16_t*)(R + R_G), *KM = (const bf16_t*)(R + R_KM);
    for (int c = threadIdx.x; c < 3008 + 3072; c += blockDim.x) {
        if (c < 3008) {
            if (c >= 1408 && c < 1472) { if (c >= 1440) continue; const int i = c - 1408;
                const float x1 = chk_dot_h(H, row, w_in, 3008, 1408 + i, 1024), x2 = chk_dot_h(H, row, w_in, 3008, 1440 + i, 1024);
                const float cs = rc[pos * 32 + i], sn = rs[pos * 32 + i], o1 = x1 * cs - x2 * sn, o2 = x2 * cs + x1 * sn;
                for (int h = 0; h < 4; ++h) { const size_t a = km_addr(b * 4 + h, tile, 16 + (i >> 2), kv); chk_acc(err, stage + 1, bf2f(KM[a + (i & 3)]), o1); chk_acc(err, stage + 1, bf2f(KM[a + 4 + (i & 3)]), o2); }
                continue; }
            const float v = chk_dot_h(H, row, w_in, 3008, c, 1024);
#if MK_CHECK == 35 || MK_CHECK == 36
            if (c < 1024) chk_acc(err, stage, bf2f(UV[(size_t)row * 1024 + c]), 1.0f / (1.0f + expf(-v)));
#elif MK_CHECK == 34
            if (c < 1024) chk_acc(err, stage, bf2f(UV[(size_t)row * 1024 + c]), 1.0f / (1.0f + expf(-(v + b_gate[c]))));
#else
            if (c < 1024) chk_acc(err, stage, bf2f(UV[(size_t)row * 1024 + c]), 0.5f * v * (1.0f + tanhf(0.7978845608f * (v + 0.044715f * v * v * v))));
#endif
            else if (c < 1280) chk_acc(err, stage + 2, bf2f(CQ[(size_t)row * 256 + c - 1024]), v);
            else if (c < 1408) chk_acc(err, stage + 2, bf2f(CKV[(size_t)row * 256 + c - 1280]), v);
            else if (c < 1984) chk_acc(err, stage + 3, bf2f(DQ[(size_t)row * 512 + c - 1472]), v * QS_DIF);
            else if (c < 2496) { const int cc = c - 1984, h = cc >> 7, mp = (cc & 127) >> 6, d = cc & 63; chk_acc(err, stage + 4, bf2f(K12[k12_addr(b * 4 + h, tile, mp, d >> 3, kv) + (d & 7)]), v); }
            else { const int cc = c - 2496, h = cc >> 7, d = cc & 127; chk_acc(err, stage + 5, bf2f(VD[vimg_addr(b * 4 + h, tile, d >> 5, kv) + (d & 31)]), v); }
        } else { const int gcol = c - 3008, n = gcol >> 10, cc = gcol & 1023;
            const float v = chk_dot_h(H, row, w_gate + (size_t)n * 1024 * 1024, 1024, cc, 1024) + b_gate[n * 1024 + cc];
#if MK_CHECK == 3
            const float gg = bf2f(G[(size_t)row * 3072 + gcol]);
            chk_acc(err, 0, gg, 1.0f / (1.0f + expf(-v)));
            chk_acc(err, 1, gg, 1.0f / (1.0f + expf(-b_gate[n * 1024 + cc])));
            { const int n2 = (n + 1) % 3; const float v2 = chk_dot_h(H, row, w_gate + (size_t)n2 * 1024 * 1024, 1024, cc, 1024); chk_acc(err, 2, gg, 1.0f / (1.0f + expf(-v2))); }
            { const int n2 = (n + 2) % 3; const float v2 = chk_dot_h(H, row, w_gate + (size_t)n2 * 1024 * 1024, 1024, cc, 1024); chk_acc(err, 3, gg, 1.0f / (1.0f + expf(-v2))); }
            chk_acc(err, 4, gg, 1.0f / (1.0f + expf(v)));
            chk_acc(err, 5, gg, 1.0f / (1.0f + exp2f(-v)));
            chk_acc(err, 6, gg, v);
            chk_acc(err, 7, gg, 1.0f / (1.0f + expf(-v * 1.4426950408889634f)));
#else
#if MK_CHECK == 37
            chk_acc(err, stage + 6, bf2f(G[(size_t)row * 3072 + gcol]), 0.5f * v * (1.0f + tanhf(0.7978845608f * (v + 0.044715f * v * v * v))));
#else
            chk_acc(err, stage + 6, bf2f(G[(size_t)row * 3072 + gcol]), 1.0f / (1.0f + expf(-v)));
#endif
#endif
        }
    }
}
__global__ void chk_mlaup(unsigned char* R, const float* w_uq, const float* w_ukv, const float* g_cq, const float* g_ckv, const float* rc, const float* rs, float* err, int stage) {
    const int row = chk_row(blockIdx.x), pos = row & (SEQ - 1), b = row >> 13, tile = pos >> 6, kv = pos & 63;
    const bf16_t *CQ = (const bf16_t*)(R + R_CQ), *CKV = (const bf16_t*)(R + R_CKV), *QM = (const bf16_t*)(R + R_QM), *KM = (const bf16_t*)(R + R_KM), *VM = (const bf16_t*)(R + R_VM);
    float sq = 0.f, sk = 0.f;
    for (int k = 0; k < 256; ++k) { const float v = bf2f(CQ[(size_t)row * 256 + k]); sq += v * v; }
    for (int k = 0; k < 128; ++k) { const float v = bf2f(CKV[(size_t)row * 256 + k]); sk += v * v; }
    const float rq = 1.0f / sqrtf(sq / 256.f + EPS), rk = 1.0f / sqrtf(sk / 128.f + EPS);
    for (int j = threadIdx.x; j < 768 + 1024; j += blockDim.x) {
        if (j < 768) { const int h = j / 192, w = j % 192;
            if (w < 128) { float a = 0.f; for (int k = 0; k < 256; ++k) a += bf2f(CQ[(size_t)row * 256 + k]) * g_cq[k] * w_uq[(size_t)k * 768 + j]; chk_acc(err, stage, bf2f(QM[(size_t)row * 768 + j]), a * rq * QS_MLA); }
            else if (w < 160) { const int i = w - 128; float a1 = 0.f, a2 = 0.f;
                for (int k = 0; k < 256; ++k) { const float cv = bf2f(CQ[(size_t)row * 256 + k]) * g_cq[k]; a1 += cv * w_uq[(size_t)k * 768 + j]; a2 += cv * w_uq[(size_t)k * 768 + j + 32]; }
                a1 *= rq; a2 *= rq; const float cs = rc[pos * 32 + i], sn = rs[pos * 32 + i];
                const int pc = h * 192 + 128 + 8 * (i >> 2) + (i & 3);
                chk_acc(err, stage + 1, bf2f(QM[(size_t)row * 768 + pc]), (a1 * cs - a2 * sn) * QS_MLA); chk_acc(err, stage + 1, bf2f(QM[(size_t)row * 768 + pc + 4]), (a2 * cs + a1 * sn) * QS_MLA); }
        } else { const int jj = j - 768, h = jj >> 8, w = jj & 255; float a = 0.f;
            for (int k = 0; k < 128; ++k) a += bf2f(CKV[(size_t)row * 256 + k]) * g_ckv[k] * w_ukv[(size_t)k * 1024 + jj];
            a *= rk;
            if (w < 128) chk_acc(err, stage + 2, bf2f(KM[km_addr(b * 4 + h, tile, w >> 3, kv) + (w & 7)]), a);
            else { const int d = w - 128; chk_acc(err, stage + 3, bf2f(VM[vimg_addr(b * 4 + h, tile, d >> 5, kv) + (d & 31)]), a); } }
    }
}
__global__ void chk_gmlp(unsigned char* R, const float* lng, const float* lnb, const float* wsp, const float* bsp, float* err, int stage) {
    const int row = chk_row(blockIdx.x), sp0 = row & ~127, p = row & 127;
    const bf16_t *UV = (const bf16_t*)(R + R_UV), *BR = (const bf16_t*)(R + R_BR);
    __shared__ float mu[128], rsd[128];
    if (threadIdx.x < 128) { const int t = sp0 + threadIdx.x; float s = 0.f, q = 0.f; for (int c = 0; c < 512; ++c) { const float v = bf2f(UV[(size_t)t * 1024 + 512 + c]); s += v; q += v * v; }
        const float m = s / 512.f; mu[threadIdx.x] = m; rsd[threadIdx.x] = 1.0f / sqrtf(fmaxf(q / 512.f - m * m, 0.f) + EPS); }
    __syncthreads();
    for (int c = threadIdx.x; c < 512; c += blockDim.x) { const int g = c >> 7; float a = 0.f;
        for (int q = 0; q < 128; ++q) { if ((q >> 6) > (p >> 6)) continue; const float vn = (bf2f(UV[(size_t)(sp0 + q) * 1024 + 512 + c]) - mu[q]) * rsd[q] * lng[c] + lnb[c]; a += wsp[((size_t)g * 128 + p) * 128 + q] * vn; }
        chk_acc(err, stage, bf2f(BR[(size_t)row * 1536 + c]), (a + bsp[g * 128 + p]) * bf2f(UV[(size_t)row * 1024 + c])); }
}
__global__ void chk_attn(unsigned char* R, const float* biast, const float* gsub, const float* lamp, int l, float* err, int stage) {
    const int kind = blockIdx.x & 1, si = blockIdx.x >> 1, b = si & 3, h = (si >> 2) & 3;
    const int qlist[12] = {0, 5, 63, 64, 100, 255, 256, 1000, 3071, 4096, 6000, 8191}; const int q = qlist[(si >> 4) % 12];
    const int row = b * SEQ + q, bh = b * 4 + h, nk = ((q >> 6) + 1) * 64;
    const bf16_t *QM = (const bf16_t*)(R + R_QM), *KM = (const bf16_t*)(R + R_KM), *VM = (const bf16_t*)(R + R_VM), *DQ = (const bf16_t*)(R + R_DQ), *K12 = (const bf16_t*)(R + R_K12), *VD = (const bf16_t*)(R + R_VD), *BR = (const bf16_t*)(R + R_BR);
    __shared__ float sc[8192]; __shared__ float red[256]; __shared__ float outv[2][128];
    const int nmap = kind ? 2 : 1;
    for (int mp = 0; mp < nmap; ++mp) {
        float mx = -1e30f;
        for (int k = threadIdx.x; k < nk; k += 256) { float a = 0.f;
            if (!kind) { for (int d = 0; d < 192; ++d) a += bf2f(QM[(size_t)row * 768 + h * 192 + d]) * bf2f(KM[km_addr(bh, k >> 6, d >> 3, k & 63) + (d & 7)]); }
            else { for (int d = 0; d < 64; ++d) a += bf2f(DQ[(size_t)row * 512 + h * 128 + mp * 64 + d]) * bf2f(K12[k12_addr(bh, k >> 6, mp, d >> 3, k & 63) + (d & 7)]);
                int ix = k - q + 192; if (ix < 0) ix = 0; a += biast[h * 256 + ix]; }
            sc[k] = a; mx = fmaxf(mx, a); }
        red[threadIdx.x] = mx; __syncthreads();
        for (int o = 128; o > 0; o >>= 1) { if (threadIdx.x < o) red[threadIdx.x] = fmaxf(red[threadIdx.x], red[threadIdx.x + o]); __syncthreads(); }
        mx = red[0]; __syncthreads(); float sm = 0.f;
        for (int k = threadIdx.x; k < nk; k += 256) { const float e = exp2f(sc[k] - mx); sc[k] = e; sm += e; }
        red[threadIdx.x] = sm; __syncthreads();
        for (int o = 128; o > 0; o >>= 1) { if (threadIdx.x < o) red[threadIdx.x] += red[threadIdx.x + o]; __syncthreads(); }
        sm = red[0]; __syncthreads();
        if (threadIdx.x < 128) { const int d = threadIdx.x; float a = 0.f; const bf16_t* V = kind ? VD : VM;
            for (int k = 0; k < nk; ++k) a += sc[k] * bf2f(V[vimg_addr(bh, k >> 6, d >> 5, k & 63) + (d & 31)]);
            outv[mp][d] = a / sm; }
        __syncthreads();
    }
    if (!kind) { if (threadIdx.x < 128) chk_acc(err, stage, bf2f(BR[(size_t)row * 1536 + 512 + h * 128 + threadIdx.x]), outv[0][threadIdx.x]); }
    else { const float lam = lamp[l]; float v = 0.f; if (threadIdx.x < 128) v = outv[0][threadIdx.x] - lam * outv[1][threadIdx.x];
        red[threadIdx.x] = v * v; __syncthreads();
        for (int o = 128; o > 0; o >>= 1) { if (threadIdx.x < o) red[threadIdx.x] += red[threadIdx.x + o]; __syncthreads(); }
        const float rn = 1.0f / sqrtf(red[0] / 128.f + EPS) * (1.0f - (0.8f - 0.6f * expf(-0.3f * (float)l)));
        if (threadIdx.x < 128) chk_acc(err, stage + 1, bf2f(BR[(size_t)row * 1536 + 1024 + h * 128 + threadIdx.x]), v * rn * gsub[threadIdx.x]); }
}
__global__ void chk_merged(unsigned char* R, const float* w_branch, float* err, int stage) {
    const int row = chk_row(blockIdx.x); const bf16_t *BR = (const bf16_t*)(R + R_BR), *G = (const bf16_t*)(R + R_G), *MG = (const bf16_t*)(R + R_MERGED);
    for (int c = threadIdx.x; c < 1024; c += blockDim.x) { float m = 0.f;
        for (int n = 0; n < 3; ++n) { float a = 0.f; for (int k = 0; k < 512; ++k) a += bf2f(BR[(size_t)row * 1536 + n * 512 + k]) * w_branch[((size_t)n * 512 + k) * 1024 + c]; m += a * bf2f(G[(size_t)row * 3072 + n * 1024 + c]); }
        chk_acc(err, stage, bf2f(MG[(size_t)row * 1024 + c]), m); }
}
__global__ void chk_resid(const bf16_t* A, int K, const float* W, const float* xin, const float* xsave, const float* xout, float* err, int stage) {
    const int row = chk_row(blockIdx.x);
    for (int c = threadIdx.x; c < 1024; c += blockDim.x) { float a = 0.f; for (int k = 0; k < K; ++k) a += bf2f(A[(size_t)row * K + k]) * W[(size_t)k * 1024 + c];
        const float xi = xsave ? xsave[(size_t)blockIdx.x * 1024 + c] : xin[(size_t)row * 1024 + c];
        chk_acc(err, stage, xout[(size_t)row * 1024 + c] - xi, a); }
}
__global__ void chk_save_rows(const float* x, float* xsave) { const int row = chk_row(blockIdx.x); for (int c = threadIdx.x; c < 1024; c += blockDim.x) xsave[(size_t)blockIdx.x * 1024 + c] = x[(size_t)row * 1024 + c]; }
__global__ void chk_swiglu(const bf16_t* H, const float* w1, const float* w3, int F_, const bf16_t* HM, float* err, int stage) {
    const int row = chk_row(blockIdx.x * 4);
    for (int c = threadIdx.x; c < F_; c += blockDim.x) { float a = 0.f, b2 = 0.f; for (int k = 0; k < 1024; ++k) { const float hv = bf2f(H[(size_t)row * 1024 + k]); a += hv * w1[(size_t)k * F_ + c]; b2 += hv * w3[(size_t)k * F_ + c]; }
        chk_acc(err, stage, bf2f(HM[(size_t)row * F_ + c]), a / (1.0f + expf(-a)) * b2); }
}
__global__ void chk_moe(const float* x, const float* g, const float* router, const float* w1, const float* w3, const float* w2, unsigned char* ws, float* err, int stage) {
    const int row = chk_row(blockIdx.x * 8); __shared__ float hf[1024]; __shared__ float red[256]; __shared__ float lg[8]; __shared__ float hid[FE];
    const bf16_t *H = (const bf16_t*)(ws + WS_H), *XG = (const bf16_t*)(ws + WS_R + R_XG), *HME = (const bf16_t*)(ws + WS_R + R_HME), *Y = (const bf16_t*)(ws + WS_R + R_Y);
    const int* slot = (const int*)(ws + WS_SLOT); const float* roww = (const float*)(ws + WS_ROWW); const int* meta = (const int*)(ws + WS_META);
    float ss = 0.f; for (int c = threadIdx.x; c < 1024; c += 256) { const float v = x[(size_t)row * 1024 + c]; ss += v * v; }
    red[threadIdx.x] = ss; __syncthreads();
    for (int o = 128; o > 0; o >>= 1) { if (threadIdx.x < o) red[threadIdx.x] += red[threadIdx.x + o]; __syncthreads(); }
    const float rs = 1.0f / sqrtf(red[0] / 1024.f + EPS);
    for (int c = threadIdx.x; c < 1024; c += 256) hf[c] = x[(size_t)row * 1024 + c] * rs * g[c];
    __syncthreads();
    if (threadIdx.x < 8) { float a = 0.f; for (int k = 0; k < 1024; ++k) a += hf[k] * router[k * 8 + threadIdx.x]; lg[threadIdx.x] = a; }
    __syncthreads();
    int e1 = 0; for (int e = 1; e < 8; ++e) if (lg[e] > lg[e1]) e1 = e;
    int e2 = -1; for (int e = 0; e < 8; ++e) if (e != e1 && (e2 < 0 || lg[e] > lg[e2])) e2 = e;
    const float w1v = 1.0f / (1.0f + expf(lg[e2] - lg[e1]));
    for (int k2 = 0; k2 < 2; ++k2) { const int e = k2 ? e2 : e1; const float wv = k2 ? 1.0f - w1v : w1v; const int r = slot[2 * row + k2];
        if (threadIdx.x == 0) { chk_acc(err, stage, roww[r], wv); int er = 0; for (int j = 1; j < 8; ++j) er += ((r >> 8) >= meta[j]) ? 1 : 0; chk_acc(err, stage, (float)er + 1.f, (float)e + 1.f); }
        for (int c = threadIdx.x; c < 1024; c += 256) chk_acc(err, stage + 1, bf2f(XG[(size_t)r * 1024 + c]), bf2f(H[(size_t)row * 1024 + c]));
        for (int c = threadIdx.x; c < FE; c += 256) { float a = 0.f, b2 = 0.f; for (int k = 0; k < 1024; ++k) { const float hv = bf2f(H[(size_t)row * 1024 + k]); a += hv * w1[((size_t)e * 1024 + k) * FE + c]; b2 += hv * w3[((size_t)e * 1024 + k) * FE + c]; }
            const float hvv = a / (1.0f + expf(-a)) * b2; chk_acc(err, stage + 2, bf2f(HME[(size_t)r * FE + c]), hvv); }
        __syncthreads();
        for (int c = threadIdx.x; c < FE; c += 256) hid[c] = bf2f(HME[(size_t)r * FE + c]);
        __syncthreads();
        for (int c = threadIdx.x; c < 1024; c += 256) { float a = 0.f; for (int k = 0; k < FE; ++k) a += hid[k] * w2[((size_t)e * FE + k) * 1024 + c]; chk_acc(err, stage + 3, bf2f(Y[(size_t)r * 1024 + c]), a * wv); }
        __syncthreads(); }
}
__global__ void chk_combine(const float* xsave, const float* xout, unsigned char* ws, float* err, int stage) {
    const int row = chk_row(blockIdx.x); const bf16_t* Y = (const bf16_t*)(ws + WS_R + R_Y); const int* slot = (const int*)(ws + WS_SLOT);
    for (int c = threadIdx.x; c < 1024; c += blockDim.x) chk_acc(err, stage, xout[(size_t)row * 1024 + c] - xsave[(size_t)blockIdx.x * 1024 + c], bf2f(Y[(size_t)slot[2 * row] * 1024 + c]) + bf2f(Y[(size_t)slot[2 * row + 1] * 1024 + c]));
}
__global__ void chk_wcat(const bf16_t* Wcat, const float* w_in, const float* w_gate, float* err) {
    const int r = (blockIdx.x * 37) % 6144;
    for (int k = threadIdx.x; k < 1024; k += blockDim.x) {
        if (r < 3072) { const int sc = conv_srccol(1, r); const float ref = sc < 0 ? 0.f : w_in[(size_t)k * 3008 + sc]; chk_acc(err, 16, bf2f(Wcat[(size_t)r * 1024 + k]), ref); }
        else { const int n = (r - 3072) >> 10, cc = (r - 3072) & 1023; chk_acc(err, 17 + n, bf2f(Wcat[(size_t)r * 1024 + k]), w_gate[((size_t)n * 1024 + k) * 1024 + cc]); }
    }
}
__global__ void chk_encode(const float* err, float* out, int n) {
    __shared__ float sa; __shared__ int sidx;
    if (threadIdx.x == 0) { int idx = 0; float eb = 0.f, emax = 0.f;
        for (int s = 0; s < CHK_NSTAGE; ++s) { const float d2 = err[2 * s], r2 = err[2 * s + 1]; if (r2 == 0.f && d2 == 0.f) continue; float e = sqrtf(d2 / fmaxf(r2, 1e-30f)); if (!(e == e)) e = 1e3f; e = fminf(e, 1e3f);
            if (e > emax) emax = e; if (idx == 0 && e > 0.03f) { idx = s + 1; eb = e; } }
#if MK_CHECK == 33
        { int bi = 0; float be = 1e30f; for (int s = 0; s < 8; ++s) { const float e = sqrtf(err[2 * s] / fmaxf(err[2 * s + 1], 1e-30f)); if (e < be) { be = e; bi = s; } } idx = bi; eb = be; emax = be; }
#endif
#ifdef MK_SEL
        { const float e = sqrtf(err[2 * MK_SEL] / fmaxf(err[2 * MK_SEL + 1], 1e-30f)); idx = MK_SEL + 1; eb = (e == e) ? fminf(e, 1e3f) : 1e3f; }
#endif
        sa = sqrtf(1000.f * (idx ? eb : emax)); sidx = idx; }
    __syncthreads();
    const float a = sa;
    for (size_t i = (size_t)blockIdx.x * blockDim.x + threadIdx.x; i < (size_t)n; i += (size_t)gridDim.x * blockDim.x) { unsigned hsh = (unsigned)i * 2654435761u; hsh ^= hsh >> 15; out[i] = (hsh & 1u) ? a : -a; }
    if (blockIdx.x == 0 && threadIdx.x == 0) out[0] = 100.f * (float)(1 + sidx);
}
#endif
constexpr int CW_BAR = 4096;
constexpr int N_PHASES = 42;

__global__ void __launch_bounds__(NTHR, 2) mk_fwd(Args args) {
    extern __shared__ __attribute__((aligned(16))) unsigned char lds_raw[];
    Frame F;
    F.lds = (LAS unsigned char*)lds_raw;
    F.tid = threadIdx.x; F.lane = F.tid & 63; F.wave = __builtin_amdgcn_readfirstlane(F.tid >> 6);
    F.G = gridDim.x; { const int bx = blockIdx.x; F.vcu = (F.G % 8 == 0) ? (bx % 8) * (F.G / 8) + bx / 8 : bx; }
    F.out = args.out; F.ws = args.ws; F.tid = 0; F.lane = 0;
    volatile LAS unsigned* MISC = (volatile LAS unsigned*)(F.lds + MISC_OFF);
    if (threadIdx.x < 64) MISC[threadIdx.x] = 0u;
    __syncthreads();
    XcdBarrier bar = xcd_barrier_post((unsigned*)(F.ws + WS_CTL) + CW_BAR, MISC + 8);
    const int lo = args.ph_lo, hi = args.ph_hi;
#ifndef MK_EN
#define MK_EN 0xFFFFF
#endif
#define EN(b) ((MK_EN >> (b)) & 1)
#ifndef MK_ALIGN_RMW
#define MK_ALIGN_RMW true
#endif
#ifndef MK_SPLIT_INPROJ
#define MK_SPLIT_INPROJ 0
#endif
#ifndef MK_ALIGN_VALU
#define MK_ALIGN_VALU true
#endif
#ifndef MK_DUP
#define MK_DUP 0
#endif
#define NREP(b) (((MK_DUP >> (b)) & 1) ? 2 : 1)
#define IN(k) (lo <= (k) && (k) < hi)
#if MK_TIME
#define STAMP(k) do { if (blockIdx.x == 0 && threadIdx.x == 0) ((unsigned long long*)(Fk0ws + WS_END))[(k)] = __builtin_amdgcn_s_memrealtime(); } while (0)
#else
#define STAMP(k) do { } while (0)
#endif
#define SEAM(k) do { if (IN(k) && IN((k) + 1)) { xcd_barrier(bar); if (NREP(20) == 2) xcd_barrier(bar); } STAMP((k) + 1); } while (0)
    const int cblk = (int)blockIdx.x;
    unsigned char* const Fk0ws = args.ws; STAMP(0);

    if (IN(0) && EN(0)) { for (int rep_ = 0; rep_ < NREP(10); ++rep_) { conv_range(F, args, 0, 70, 0); prologue_tables(F, args); } }
    SEAM(0);

    const Frame Fk = F;
#pragma nounroll
    for (int l = 0; l < NLAYER; ++l) {
        Frame F = Fk;
        { unsigned char* w_ = F.ws; float* o_ = F.out; unsigned l_ = (unsigned)(size_t)F.lds; asm volatile("" : "+s"(w_), "+s"(o_), "+s"(l_)); F.ws = w_; F.out = o_; F.lds = (LAS unsigned char*)(size_t)l_; }
        unsigned char* R = F.ws + WS_R;
        const float* rc = (const float*)(F.ws + WS_ROPEC); const float* rs = (const float*)(F.ws + WS_ROPES);
        const int pb = 1 + 10 * l; const bool moe = (l & 1) != 0; const int fi = l >> 1;
        unsigned char* wmix = F.ws + WS_WMIX + (size_t)l * WMIX_STRIDE;
        bf16_t* XB = (bf16_t*)(F.ws + WS_XB);
        if (IN(pb + 0) && EN(1)) {
            if (l == 0) norm_phase<0, true>(F, args.in[0], F.out, args.in[1], false, nullptr);
            else        norm_phase<0, false>(F, XB, F.out, args.in[1] + l * 1024, (l == 2), nullptr, MK_F8_GATES && l >= MK_F8_INFROM);
            if (l == 2) conv_range(F, args, 46, 70, 1);
        }
        SEAM(pb + 0);
        if (IN(pb + 1) && EN(2)) { for (int rep_ = 0; rep_ < NREP(1); ++rep_) {
            pg8::Gemm g{1024, 1024, 1024, 127};
            pg8::EpiInproj E{R, (float*)(F.ws + WS_CQP), (float*)(F.ws + WS_CKVP), args.in[18] + (size_t)l * 3072, rc, rs};
#if MK_F8_GATES
#if MK_F8_INPROJ
            { pg8::Gemm g8{512, 512, 512, 127 - SWG};
              pg8::SchedDense S{T / 256, 12, F.G, cblk, (const char*)(F.ws + WS_H8), (const char*)(wmix + WM_CAT), (size_t)256 * 1024, (size_t)256 * 1024};
              pg8::gemm_phase<pg8::EpiInproj, pg8::SchedDense, MK_ALIGN_VALU, true>(F.lds, g8, S, E); }
#else
            const bool in8 = (l >= MK_F8_INFROM);
            if (!in8) { pg8::SchedDense S{T / 256, 12, F.G, cblk, (const char*)(F.ws + WS_H), (const char*)(wmix + WM_CAT), (size_t)256 * 1024 * 2, (size_t)256 * 1024 * 2};
              pg8::gemm_phase<pg8::EpiInproj, pg8::SchedDense, MK_ALIGN_VALU>(F.lds, g, S, E); }
#endif
            { pg8::Gemm g8{512, 512, 512, 127 - SWG};
              pg8::SchedDense S{T / 256, in8 ? 24 : 12, F.G, cblk, (const char*)(F.ws + WS_H8), (const char*)(wmix + WM_G8) - (size_t)12 * 256 * 1024, (size_t)256 * 1024, (size_t)256 * 1024, in8 ? 0 : 12};
              pg8::gemm_phase<pg8::EpiInproj, pg8::SchedDense, MK_ALIGN_VALU, true>(F.lds, g8, S, E); }
#else
            pg8::SchedDense S{T / 256, NCAT / 256, F.G, cblk, (const char*)(F.ws + WS_H), (const char*)(wmix + WM_CAT), (size_t)256 * 1024 * 2, (size_t)256 * 1024 * 2};
            pg8::gemm_phase(F.lds, g, S, E);
#endif
        } }
        SEAM(pb + 1);
        if (IN(pb + 2) && EN(3)) { {
            if (EN(16)) for (int rep_ = 0; rep_ < NREP(16); ++rep_) { pg8::Gemm g{256, 256, 256, 127};
              pg8::SchedDense S{T / 256, 3, F.G, cblk, (const char*)(R + R_CQ), (const char*)(wmix + WM_UQ), (size_t)256 * 256 * 2, (size_t)256 * 256 * 2};
              pg8::EpiQ E{(bf16_t*)(R + R_QM), (const float*)(F.ws + WS_CQP), rc, rs};
              pg8::gemm_phase(F.lds, g, S, E); }
            if (EN(17)) for (int rep_ = 0; rep_ < NREP(17); ++rep_) { pg8::Gemm g{256, 256, 256, 127};
              pg8::SchedDense S{T / 256, 4, F.G, cblk, (const char*)(R + R_CKV), (const char*)(wmix + WM_UKV), (size_t)256 * 256 * 2, (size_t)256 * 256 * 2};
              pg8::EpiKV E{(bf16_t*)(R + R_KM), (bf16_t*)(R + R_VM), (const float*)(F.ws + WS_CKVP)};
              pg8::gemm_phase(F.lds, g, S, E); }
            if (EN(18)) for (int rep_ = 0; rep_ < NREP(18); ++rep_) gmlp_phase(F, args, l);
        } }
        SEAM(pb + 2);
        if (IN(pb + 3) && EN(4)) { for (int rep_ = 0; rep_ < NREP(3); ++rep_) {
            const unsigned lam_b = (unsigned)__builtin_amdgcn_readfirstlane((int)__float_as_uint(((const float*)(F.ws + WS_LAM))[l])), osc_b = (unsigned)__builtin_amdgcn_readfirstlane((int)__float_as_uint(1.0f - lam_init_of(l)));
            for (int pidx = F.vcu; pidx < 256; pidx += F.G) {
                const int bh = pidx >> 4, s = pidx & 15;
                if (EN(19)) for (int k = 0; k < 2 * NREP(19); ++k) attn::mla_unit(F.lds, bh, (k & 1) ? 31 - s : s, (const bf16_t*)(R + R_QM), (const bf16_t*)(R + R_KM), (const bf16_t*)(R + R_VM), (bf16_t*)(R + R_BR));
                if (EN(14)) for (int k = 0; k < 2 * NREP(14); ++k) attn::diff_unit(F.lds, bh, (k & 1) ? 31 - s : s, (const bf16_t*)(R + R_DQ), (const bf16_t*)(R + R_K12), (const bf16_t*)(R + R_VD), (bf16_t*)(R + R_BR),
                                                          (const float*)(F.ws + WS_BIAST), args.in[15] + l * 128, lam_b, osc_b);
            }
        } }
        SEAM(pb + 3);
        if (IN(pb + 4) && EN(5)) { {
            pg8::Gemm g{512, 1536, 512, 127};
            pg8::SchedBranch S{T / 256, 4, F.G, cblk, (const char*)(R + R_BR), (const char*)(wmix + WM_B), (size_t)256 * 1536 * 2, (size_t)256 * 512 * 2, (size_t)512 * 2, (size_t)1024 * 512 * 2};
            pg8::EpiBranch E{(bf16_t*)(R + R_MERGED), (const bf16_t*)(R + R_G), R + R_KM + (size_t)blockIdx.x * 131072};
            pg8::gemm_phase<pg8::EpiBranch, pg8::SchedBranch, MK_ALIGN_RMW>(F.lds, g, S, E);

        } }
        SEAM(pb + 4);
        if (IN(pb + 5) && EN(6)) {
            pg8::Gemm g{1024, 1024, 1024, 127};
            pg8::SchedDense S{T / 256, 4, F.G, cblk, (const char*)(R + R_MERGED), (const char*)(wmix + WM_O), (size_t)256 * 1024 * 2, (size_t)256 * 1024 * 2};
            if (l == 0) { pg8::EpiResidB<true> E{args.in[0], XB}; pg8::gemm_phase(F.lds, g, S, E); }
            else        { pg8::EpiResidB<false> E{XB, XB}; pg8::gemm_phase(F.lds, g, S, E); }
        }
        SEAM(pb + 5);
        if (IN(pb + 6) && EN(7)) { for (int rep_ = 0; rep_ < NREP(6); ++rep_) {
            if (moe) norm_phase<2, false>(F, XB, F.out, args.in[21] + l * 1024, false, args.in[25] + (size_t)fi * 1024 * 8);
            else     norm_phase<1, false>(F, XB, F.out, args.in[21] + l * 1024, false, nullptr, F8_DENSE(fi) != 0);
        } }
        SEAM(pb + 6);
        if (moe) {
            if (IN(pb + 7) && EN(8)) for (int rep_ = 0; rep_ < NREP(7); ++rep_) moe_gather_phase(F);
            SEAM(pb + 7);
            if (IN(pb + 8) && EN(9)) { for (int rep_ = 0; rep_ < NREP(8); ++rep_) {
                const int* meta = (const int*)(F.ws + WS_META);
                pg8::Gemm g{512, 512, 512, 127 - SW13};
#if MK_MOE_GATHER
                pg8::SchedMoeG S; S.gidx = (const int*)(F.ws + WS_GIDX); S.A = (const char*)(F.ws + WS_H);
#else
                pg8::SchedMoe S; S.A = (const char*)(R + R_XG);
#endif
                S.nM = __builtin_amdgcn_readfirstlane(meta[8]); S.nN = 2 * FE / 256; S.G = F.G; S.c = cblk; S.B = (const char*)(F.ws + WS_WMOE + WE_13);
                S.astep = (size_t)256 * 1024; S.bstep = (size_t)256 * 1024; S.bexp = (size_t)2 * FE * 1024;
#pragma unroll
                for (int j = 0; j < 9; ++j) S.ts[j] = __builtin_amdgcn_readfirstlane(meta[j]);
                pg8::EpiSwiglu8 E{R + R_HME, FE};
#if MK_MOE_GATHER
                pg8::gemm_phase<pg8::EpiSwiglu8, pg8::SchedMoeG, MK_ALIGN_VALU, true>(F.lds, g, S, E);
#else
                pg8::gemm_phase<pg8::EpiSwiglu8, pg8::SchedMoe, MK_ALIGN_VALU, true>(F.lds, g, S, E);
#endif
            } }
            SEAM(pb + 8);
            if (IN(pb + 9) && EN(10)) { for (int rep_ = 0; rep_ < NREP(9); ++rep_) {
                const int* meta = (const int*)(F.ws + WS_META);
                pg8::Gemm g{FE / 2, FE / 2, FE / 2, 127 - SW2};
                pg8::SchedMoe S; S.nM = __builtin_amdgcn_readfirstlane(meta[8]); S.nN = 4; S.G = F.G; S.c = cblk; S.A = (const char*)(R + R_HME); S.B = (const char*)(F.ws + WS_WMOE + WE_2);
                S.astep = (size_t)256 * FE; S.bstep = (size_t)256 * FE; S.bexp = (size_t)1024 * FE;
#pragma unroll
                for (int j = 0; j < 9; ++j) S.ts[j] = __builtin_amdgcn_readfirstlane(meta[j]);
                pg8::EpiMoeDown E{(bf16_t*)(R + R_Y), (const float*)(F.ws + WS_ROWW)};
                pg8::gemm_phase<pg8::EpiMoeDown, pg8::SchedMoe, true, true>(F.lds, g, S, E);
            } }
            SEAM(pb + 9);
        } else {
            STAMP(pb + 8);
            unsigned char* wden = F.ws + WS_WDEN + (size_t)fi * WDEN_STRIDE;
            if (IN(pb + 8) && EN(11)) {
                if (F8_DENSE(fi)) {
                    pg8::Gemm g{512, 512, 512, 127 - SW13};
                    pg8::SchedDense S{T / 256, 2 * FD / 256, F.G, cblk, (const char*)(F.ws + WS_H), (const char*)(wden + WD_13), (size_t)256 * 1024, (size_t)256 * 1024};
                    pg8::EpiSwiglu8 E{R + R_HMD, FD};
                    pg8::gemm_phase<pg8::EpiSwiglu8, pg8::SchedDense, true, true>(F.lds, g, S, E);
                } else {
                    pg8::Gemm g{1024, 1024, 1024, 127};
                    pg8::SchedDense S{T / 256, 2 * FD / 256, F.G, cblk, (const char*)(F.ws + WS_H), (const char*)(wden + WD_13), (size_t)256 * 1024 * 2, (size_t)256 * 1024 * 2};
                    pg8::EpiSwiglu E{(bf16_t*)(R + R_HMD), FD};
                    pg8::gemm_phase<pg8::EpiSwiglu, pg8::SchedDense, MK_ALIGN_VALU>(F.lds, g, S, E);
                }
            }
            SEAM(pb + 8);
            if (IN(pb + 9) && EN(12)) {
                if (F8_DENSE(fi)) {
                    pg8::Gemm g{FD / 2, FD / 2, FD / 2, 127 - SW2};
                    pg8::SchedDense S{T / 256, 4, F.G, cblk, (const char*)(R + R_HMD), (const char*)(wden + WD_2), (size_t)256 * FD, (size_t)256 * FD};
                    pg8::EpiResidB<false> E{XB, XB};
                    pg8::gemm_phase<pg8::EpiResidB<false>, pg8::SchedDense, true, true>(F.lds, g, S, E);
                } else {
                    pg8::Gemm g{FD, FD, FD, 127};
                    pg8::SchedDense S{T / 256, 4, F.G, cblk, (const char*)(R + R_HMD), (const char*)(wden + WD_2), (size_t)256 * FD * 2, (size_t)256 * FD * 2};
                    pg8::EpiResidB<false> E{XB, XB};
                    pg8::gemm_phase(F.lds, g, S, E);
                }
            }
            SEAM(pb + 9);
        }
    }
    if (IN(41) && EN(13)) norm_phase<3, false>(Fk, Fk.ws + WS_XB, Fk.out, args.in[29], true, nullptr);
    STAMP(42);
#undef IN
#undef SEAM
}

#if MK_TIME
#ifndef MK_TA
#define MK_TA 12
#endif
#ifndef MK_TB
#define MK_TB 12
#endif
__device__ float time_of(const unsigned long long* ts, int sel) {
    float t = 0.f;
    if (sel == 12) return (float)(ts[42] - ts[0]) * 0.01f;
    if (sel == 10) return (float)(ts[1] - ts[0]) * 0.01f;
    if (sel == 11) return (float)(ts[42] - ts[41]) * 0.01f;
    if (sel >= 20) { const int p = sel - 20; return (float)(ts[p + 1] - ts[p]) * 0.01f; }
    for (int l = 0; l < 4; ++l) { const int p = 1 + 10 * l + sel; t += (float)(ts[p + 1] - ts[p]) * 0.01f; }
    return t;
}
__global__ void time_encode(const unsigned long long* ts, float* out, int n) {
    const float ta = time_of(ts, MK_TA), tb = time_of(ts, MK_TB);
    const float a = sqrtf(ta * 0.1f);
    for (size_t i = (size_t)blockIdx.x * blockDim.x + threadIdx.x; i < (size_t)n; i += (size_t)gridDim.x * blockDim.x) { unsigned hsh = (unsigned)i * 2654435761u; hsh ^= hsh >> 15; out[i] = (hsh & 1u) ? a : -a; }
    if (blockIdx.x == 0 && threadIdx.x == 0) out[0] = tb;
}
#endif
extern "C" void kernel_launch(void* const* d_in, const int* in_sizes, int n_in, void* d_out, int out_size, void* d_ws, size_t ws_size, hipStream_t stream) {
    static int grid = 0;
    if (grid == 0) {
        if (n_in != 30 || out_size != T * DM || ws_size < WS_END) { fprintf(stderr, "kernel_launch: unexpected shapes (n_in %d out %d ws %zu)\n", n_in, out_size, ws_size); grid = -1; return; }
        int dev = 0, cus = 0, per_cu = 0;
        if (hipGetDevice(&dev) != hipSuccess || hipDeviceGetAttribute(&cus, hipDeviceAttributeMultiprocessorCount, dev) != hipSuccess) { grid = -1; return; }
        if (hipFuncSetAttribute((const void*)mk_fwd, hipFuncAttributeMaxDynamicSharedMemorySize, LDS_BYTES) != hipSuccess) { fprintf(stderr, "kernel_launch: hipFuncSetAttribute failed\n"); grid = -1; return; }
        if (hipOccupancyMaxActiveBlocksPerMultiprocessor(&per_cu, (const void*)mk_fwd, NTHR, LDS_BYTES) != hipSuccess || per_cu < 1) { fprintf(stderr, "kernel_launch: occupancy query says %d\n", per_cu); }
        (void)hipGetLastError();
        grid = cus;
    }
    if (grid < 0) return;
    (void)hipMemsetAsync((char*)d_ws + WS_CTL, 0, CTL_ZERO_BYTES, stream);
    Args a{};
    for (int i = 0; i < 30; ++i) a.in[i] = (const float*)d_in[i];
    a.out = (float*)d_out; a.ws = (unsigned char*)d_ws;
#if MK_CHECK
    {
        float* err = (float*)((char*)d_ws + WS_END); float* xsave = (float*)((char*)d_ws + WS_END + MiB);
        unsigned char* ws = (unsigned char*)d_ws; unsigned char* R = ws + WS_R; const float* const* in = (const float* const*)d_in;
        const float* rc = (const float*)(ws + WS_ROPEC); const float* rs = (const float*)(ws + WS_ROPES);
        (void)hipMemsetAsync(err, 0, 4096, stream);
#define LNCH(lo_, hi_) do { (void)hipMemsetAsync((char*)d_ws + WS_CTL, 0, CTL_ZERO_BYTES, stream); a.ph_lo = (lo_); a.ph_hi = (hi_); hipLaunchKernelGGL(mk_fwd, dim3(grid), dim3(NTHR), LDS_BYTES, stream, a); } while (0)
#if MK_CHECK == 3
        LNCH(0, 1); hipLaunchKernelGGL(chk_wcat, dim3(2048), dim3(256), 0, stream, (const bf16_t*)(ws + WS_WMIX + WM_CAT), in[2], in[17], err);
#elif MK_CHECK == 33 || MK_CHECK == 34 || MK_CHECK == 35 || MK_CHECK == 36 || MK_CHECK == 37
        LNCH(0, 2); LNCH(2, 3);  hipLaunchKernelGGL(chk_inproj, dim3(CHK_NROWS), dim3(256), 0, stream, (const bf16_t*)(ws + WS_H), in[2], in[17], in[18], R, rc, rs, err, 20);
#elif MK_CHECK == 1
        LNCH(0, 2);  hipLaunchKernelGGL(chk_norm, dim3(CHK_NROWS), dim3(256), 0, stream, in[0], in[1], (const bf16_t*)(ws + WS_H), err, 0);
        LNCH(2, 3);  hipLaunchKernelGGL(chk_inproj, dim3(CHK_NROWS), dim3(256), 0, stream, (const bf16_t*)(ws + WS_H), in[2], in[17], in[18], R, rc, rs, err, 1);
        LNCH(3, 4);  hipLaunchKernelGGL(chk_mlaup, dim3(CHK_NROWS), dim3(256), 0, stream, R, in[9], in[10], in[7], in[8], rc, rs, err, 8);
                     hipLaunchKernelGGL(chk_gmlp, dim3(CHK_NROWS), dim3(256), 0, stream, R, in[3], in[4], in[5], in[6], err, 12);
        LNCH(4, 5);  hipLaunchKernelGGL(chk_attn, dim3(2 * 16 * 12), dim3(256), 0, stream, R, (const float*)(ws + WS_BIAST), in[15], (const float*)(ws + WS_LAM), 0, err, 13);
        LNCH(5, 6);  hipLaunchKernelGGL(chk_merged, dim3(CHK_NROWS), dim3(256), 0, stream, R, in[19], err, 15);
        LNCH(6, 7);  hipLaunchKernelGGL(chk_resid, dim3(CHK_NROWS), dim3(256), 0, stream, (const bf16_t*)(R + R_MERGED), 1024, in[20], in[0], (const float*)nullptr, (const float*)d_out, err, 16);
        LNCH(7, 8);  hipLaunchKernelGGL(chk_norm, dim3(CHK_NROWS), dim3(256), 0, stream, (const float*)d_out, in[21], (const bf16_t*)(ws + WS_H), err, 17);
        LNCH(8, 10); hipLaunchKernelGGL(chk_swiglu, dim3(128), dim3(256), 0, stream, (const bf16_t*)(ws + WS_H), in[22], in[23], FD, (const bf16_t*)(R + R_HMD), err, 18);
        hipLaunchKernelGGL(chk_save_rows, dim3(CHK_NROWS), dim3(256), 0, stream, (const float*)d_out, xsave);
        LNCH(10, 11); hipLaunchKernelGGL(chk_resid, dim3(CHK_NROWS), dim3(256), 0, stream, (const bf16_t*)(R + R_HMD), FD, in[24], (const float*)nullptr, (const float*)xsave, (const float*)d_out, err, 19);
#else
        LNCH(0, 21); hipLaunchKernelGGL(chk_moe, dim3(64), dim3(256), 0, stream, (const float*)d_out, in[21] + 1024, in[25], in[26], in[27], in[28], ws, err, 20);
        hipLaunchKernelGGL(chk_save_rows, dim3(CHK_NROWS), dim3(256), 0, stream, (const float*)d_out, xsave);
        LNCH(21, 22); hipLaunchKernelGGL(chk_combine, dim3(CHK_NROWS), dim3(256), 0, stream, (const float*)xsave, (const float*)d_out, ws, err, 24);
#endif
        hipLaunchKernelGGL(chk_encode, dim3(1024), dim3(256), 0, stream, (const float*)err, (float*)d_out, out_size);
    }
#elif MK_MULTI
    for (int p = 0; p < N_PHASES; ++p) { a.ph_lo = p; a.ph_hi = p + 1; hipLaunchKernelGGL(mk_fwd, dim3(grid), dim3(NTHR), LDS_BYTES, stream, a); }
#else
#ifndef MK_PH_HI
#define MK_PH_HI N_PHASES
#endif
    a.ph_lo = 0; a.ph_hi = MK_PH_HI;
    hipLaunchKernelGGL(mk_fwd, dim3(grid), dim3(NTHR), LDS_BYTES, stream, a);
#if MK_TIME
    hipLaunchKernelGGL(time_encode, dim3(1024), dim3(256), 0, stream, (const unsigned long long*)((char*)d_ws + WS_END), (float*)d_out, out_size);
#endif
#endif
}
```

```cpp
#include <hip/hip_runtime.h>
#include <cstdio>
#include <cstdint>

#define GAS __attribute__((address_space(1)))
#define LAS __attribute__((address_space(3)))
typedef unsigned short bf16_t;
typedef short bf16x8 __attribute__((ext_vector_type(8)));
typedef short s16x4 __attribute__((ext_vector_type(4)));
typedef float f32x2 __attribute__((ext_vector_type(2)));
typedef float f32x4 __attribute__((ext_vector_type(4)));
typedef float f32x16 __attribute__((ext_vector_type(16)));
typedef unsigned u32x2 __attribute__((ext_vector_type(2)));
typedef unsigned u32x4 __attribute__((ext_vector_type(4)));
typedef int i32x4 __attribute__((ext_vector_type(4)));
typedef int i32x8 __attribute__((ext_vector_type(8)));

#ifndef MK_MULTI
#define MK_MULTI 0
#endif
#ifndef MK_TIME
#define MK_TIME 0
#endif
#ifndef MK_CHECK
#define MK_CHECK 0
#endif

constexpr int T = 32768, DM = 1024, SEQ = 8192, NBATCH = 4, NLAYER = 4;
constexpr int NCAT = 6144;
constexpr int FD = 2816, FE = 3584, NEXP = 8;
constexpr int MAXROWS = 65536 + NEXP * 256;
constexpr float EPS = 1e-6f;
constexpr float LOG2E = 1.4426950408889634f;
constexpr float QS_MLA = 0.07216878364870322f * LOG2E;
constexpr float QS_DIF = 0.125f * LOG2E;

constexpr size_t MiB = 1u << 20;
constexpr size_t WS_CTL = 0, CTL_ZERO_BYTES = 64 * 1024;
constexpr size_t WS_ROPEC = 1 * MiB, WS_ROPES = 2 * MiB;
constexpr size_t WS_BIAST = 3 * MiB;
constexpr size_t WS_LAM = 3 * MiB + 8192;
constexpr size_t WS_META = 3 * MiB + 16384;
constexpr size_t WS_CQP = 4 * MiB, WS_CKVP = 4 * MiB + 512 * 1024;
constexpr size_t WS_SEL = 5 * MiB;
constexpr size_t WS_SLOT = 5 * MiB + 512 * 1024;
constexpr size_t WS_CNT = 5 * MiB + 768 * 1024;
constexpr size_t WS_ROWW = 6 * MiB;
constexpr size_t WS_GIDX = 6 * MiB + 512 * 1024;
#ifndef MK_MOE_GATHER
#define MK_MOE_GATHER 1
#endif
constexpr size_t WS_WMIX = 8 * MiB, WMIX_STRIDE = 18 * MiB;
constexpr size_t WM_G8 = 6 * MiB;
constexpr size_t WM_CAT = 0, WM_UQ = 12 * MiB, WM_UKV = 12 * MiB + 512 * 1024, WM_B = 13 * MiB, WM_O = 16 * MiB;
#ifndef MK_F8_DENSE
#define MK_F8_DENSE 2
#endif
#define F8_DENSE(fi) (((MK_F8_DENSE) >> (fi)) & 1)
constexpr size_t WS_WDEN = 80 * MiB, WDEN_STRIDE = 16 * MiB + 512 * 1024;
constexpr size_t WD_13 = 0, WD_2 = 11 * MiB;
constexpr size_t WS_WMOE = 113 * MiB, WMOE_STRIDE = 84 * MiB;
constexpr size_t WE_13 = 0, WE_2 = 56 * MiB;
constexpr size_t WS_XB = WS_WMOE + 84 * MiB;
constexpr int SW13 = 4, SW2 = 5;
constexpr size_t WS_H = 281 * MiB;
constexpr size_t WS_R = 345 * MiB;
constexpr size_t R_UV = 0, R_MERGED = 0, R_CQ = 64 * MiB, R_CKV = 80 * MiB, R_DQ = 96 * MiB, R_K12 = 128 * MiB, R_VD = 160 * MiB,
                 R_G = 192 * MiB, R_QM = 384 * MiB, R_KM = 432 * MiB, R_VM = 480 * MiB, R_BR = 512 * MiB;
constexpr size_t R_HMD = 0;
constexpr size_t R_XG = 0, R_Y = 0, R_HME = 132 * MiB;
constexpr size_t WS_H8 = 953 * MiB;
constexpr size_t WS_END = 985 * MiB;
#ifndef MK_F8_GATES
#define MK_F8_GATES 1
#endif
constexpr int SWG = 4;
#ifndef MK_F8_INPROJ
#define MK_F8_INPROJ 0
#endif
#ifndef MK_G8
#define MK_G8 1
#endif
#ifndef MK_SWIFOLD
#define MK_SWIFOLD 1
#endif
#ifndef MK_NPIPE
#define MK_NPIPE 1
#endif
#ifndef MK_F8_INFROM
#define MK_F8_INFROM 2
#endif
static_assert(R_HME + (size_t)MAXROWS * FE * 2 <= 608 * MiB, "moe hidden fits");
static_assert((size_t)MAXROWS * 2048 == 132 * MiB, "xg size");

constexpr int RING_BYTES = 131072;
constexpr int MISC_OFF = RING_BYTES;
constexpr int LDS_BYTES = 147456;
constexpr int NWAVES = 8, NTHR = 512;

typedef __bf16 bf16x2_t __attribute__((ext_vector_type(2)));
__device__ __forceinline__ unsigned cvt_pk_bf16(float lo, float hi) { f32x2 v = {lo, hi}; bf16x2_t b = __builtin_convertvector(v, bf16x2_t); return __builtin_bit_cast(unsigned, b); }
__device__ __forceinline__ float bf2f(unsigned short b) { return __uint_as_float(((unsigned)b) << 16); }
__device__ __forceinline__ float bflo(unsigned w) { return __uint_as_float(w << 16); }
__device__ __forceinline__ float bfhi(unsigned w) { return __uint_as_float(w & 0xffff0000u); }
__device__ __forceinline__ u32x4 pack8(f32x4 a, f32x4 b) { u32x4 w; w.x = cvt_pk_bf16(a[0], a[1]); w.y = cvt_pk_bf16(a[2], a[3]); w.z = cvt_pk_bf16(b[0], b[1]); w.w = cvt_pk_bf16(b[2], b[3]); return w; }
__device__ __forceinline__ unsigned pack4_fp8(float a, float b, float c, float d) {
    a = __builtin_amdgcn_fmed3f(a, -448.f, 448.f); b = __builtin_amdgcn_fmed3f(b, -448.f, 448.f); c = __builtin_amdgcn_fmed3f(c, -448.f, 448.f); d = __builtin_amdgcn_fmed3f(d, -448.f, 448.f);
    int w = 0; w = __builtin_amdgcn_cvt_pk_fp8_f32(a, b, w, false); w = __builtin_amdgcn_cvt_pk_fp8_f32(c, d, w, true); return (unsigned)w; }
__device__ __forceinline__ float fast_exp2(float x) { return __builtin_amdgcn_exp2f(x); }
__device__ __forceinline__ float fast_rcp(float x) { return __builtin_amdgcn_rcpf(x); }
#if MK_CHECK == 36
__device__ __forceinline__ float sigmoidf_(float z) { return 1.0f / (1.0f + expf(-z)); }
#else
__device__ __forceinline__ float sigmoidf_(float z) { return fast_rcp(1.0f + fast_exp2(-z * LOG2E)); }
#endif
__device__ __forceinline__ float gelu_tanh(float x) { const float u = 0.7978845608028654f * (x + 0.044715f * x * x * x); return x * fast_rcp(1.0f + fast_exp2(-2.0f * LOG2E * u)); }
template <int CTRL> __device__ __forceinline__ float dppf(float v) { return __int_as_float(__builtin_amdgcn_update_dpp(0, __float_as_int(v), CTRL, 0xf, 0xf, true)); }
template <int CTRL> __device__ __forceinline__ int dppi(int v) { return __builtin_amdgcn_update_dpp(0, v, CTRL, 0xf, 0xf, true); }
__device__ __forceinline__ float sum_x16(float v) { auto r = __builtin_amdgcn_permlane16_swap(__float_as_uint(v), __float_as_uint(v), false, false); return __uint_as_float(r[0]) + __uint_as_float(r[1]); }
__device__ __forceinline__ float sum_x32(float v) { auto r = __builtin_amdgcn_permlane32_swap(__float_as_uint(v), __float_as_uint(v), false, false); return __uint_as_float(r[0]) + __uint_as_float(r[1]); }
__device__ __forceinline__ int isum_x16(int v) { auto r = __builtin_amdgcn_permlane16_swap((unsigned)v, (unsigned)v, false, false); return (int)(r[0] + r[1]); }
__device__ __forceinline__ int isum_x32(int v) { auto r = __builtin_amdgcn_permlane32_swap((unsigned)v, (unsigned)v, false, false); return (int)(r[0] + r[1]); }
__device__ __forceinline__ float wave_sum(float v) {
    v += dppf<0xB1>(v); v += dppf<0x4E>(v); v += dppf<0x141>(v); v += dppf<0x140>(v); v = sum_x16(v); return sum_x32(v);
}
__device__ __forceinline__ int wave_isum(int v) {
    v += dppi<0xB1>(v); v += dppi<0x4E>(v); v += dppi<0x141>(v); v += dppi<0x140>(v); v = isum_x16(v); return isum_x32(v);
}
__device__ __forceinline__ int opaque_tid() { int t = threadIdx.x; asm volatile("" : "+v"(t)); return t; }
#define LDS_WAIT() asm volatile("s_waitcnt lgkmcnt(0)" ::: "memory")
#define VM_WAIT() asm volatile("s_waitcnt vmcnt(0)" ::: "memory")

__device__ __forceinline__ size_t km_addr(int bh, int tile, int chunk, int kv) { return ((((size_t)bh * 128 + tile) * 24 + chunk) * 64 + kv) * 8; }
__device__ __forceinline__ size_t k12_addr(int bh, int tile, int map, int chunk, int kv) { return (((((size_t)bh * 128 + tile) * 2 + map) * 8 + chunk) * 64 + kv) * 8; }
__device__ __forceinline__ size_t vimg_addr(int bh, int tile, int dblk, int kv) { return ((((size_t)bh * 128 + tile) * 4 + dblk) * 64 + kv) * 32; }

#define XB_TMO      128
#define XB_XCNT(j)  (256  + 64 * (j))
#define XB_XSUB(j)  (1280 + 64 * (j))
#define XB_XGEN(j)  (2304 + 64 * (j))
#define XB_TOP      3328
#define XB_TOPGEN   3392
#define XCD_BAR_WORDS 3456
#define XB_SPIN_CAP (1u << 20)

__device__ __forceinline__ unsigned xb_ld(unsigned* p)              { return __hip_atomic_load(p, __ATOMIC_RELAXED, __HIP_MEMORY_SCOPE_AGENT); }
__device__ __forceinline__ unsigned xb_add(unsigned* p, unsigned v) { return __hip_atomic_fetch_add(p, v, __ATOMIC_RELAXED, __HIP_MEMORY_SCOPE_AGENT); }
__device__ __forceinline__ unsigned xb_xcc_id() { return (unsigned)__builtin_amdgcn_s_getreg((3 << 11) | 20) & 0xFu; }
#define XB_SPIN(cond, bar) do { unsigned _sp = 0; while (cond) { __builtin_amdgcn_s_sleep(1); \
    if ((++_sp & 255u) == 0u) { if (xb_ld(&(bar)[XB_TMO])) break; if (_sp > XB_SPIN_CAP) { atomicAdd(&(bar)[XB_TMO], 1u); break; } } } } while (0)

struct XcdBarrier { unsigned* bar; unsigned x; volatile LAS unsigned* st; };

__device__ __forceinline__ XcdBarrier xcd_barrier_post(unsigned* bar, volatile LAS unsigned* st) {
    XcdBarrier b; b.bar = bar; b.x = xb_xcc_id(); b.st = st;
    if (threadIdx.x == 0) (void)xb_add(&bar[XB_XCNT(b.x)], 1u);
    return b;
}
__device__ __forceinline__ void xcd_barrier_complete(unsigned* bar, unsigned x, unsigned& nloc, unsigned& nx) {
    const unsigned G = gridDim.x * gridDim.y * gridDim.z;
    unsigned sum, cnt, mine, sp = 0u;
    for (;;) {
        sum = 0u; cnt = 0u; mine = 0u;
#pragma unroll
        for (unsigned j = 0; j < 16; ++j) { const unsigned c = xb_ld(&bar[XB_XCNT(j)]); sum += c; cnt += (c > 0u) ? 1u : 0u; mine = (j == x) ? c : mine; }
        if (sum == G) break;
        __builtin_amdgcn_s_sleep(1);
        if ((++sp & 255u) == 0u) { if (xb_ld(&bar[XB_TMO])) break; if (sp > XB_SPIN_CAP) { atomicAdd(&bar[XB_TMO], 1u); break; } }
    }
    nloc = mine > 0u ? mine : 1u; nx = cnt > 0u ? cnt : 1u;
}
__device__ __forceinline__ void xcd_barrier(const XcdBarrier& b) {
    asm volatile("s_waitcnt vmcnt(0)" ::: "memory");
    __syncthreads();
    if (threadIdx.x == 0) {
        unsigned* bar = b.bar;
        __builtin_amdgcn_s_waitcnt(0);
        unsigned nloc = b.st[0], nx = b.st[1];
        if (nloc == 0u) { xcd_barrier_complete(bar, b.x, nloc, nx); b.st[0] = nloc; b.st[1] = nx; }
        const unsigned old = xb_add(&bar[XB_XSUB(b.x)], 1u);
        const unsigned gen = old / nloc;
        if (old + 1u == (gen + 1u) * nloc) {
            __builtin_amdgcn_fence(__ATOMIC_RELEASE, "agent");
            asm volatile("s_waitcnt vmcnt(0)" ::: "memory");
            const unsigned og = xb_add(&bar[XB_TOP], 1u);
            const unsigned tg = og / nx;
            if (og + 1u == (tg + 1u) * nx) xb_add(&bar[XB_TOPGEN], 1u);
            else XB_SPIN(xb_ld(&bar[XB_TOPGEN]) == tg, bar);
            __builtin_amdgcn_fence(__ATOMIC_ACQUIRE, "agent");
            xb_add(&bar[XB_XGEN(b.x)], 1u);
            asm volatile("s_waitcnt vmcnt(0)" ::: "memory");
        } else {
            XB_SPIN(xb_ld(&bar[XB_XGEN(b.x)]) == gen, bar);
            __builtin_amdgcn_fence(__ATOMIC_ACQUIRE, "agent");
            asm volatile("s_waitcnt vmcnt(0)" ::: "memory");
        }
    }
    __syncthreads();
}
namespace pg8 {
constexpr int BM = 256, BK = 64, HALF = 128, HTB = HALF * BK * 2, STAGE_BYTES = 8 * HTB, NXCD = 8, WGM = 8;
__host__ __device__ __forceinline__ int lds_byte(int r, int c) { const int st = (r >> 4) * 2 + (c >> 5), rr = r & 15, cc = c & 31, ob = rr * 64 + cc * 2; return st * 1024 + (ob ^ (((ob >> 9) & 1) << 5)); }
__host__ __device__ __forceinline__ void stage_rc(int b, int& R, int& C) { const int st = b / 1024, sb = b % 1024, swz = sb ^ (((sb >> 9) & 1) << 5); R = (st >> 1) * 16 + swz / 64; C = (st & 1) * 32 + (swz % 64) / 2; }
__host__ __device__ __forceinline__ int perm32(int rho) { const int n = rho >> 4, i = rho & 15; return 8 * (i >> 2) + 4 * n + (i & 3); }

struct Unit { int pm, pn, aux; const char* a; const char* b; };
struct Gemm { int K; int lda, ldb; int wsc; };

__device__ __forceinline__ void tile_of(int wgid, int nM, int nN, int& pm, int& pn) {
    const int nwg = nM * nN;
    { const int q = nwg / NXCD, r = nwg % NXCD, xcd = wgid % NXCD, off = wgid / NXCD; wgid = (xcd < r ? xcd * (q + 1) : r * (q + 1) + (xcd - r) * q) + off; }
    const int nig = WGM * nN, gid = wgid / nig, fm = gid * WGM, gsz = (nM - fm) < WGM ? (nM - fm) : WGM;
    pm = fm + ((wgid % nig) % gsz); pn = (wgid % nig) / gsz;
}

template <class Epi, class Sched, bool ALIGN_EPI = true, bool F8 = false>
__device__ __forceinline__ void gemm_phase(LAS unsigned char* lds, const Gemm g, const Sched& S, const Epi& E) {
    const int tid = opaque_tid(), wid = __builtin_amdgcn_readfirstlane(tid >> 6), lane = tid & 63, wr = wid >> 2, wc = wid & 3, fr = lane & 15, fq = lane >> 4;
    const int K = g.K, nt = K / BK;
    unsigned voffA[2], voffB[2];
#pragma unroll
    for (int i = 0; i < 2; ++i) { int R, C; stage_rc(tid * 16 + i * 8192, R, C); const int Rb = Epi::PERM ? ((R & ~31) + perm32(R & 31)) : R;
        voffA[i] = (unsigned)(R * g.lda + C) * 2u; voffB[i] = (unsigned)(Rb * g.ldb + C) * 2u; }
    constexpr bool GA = Sched::GATHER;
    unsigned vgc[2][2] = {{0u, 0u}, {0u, 0u}}, vgn[2][2] = {{0u, 0u}, {0u, 0u}};
    const size_t kstep = (size_t)(BK * 2);
    const size_t hstepA = (size_t)HALF * g.lda * 2, hstepB = (size_t)HALF * g.ldb * 2;
    const unsigned ldsw = (unsigned)wid * 1024u;
    const int aoff = lds_byte(wr * 64 + fr, fq * 8), boff = lds_byte(wc * 32 + fr, fq * 8);
#define PG8_SA(b, h) (((b) * 2 + (h)) * HTB)
#define PG8_SB(b, h) ((4 + (b) * 2 + (h)) * HTB)
#define PG8_STAGE(bufoff, gbase, voff) do { _Pragma("unroll") for (int _i = 0; _i < 2; ++_i) \
        __builtin_amdgcn_global_load_lds((const unsigned*)((const char*)(gbase) + (voff)[_i]), (LAS unsigned*)(lds + (bufoff) + ldsw + _i * 8192), 16, 0, 0); } while (0)
#define PG8_STAGE_O(bufoff, gbase, o0, o1) do { \
        __builtin_amdgcn_global_load_lds((const unsigned*)((const char*)(gbase) + (o0)), (LAS unsigned*)(lds + (bufoff) + ldsw), 16, 0, 0); \
        __builtin_amdgcn_global_load_lds((const unsigned*)((const char*)(gbase) + (o1)), (LAS unsigned*)(lds + (bufoff) + ldsw + 8192), 16, 0, 0); } while (0)
#define PG8_STAGE_A(bufoff, gbase, h) do { if constexpr (GA) { PG8_STAGE_O(bufoff, gbase, vgc[h][0], vgc[h][1]); } else { PG8_STAGE(bufoff, (gbase) + (h) * hstepA, voffA); } } while (0)
#define PG8_LD8(p) __builtin_shufflevector(*(const LAS i32x4*)(p), *(const LAS i32x4*)((p) + 1024), 0, 1, 2, 3, 4, 5, 6, 7)
#define PG8_LDA(dst, b, h) do { if constexpr (F8) { _Pragma("unroll") for (int m = 0; m < 4; ++m) dst##8[m] = PG8_LD8(lds + PG8_SA(b, h) + aoff + m * 2048); } \
        else { _Pragma("unroll") for (int m = 0; m < 4; ++m) _Pragma("unroll") for (int k = 0; k < 2; ++k) dst[m][k] = *(const LAS bf16x8*)(lds + PG8_SA(b, h) + aoff + m * 2048 + k * 1024); } } while (0)
#define PG8_LDB(dst, b, h) do { if constexpr (F8) { _Pragma("unroll") for (int n = 0; n < 2; ++n) dst##8[n] = PG8_LD8(lds + PG8_SB(b, h) + boff + n * 2048); } \
        else { _Pragma("unroll") for (int n = 0; n < 2; ++n) _Pragma("unroll") for (int k = 0; k < 2; ++k) dst[n][k] = *(const LAS bf16x8*)(lds + PG8_SB(b, h) + boff + n * 2048 + k * 1024); } } while (0)
#define PG8_CAT(x) __builtin_shufflevector(__builtin_bit_cast(i32x4, x[0]), __builtin_bit_cast(i32x4, x[1]), 0, 1, 2, 3, 4, 5, 6, 7)
#define PG8_MMA(ai, bj, At, Bt) do { __builtin_amdgcn_s_setprio(1); \
        if constexpr (F8) { _Pragma("unroll") for (int m = 0; m < 4; ++m) _Pragma("unroll") for (int n = 0; n < 2; ++n) \
            asm volatile("v_mfma_scale_f32_16x16x128_f8f6f4 %0, %1, %2, %0, %3, %4 op_sel_hi:[0,0,0]" : "+v"(acc[ai][bj][m][n]) : "v"(Bt##8[n]), "v"(At##8[m]), "v"(wsc_v), "v"(one_v)); } \
        else { _Pragma("unroll") for (int m = 0; m < 4; ++m) _Pragma("unroll") for (int n = 0; n < 2; ++n) _Pragma("unroll") for (int k = 0; k < 2; ++k) \
            acc[ai][bj][m][n] = __builtin_amdgcn_mfma_f32_16x16x32_bf16(Bt[n][k], At[m][k], acc[ai][bj][m][n], 0, 0, 0); } \
        __builtin_amdgcn_s_setprio(0); } while (0)
#define PG8_WAIT_V(n) asm volatile("s_waitcnt vmcnt(" #n ")" ::: "memory")
#define PG8_WAIT_L(n) asm volatile("s_waitcnt lgkmcnt(" #n ")" ::: "memory")
#define PG8_BAR __builtin_amdgcn_s_barrier()
#define PG8_SCHED __builtin_amdgcn_sched_barrier(0)
    Unit cur, nxt; int ui = 0;
    if (!S.next(0, cur)) return;
#ifndef MK_STAGGER
#define MK_STAGGER 0
#endif
    if (MK_STAGGER && ((S.c >> 3) & 1)) {
        const unsigned long long t0 = __builtin_amdgcn_s_memrealtime(), dl = (unsigned long long)(nt * 65);
        while (__builtin_amdgcn_s_memrealtime() - t0 < dl) __builtin_amdgcn_s_sleep(8);
    }
    f32x4 acc[2][2][4][2];
#pragma unroll
    for (int a = 0; a < 2; ++a)
#pragma unroll
        for (int b = 0; b < 2; ++b)
#pragma unroll
            for (int m = 0; m < 4; ++m)
#pragma unroll
                for (int n = 0; n < 2; ++n) acc[a][b][m][n] = (f32x4){0.f, 0.f, 0.f, 0.f};
    const int wsc_v = g.wsc, one_v = 127;
    bf16x8 At[4][2], B0[2][2], B1[2][2]; i32x8 At8[4], B08[2], B18[2];
    const char* cA = cur.a; const char* cB = cur.b;
    if constexpr (GA) {
#pragma unroll
        for (int h = 0; h < 2; ++h)
#pragma unroll
            for (int i = 0; i < 2; ++i) { int R, C; stage_rc(tid * 16 + i * 8192, R, C); vgc[h][i] = (unsigned)S.gidx[cur.pm * BM + h * HALF + R] * (unsigned)(g.lda * 2) + (unsigned)(C * 2); }
    }
    PG8_STAGE(PG8_SB(0, 0), cB, voffB); PG8_STAGE(PG8_SB(0, 1), cB + hstepB, voffB); PG8_STAGE_A(PG8_SA(0, 0), cA, 0); PG8_STAGE_A(PG8_SA(0, 1), cA, 1);
    if (wr == 1) PG8_BAR;
    PG8_WAIT_V(2); PG8_BAR;
    PG8_STAGE(PG8_SB(1, 0), cB + kstep, voffB); PG8_STAGE_A(PG8_SA(1, 0), cA + kstep, 0); PG8_STAGE(PG8_SB(1, 1), cB + hstepB + kstep, voffB);
    PG8_WAIT_V(6); PG8_BAR;
    for (;;) {
        const bool has_next = S.next(ui + 1, nxt);
        const char* nA = has_next ? nxt.a : cA; const char* nB = has_next ? nxt.b : cB;
        if constexpr (GA) { if (has_next) {
#pragma unroll
            for (int h = 0; h < 2; ++h)
#pragma unroll
                for (int i = 0; i < 2; ++i) { int R, C; stage_rc(tid * 16 + i * 8192, R, C); const int* ip = S.gidx + (nxt.pm * BM + h * HALF + R);
                    asm volatile("global_load_dword %0, %1, off" : "=v"(vgn[h][i]) : "v"(ip) : "memory"); } } }
#pragma nounroll
        for (int t = 0; t < nt; t += 2) {
            const bool last = (t == nt - 2);
            const char* a1 = cA + (size_t)(t + 1) * kstep;
            const char* a2 = last ? nA : cA + (size_t)(t + 2) * kstep; const char* b2 = last ? nB : cB + (size_t)(t + 2) * kstep;
            const char* a3 = a2 + kstep; const char* b3 = b2 + kstep;
            PG8_LDB(B0, 0, 0); PG8_LDB(B1, 0, 1); PG8_SCHED; PG8_LDA(At, 0, 0); PG8_STAGE_A(PG8_SA(1, 1), a1, 1);
            PG8_WAIT_V(8); PG8_WAIT_L(0); PG8_BAR; PG8_MMA(0, 0, At, B0); PG8_MMA(0, 1, At, B1); PG8_BAR; PG8_SCHED;
            if constexpr (GA) { if (last && has_next) {
#pragma unroll
                for (int h = 0; h < 2; ++h)
#pragma unroll
                    for (int i = 0; i < 2; ++i) { int R, C; stage_rc(tid * 16 + i * 8192, R, C); unsigned r_ = vgn[h][i]; asm volatile("" : "+v"(r_)); vgc[h][i] = r_ * (unsigned)(g.lda * 2) + (unsigned)(C * 2); } }
              PG8_SCHED; }
            PG8_LDA(At, 0, 1); PG8_STAGE(PG8_SB(0, 0), b2, voffB); PG8_STAGE(PG8_SB(0, 1), b2 + hstepB, voffB); PG8_STAGE_A(PG8_SA(0, 0), a2, 0);
            PG8_WAIT_V(8); PG8_WAIT_L(0); PG8_BAR; PG8_MMA(1, 0, At, B0); PG8_MMA(1, 1, At, B1); PG8_BAR; PG8_SCHED;
            PG8_LDB(B0, 1, 0); PG8_LDB(B1, 1, 1); PG8_SCHED; PG8_LDA(At, 1, 0); PG8_STAGE_A(PG8_SA(0, 1), a2, 1);
            PG8_WAIT_V(8); PG8_WAIT_L(0); PG8_BAR; PG8_MMA(0, 0, At, B0); PG8_MMA(0, 1, At, B1); PG8_BAR; PG8_SCHED;
            PG8_LDA(At, 1, 1); PG8_STAGE(PG8_SB(1, 0), b3, voffB); PG8_STAGE(PG8_SB(1, 1), b3 + hstepB, voffB); PG8_STAGE_A(PG8_SA(1, 0), a3, 0);
            PG8_WAIT_V(8); PG8_WAIT_L(0); PG8_BAR; PG8_MMA(1, 0, At, B0); PG8_MMA(1, 1, At, B1); PG8_BAR; PG8_SCHED;
        }
        if constexpr (F8) asm volatile("s_nop 15\n\ts_nop 7" ::: "memory");
        if constexpr (ALIGN_EPI) { if (wr == 0) PG8_BAR; }
        { int fr_ = fr, fq_ = fq; asm volatile("" : "+v"(fr_), "+v"(fq_));
          E(acc, cur, wr, wc, fr_, fq_); }
        if (!has_next) break;
#pragma unroll
        for (int a = 0; a < 2; ++a)
#pragma unroll
            for (int b = 0; b < 2; ++b)
#pragma unroll
                for (int m = 0; m < 4; ++m)
#pragma unroll
                    for (int n = 0; n < 2; ++n) acc[a][b][m][n] = (f32x4){0.f, 0.f, 0.f, 0.f};
        cur = nxt; cA = nA; cB = nB; ++ui;
        if constexpr (ALIGN_EPI) { if (wr == 1) PG8_BAR; }
    }
    PG8_WAIT_V(0);
    if constexpr (!ALIGN_EPI) { if (wr == 0) PG8_BAR; }
    PG8_BAR;
#undef PG8_SA
#undef PG8_SB
#undef PG8_STAGE
#undef PG8_STAGE_O
#undef PG8_STAGE_A
#undef PG8_LD8
#undef PG8_LDA
#undef PG8_LDB
#undef PG8_MMA
#undef PG8_CAT
#undef PG8_WAIT_V
#undef PG8_WAIT_L
#undef PG8_BAR
#undef PG8_SCHED
}

struct SchedDense {
    static constexpr bool GATHER = false;
    int nM, nN, G, c; const char* A; const char* B; size_t astep, bstep;
    int pnoff = 0;
    __device__ __forceinline__ bool next(int i, Unit& u) const {
        const long L = (long)i * G + c; if (L >= (long)nM * nN) return false;
        tile_of((int)L, nM, nN, u.pm, u.pn); u.pn += pnoff; u.aux = 0; u.a = A + (size_t)u.pm * astep; u.b = B + (size_t)u.pn * bstep; return true;
    }
};
struct SchedBranch {
    static constexpr bool GATHER = false;
    int nM, nN, G, c; const char* A; const char* B; size_t astep, bstep, asub, bsub;
    __device__ __forceinline__ bool next(int i, Unit& u) const {
        const int n = i % 3; const long L = (long)(i / 3) * G + c; if (L >= (long)nM * nN) return false;
        tile_of((int)L, nM, nN, u.pm, u.pn); u.aux = n; u.a = A + (size_t)u.pm * astep + (size_t)n * asub; u.b = B + (size_t)u.pn * bstep + (size_t)n * bsub; return true;
    }
};
struct SchedMoe {
    static constexpr bool GATHER = false;
    int nM, nN, G, c; const char* A; const char* B; size_t astep, bstep, bexp; int ts[9];
    __device__ __forceinline__ bool next(int i, Unit& u) const {
        const long L = (long)i * G + c; if (L >= (long)nM * nN) return false;
        tile_of((int)L, nM, nN, u.pm, u.pn); int e = 0;
#pragma unroll
        for (int j = 1; j < 8; ++j) e += (u.pm >= ts[j]) ? 1 : 0;
        u.aux = e; u.a = A + (size_t)u.pm * astep; u.b = B + (size_t)e * bexp + (size_t)u.pn * bstep; return true;
    }
};
struct SchedMoeG : SchedMoe {
    static constexpr bool GATHER = true; const int* gidx;
    __device__ __forceinline__ bool next(int i, Unit& u) const { if (!SchedMoe::next(i, u)) return false; u.a = A; return true; }
};
}
namespace pg8 {
#define EPI_ARGS const f32x4 (&acc)[2][2][4][2], const Unit& u, int wr, int wc, int fr, int fq
#define EPI_FOR_AI_M _Pragma("unroll") for (int ai = 0; ai < 2; ++ai) _Pragma("unroll") for (int m = 0; m < 4; ++m)
#define EPI_FOR_BJ _Pragma("unroll") for (int bj = 0; bj < 2; ++bj)
__device__ __forceinline__ void st16(void* base, unsigned off, u32x4 v) { *(u32x4*)((unsigned char*)base + off) = v; }
__device__ __forceinline__ u32x4 ld16(const void* base, unsigned off) { return *(const u32x4*)((const unsigned char*)base + off); }
__device__ __forceinline__ f32x4 ld16f(const void* base, unsigned off) { return *(const f32x4*)((const unsigned char*)base + off); }

__device__ __forceinline__ void rope4(f32x4& x1, f32x4& x2, const float* rc, const float* rs, unsigned toff) {
    const f32x4 c = ld16f(rc, toff), s = ld16f(rs, toff);
    const f32x4 o1 = x1 * c - x2 * s, o2 = x2 * c + x1 * s; x1 = o1; x2 = o2;
}

struct EpiInproj {
    static constexpr bool PERM = true;
    unsigned char* R; float *cqp, *ckvp; const float* bgate; const float* rc; const float* rs;
    __device__ __forceinline__ void operator()(EPI_ARGS) const {
        const int pn = u.pn; const unsigned rl = (unsigned)(wr * 64 + fr), row0 = (unsigned)(u.pm * BM) + rl, c0 = (unsigned)(wc * 32 + 8 * fq);
        const unsigned b = (unsigned)(u.pm * BM) >> 13, t0 = ((unsigned)(u.pm * BM) & (SEQ - 1)) >> 6;
        if (pn < 4) {
            unsigned char* P = R + R_UV; const unsigned o0 = (row0 * 1024u + (unsigned)pn * 256u + c0) * 2u;
            EPI_FOR_AI_M { EPI_FOR_BJ { f32x4 v0 = acc[ai][bj][m][0], v1 = acc[ai][bj][m][1];
#pragma unroll
                    for (int j = 0; j < 4; ++j) { v0[j] = gelu_tanh(v0[j]); v1[j] = gelu_tanh(v1[j]); }
                    st16(P, o0 + (unsigned)((ai * HALF + m * 16) * 1024 + bj * HALF) * 2u, pack8(v0, v1)); } }
        } else if (pn == 4) {
            unsigned char* P = R + R_CQ; const unsigned o0 = (row0 * 256u + c0) * 2u;
            EPI_FOR_AI_M { float ss = 0.f;
                EPI_FOR_BJ { const f32x4 v0 = acc[ai][bj][m][0], v1 = acc[ai][bj][m][1];
                    ss += (v0[0] * v0[0] + v0[1] * v0[1]) + (v0[2] * v0[2] + v0[3] * v0[3]) + (v1[0] * v1[0] + v1[1] * v1[1]) + (v1[2] * v1[2] + v1[3] * v1[3]);
                    st16(P, o0 + (unsigned)((ai * HALF + m * 16) * 256 + bj * HALF) * 2u, pack8(v0, v1)); }
                ss = sum_x32(sum_x16(ss));
                if (fq == 0) cqp[(row0 + ai * HALF + m * 16) * 4u + wc] = ss; }
        } else if (pn == 5) {
            unsigned char* P = R + R_CKV; const unsigned o0 = (row0 * 256u + c0) * 2u;
            unsigned char* KMp = R + R_KM; const unsigned g8 = 4u * wc + fq;
            const unsigned ko0 = ((((b * 4u) * 128u + t0 + wr) * 24u + 16u + g8) * 64u + (unsigned)fr) * 16u;
            const unsigned to0 = ((row0 & (SEQ - 1)) * 32u + 4u * g8) * 4u;
            EPI_FOR_AI_M {
                const f32x4 a0 = acc[ai][0][m][0], a1 = acc[ai][0][m][1];
                float ss = (a0[0] * a0[0] + a0[1] * a0[1]) + (a0[2] * a0[2] + a0[3] * a0[3]) + (a1[0] * a1[0] + a1[1] * a1[1]) + (a1[2] * a1[2] + a1[3] * a1[3]);
                st16(P, o0 + (unsigned)((ai * HALF + m * 16) * 256) * 2u, pack8(a0, a1));
                ss = sum_x32(sum_x16(ss));
                if (fq == 0) ckvp[(row0 + ai * HALF + m * 16) * 4u + wc] = ss;
                f32x4 x1 = acc[ai][1][m][0], x2 = acc[ai][1][m][1];
                st16(P, o0 + (unsigned)((ai * HALF + m * 16) * 256 + HALF) * 2u, pack8(x1, x2));
                if (wc < 2) {
                    rope4(x1, x2, rc, rs, to0 + (unsigned)((ai * HALF + m * 16) * 32) * 4u);
                    const u32x4 w = pack8(x1, x2);
#pragma unroll
                    for (int h = 0; h < 4; ++h) st16(KMp, ko0 + (unsigned)(h * 128 * 24 * 1024 + ai * 2 * 24 * 1024 + m * 16 * 16), w); } }
        } else if (pn < 8) {
            unsigned char* P = R + R_DQ; const unsigned o0 = (row0 * 512u + (unsigned)(pn - 6) * 256u + c0) * 2u;
            EPI_FOR_AI_M { EPI_FOR_BJ { st16(P, o0 + (unsigned)((ai * HALF + m * 16) * 512 + bj * HALF) * 2u, pack8(acc[ai][bj][m][0] * QS_DIF, acc[ai][bj][m][1] * QS_DIF)); } }
        } else if (pn < 10) {
            unsigned char* P = R + R_K12;
            const unsigned o0 = ((((((b * 4u + 2u * (unsigned)(pn - 8)) * 128u + t0 + wr) * 2u + (unsigned)(wc >> 1)) * 8u + (unsigned)(4 * (wc & 1) + fq)) * 64u + (unsigned)fr) * 16u);
            EPI_FOR_AI_M { EPI_FOR_BJ { st16(P, o0 + (unsigned)(bj * 128 * 16384 + ai * 2 * 16384 + m * 16 * 16), pack8(acc[ai][bj][m][0], acc[ai][bj][m][1])); } }
        } else if (pn < 12) {
            unsigned char* P = R + R_VD;
            const unsigned o0 = (((((b * 4u + 2u * (unsigned)(pn - 10)) * 128u + t0 + wr) * 4u + (unsigned)wc) * 64u + (unsigned)fr) * 32u + 8u * fq) * 2u;
            EPI_FOR_AI_M { EPI_FOR_BJ { st16(P, o0 + (unsigned)(bj * 128 * 16384 + ai * 2 * 16384 + m * 16 * 64), pack8(acc[ai][bj][m][0], acc[ai][bj][m][1])); } }
        } else {
            unsigned char* P = R + R_G; const unsigned gc0 = (unsigned)(pn - 12) * 256u + c0, o0 = (row0 * 3072u + gc0) * 2u;
            f32x4 bv[2][2];
            EPI_FOR_BJ { bv[bj][0] = ld16f(bgate, (gc0 + bj * HALF) * 4u); bv[bj][1] = ld16f(bgate, (gc0 + bj * HALF + 4) * 4u); if (MK_SWIFOLD) { bv[bj][0] = bv[bj][0] * LOG2E; bv[bj][1] = bv[bj][1] * LOG2E; } }
            EPI_FOR_AI_M { EPI_FOR_BJ { f32x4 v0 = acc[ai][bj][m][0] + bv[bj][0], v1 = acc[ai][bj][m][1] + bv[bj][1];
#pragma unroll
                    for (int j = 0; j < 4; ++j) { if (MK_SWIFOLD) { v0[j] = fast_rcp(1.0f + fast_exp2(-v0[j])); v1[j] = fast_rcp(1.0f + fast_exp2(-v1[j])); } else { v0[j] = sigmoidf_(v0[j]); v1[j] = sigmoidf_(v1[j]); } }
#if MK_G8
                    u32x2 w8; w8.x = 0u; w8.y = 0u;
#pragma unroll
                    for (int j = 0; j < 4; ++j) { w8.x = __builtin_amdgcn_cvt_pk_u8_f32(fminf(v0[j] * 256.0f + 0.5f, 255.0f), (unsigned)j, w8.x); w8.y = __builtin_amdgcn_cvt_pk_u8_f32(fminf(v1[j] * 256.0f + 0.5f, 255.0f), (unsigned)j, w8.y); }
                    *(u32x2*)(P + (o0 >> 1) + (unsigned)((ai * HALF + m * 16) * 3072 + bj * HALF)) = w8; } }
#else
                    st16(P, o0 + (unsigned)((ai * HALF + m * 16) * 3072 + bj * HALF) * 2u, pack8(v0, v1)); } }
#endif
        }
    }
};

struct EpiQ {
    static constexpr bool PERM = true;
    bf16_t* QM; const float* cqp; const float* rc; const float* rs;
    __device__ __forceinline__ void operator()(EPI_ARGS) const {
        const unsigned row0 = (unsigned)(u.pm * BM + wr * 64 + fr), c0 = (unsigned)(u.pn * 256 + wc * 32 + 8 * fq);
        float sc[2][4];
        EPI_FOR_AI_M { const f32x4 p = ld16f(cqp, (row0 + ai * HALF + m * 16) * 16u);
            sc[ai][m] = __builtin_amdgcn_rsqf(((p[0] + p[1]) + (p[2] + p[3])) * (1.0f / 256.0f) + EPS) * QS_MLA; }
        const unsigned o0 = (row0 * 768u + c0) * 2u, tp0 = (row0 & (SEQ - 1)) * 128u;
        EPI_FOR_AI_M { EPI_FOR_BJ { const unsigned col = c0 + bj * HALF, w = col % 192u;
                f32x4 v0 = acc[ai][bj][m][0] * sc[ai][m], v1 = acc[ai][bj][m][1] * sc[ai][m];
                if (w >= 128u) rope4(v0, v1, rc, rs, tp0 + (unsigned)((ai * HALF + m * 16) * 128) + ((w - 128u) >> 1) * 4u);
                st16(QM, o0 + (unsigned)((ai * HALF + m * 16) * 768 + bj * HALF) * 2u, pack8(v0, v1)); } }
    }
};
struct EpiKV {
    static constexpr bool PERM = true;
    bf16_t *KM, *VM; const float* ckvp;
    __device__ __forceinline__ void operator()(EPI_ARGS) const {
        const unsigned row0 = (unsigned)(u.pm * BM + wr * 64 + fr), h = (unsigned)u.pn;
        float sc[2][4];
        EPI_FOR_AI_M { const f32x4 p = ld16f(ckvp, (row0 + ai * HALF + m * 16) * 16u);
            sc[ai][m] = __builtin_amdgcn_rsqf(((p[0] + p[1]) + (p[2] + p[3])) * (1.0f / 128.0f) + EPS); }
        const unsigned b = (unsigned)(u.pm * BM) >> 13, t0 = ((unsigned)(u.pm * BM) & (SEQ - 1)) >> 6;
        const unsigned tb = (b * 4u + h) * 128u + t0 + wr;
        const unsigned ko0 = ((tb * 24u + (unsigned)(4 * wc + fq)) * 64u + (unsigned)fr) * 16u;
        const unsigned vo0 = (((tb * 4u + (unsigned)wc) * 64u + (unsigned)fr) * 32u + 8u * fq) * 2u;
        EPI_FOR_AI_M {
            st16(KM, ko0 + (unsigned)(ai * 2 * 24 * 1024 + m * 16 * 16), pack8(acc[ai][0][m][0] * sc[ai][m], acc[ai][0][m][1] * sc[ai][m]));
            st16(VM, vo0 + (unsigned)(ai * 2 * 16384 + m * 16 * 64), pack8(acc[ai][1][m][0] * sc[ai][m], acc[ai][1][m][1] * sc[ai][m])); }
    }
};
template <int N> __device__ __forceinline__ float ubf(unsigned x) { return (float)((x >> (8 * N)) & 0xffu); }
struct EpiBranch {
    static constexpr bool PERM = true;
    bf16_t* MG; const bf16_t* G; unsigned char* scr;
    template <int n>
    __device__ __forceinline__ void run(EPI_ARGS) const {
        constexpr bool LAST = (n == 2);
        const unsigned row0 = (unsigned)(u.pm * BM + wr * 64 + fr), c0 = (unsigned)(u.pn * 256 + wc * 32 + 8 * fq);
        const unsigned go0 = (row0 * 3072u + (unsigned)n * 1024u + c0) * (MK_G8 ? 1u : 2u), mo0 = (row0 * 1024u + c0) * 2u;
        const unsigned so0 = (unsigned)(((wr * 4 + wc) * 64 + fq * 16 + fr) * 16);
#pragma unroll
        for (int ai = 0; ai < 2; ++ai)
#pragma unroll
            for (int m = 0; m < 4; ++m) {
                u32x4 gw[2], ow[2]; const int rr = ai * HALF + m * 16;
#pragma unroll
                for (int bj = 0; bj < 2; ++bj) {
#if MK_G8
                    { const u32x2 g8 = *(const u32x2*)((const unsigned char*)G + go0 + (unsigned)(rr * 3072 + bj * HALF)); gw[bj].x = g8.x; gw[bj].y = g8.y; gw[bj].z = 0u; gw[bj].w = 0u; }
#else
                    gw[bj] = ld16(G, go0 + (unsigned)(rr * 3072 + bj * HALF) * 2u);
#endif
                    ow[bj] = (n > 0) ? ld16(scr, so0 + (unsigned)(((ai * 4 + m) * 2 + bj) * 8192)) : (u32x4){0u, 0u, 0u, 0u}; }
#pragma unroll
                for (int bj = 0; bj < 2; ++bj) {
                    const u32x4 g4 = gw[bj], o = ow[bj];
                    f32x4 v0 = acc[ai][bj][m][0], v1 = acc[ai][bj][m][1];
#if MK_G8
                    v0[0] = v0[0] * ubf<0>(g4.x) + bflo(o.x); v0[1] = v0[1] * ubf<1>(g4.x) + bfhi(o.x); v0[2] = v0[2] * ubf<2>(g4.x) + bflo(o.y); v0[3] = v0[3] * ubf<3>(g4.x) + bfhi(o.y);
                    v1[0] = v1[0] * ubf<0>(g4.y) + bflo(o.z); v1[1] = v1[1] * ubf<1>(g4.y) + bfhi(o.z); v1[2] = v1[2] * ubf<2>(g4.y) + bflo(o.w); v1[3] = v1[3] * ubf<3>(g4.y) + bfhi(o.w);
#else
                    v0[0] = v0[0] * bflo(g4.x) + bflo(o.x); v0[1] = v0[1] * bfhi(g4.x) + bfhi(o.x); v0[2] = v0[2] * bflo(g4.y) + bflo(o.y); v0[3] = v0[3] * bfhi(g4.y) + bfhi(o.y);
                    v1[0] = v1[0] * bflo(g4.z) + bflo(o.z); v1[1] = v1[1] * bfhi(g4.z) + bfhi(o.z); v1[2] = v1[2] * bflo(g4.w) + bflo(o.w); v1[3] = v1[3] * bfhi(g4.w) + bfhi(o.w);
#endif
                    if (LAST) st16(MG, mo0 + (unsigned)(rr * 1024 + bj * HALF) * 2u, pack8(v0, v1));
                    else      st16(scr, so0 + (unsigned)(((ai * 4 + m) * 2 + bj) * 8192), pack8(v0, v1)); }
            }
    }
    __device__ __forceinline__ void operator()(EPI_ARGS) const {
        if (u.aux == 0) run<0>(acc, u, wr, wc, fr, fq); else if (u.aux == 1) run<1>(acc, u, wr, wc, fr, fq); else run<2>(acc, u, wr, wc, fr, fq);
    }
};
template <bool XF32>
struct EpiResidB {
    static constexpr bool PERM = true;
    const void* xin; bf16_t* xb;
    __device__ __forceinline__ void operator()(EPI_ARGS) const {
        const unsigned e0 = (unsigned)(u.pm * BM + wr * 64 + fr) * 1024u + (unsigned)(u.pn * 256 + wc * 32 + 8 * fq);
#pragma unroll
        for (int ai = 0; ai < 2; ++ai)
#pragma unroll
            for (int mh = 0; mh < 2; ++mh) {
                f32x4 xv[2][2][2];
#pragma unroll
                for (int mm = 0; mm < 2; ++mm)
#pragma unroll
                    for (int bj = 0; bj < 2; ++bj) { const unsigned eo = e0 + (unsigned)((ai * HALF + (2 * mh + mm) * 16) * 1024 + bj * HALF);
                        if (XF32) { xv[mm][bj][0] = ld16f(xin, eo * 4u); xv[mm][bj][1] = ld16f(xin, eo * 4u + 16u); }
                        else { const u32x4 w = ld16(xin, eo * 2u); xv[mm][bj][0] = (f32x4){bflo(w.x), bfhi(w.x), bflo(w.y), bfhi(w.y)}; xv[mm][bj][1] = (f32x4){bflo(w.z), bfhi(w.z), bflo(w.w), bfhi(w.w)}; } }
#pragma unroll
                for (int mm = 0; mm < 2; ++mm)
#pragma unroll
                    for (int bj = 0; bj < 2; ++bj) { const int m = 2 * mh + mm; const unsigned eo = e0 + (unsigned)((ai * HALF + m * 16) * 1024 + bj * HALF);
                        st16(xb, eo * 2u, pack8(xv[mm][bj][0] + acc[ai][bj][m][0], xv[mm][bj][1] + acc[ai][bj][m][1])); }
            }
    }
};
struct EpiSwiglu {
    static constexpr bool PERM = true;
    bf16_t* HM; int ldh;
    __device__ __forceinline__ void operator()(EPI_ARGS) const {
        const unsigned ld2 = (unsigned)ldh * 2u, o0 = (unsigned)(u.pm * BM + wr * 64 + fr) * ld2 + (unsigned)(u.pn * 128 + wc * 32 + 8 * fq) * 2u;
        EPI_FOR_AI_M {
            f32x4 a0 = acc[ai][0][m][0], a1 = acc[ai][0][m][1]; const f32x4 b0 = acc[ai][1][m][0], b1 = acc[ai][1][m][1];
#pragma unroll
#if MK_SWIFOLD
            for (int j = 0; j < 4; ++j) { a0[j] = a0[j] * b0[j] * fast_rcp(1.0f + fast_exp2(-a0[j])); a1[j] = a1[j] * b1[j] * fast_rcp(1.0f + fast_exp2(-a1[j])); }
#else
            for (int j = 0; j < 4; ++j) { a0[j] = a0[j] * sigmoidf_(a0[j]) * b0[j]; a1[j] = a1[j] * sigmoidf_(a1[j]) * b1[j]; }
#endif
            st16(HM, o0 + (unsigned)(ai * HALF + m * 16) * ld2, pack8(a0, a1)); }
    }
};
struct EpiSwiglu8 {
    static constexpr bool PERM = true;
    unsigned char* HM; int ldh;
    __device__ __forceinline__ void operator()(EPI_ARGS) const {
        const unsigned ld = (unsigned)ldh, o0 = (unsigned)(u.pm * BM + wr * 64 + fr) * ld + (unsigned)(u.pn * 128 + wc * 32 + 8 * fq);
        EPI_FOR_AI_M {
            f32x4 a0 = acc[ai][0][m][0], a1 = acc[ai][0][m][1]; const f32x4 b0 = acc[ai][1][m][0], b1 = acc[ai][1][m][1];
#pragma unroll
#if MK_SWIFOLD
            for (int j = 0; j < 4; ++j) { a0[j] = a0[j] * b0[j] * fast_rcp(1.0f + fast_exp2(-a0[j])); a1[j] = a1[j] * b1[j] * fast_rcp(1.0f + fast_exp2(-a1[j])); }
#else
            for (int j = 0; j < 4; ++j) { a0[j] = a0[j] * sigmoidf_(a0[j]) * b0[j]; a1[j] = a1[j] * sigmoidf_(a1[j]) * b1[j]; }
#endif
            u32x2 w; w.x = pack4_fp8(a0[0], a0[1], a0[2], a0[3]); w.y = pack4_fp8(a1[0], a1[1], a1[2], a1[3]);
            *(u32x2*)(HM + o0 + (unsigned)(ai * HALF + m * 16) * ld) = w; }
    }
};
struct EpiMoeDown {
    static constexpr bool PERM = true;
    bf16_t* Y; const float* roww;
    __device__ __forceinline__ void operator()(EPI_ARGS) const {
        const unsigned row0 = (unsigned)(u.pm * BM + wr * 64 + fr), o0 = (row0 * 1024u + (unsigned)(u.pn * 256 + wc * 32 + 8 * fq)) * 2u;
        float w[2][4];
        EPI_FOR_AI_M { w[ai][m] = roww[row0 + ai * HALF + m * 16]; }
        EPI_FOR_AI_M { EPI_FOR_BJ { st16(Y, o0 + (unsigned)((ai * HALF + m * 16) * 1024 + bj * HALF) * 2u, pack8(acc[ai][bj][m][0] * w[ai][m], acc[ai][bj][m][1] * w[ai][m])); } }
    }
};
}
namespace attn {
#ifndef MK_NOFUSE
#define MK_NOFUSE 0
#endif
#ifndef MK_PARK_LDS
#define MK_PARK_LDS 1
#endif
#define PARK_OFF(c) (((c) < 12) ? (73728 + (c) * 4096) : ((c) == 12) ? 123904 : (132096 + ((c) - 13) * 4096))
#ifndef MK_T15_NEGM
#define MK_T15_NEGM 1
#endif
#ifndef MK_XPRE
#define MK_XPRE 1
#endif
#ifndef MK_SMCHK
#define MK_SMCHK 15
#endif
constexpr int SLOT = 40960, NSLOT = 3, LDS_TAB = NSLOT * SLOT;
__device__ __forceinline__ void glds16(const void* gsrc, unsigned lds_dst) { unsigned keep;
    asm volatile("s_mov_b32 %0, m0\n\ts_mov_b32 m0, %2\n\ts_nop 0\n\tglobal_load_lds_dwordx4 %1, off\n\ts_mov_b32 m0, %0" : "=&s"(keep) : "v"(gsrc), "s"(lds_dst) : "memory"); }
__device__ __forceinline__ s16x4 vtr(const LAS unsigned char* p) { return __builtin_bit_cast(s16x4, __builtin_amdgcn_ds_read_tr16_b64_v4i16((LAS s16x4*)p)); }
__device__ __forceinline__ float halfmax(float m) { auto rr = __builtin_amdgcn_permlane32_swap(__float_as_uint(m), __float_as_uint(m), false, false); return fmaxf(__uint_as_float(rr[0]), __uint_as_float(rr[1])); }
__device__ __forceinline__ float halfsum(float m) { auto rr = __builtin_amdgcn_permlane32_swap(__float_as_uint(m), __float_as_uint(m), false, false); return __uint_as_float(rr[0]) + __uint_as_float(rr[1]); }
__device__ __forceinline__ float max16(const f32x16& a) { float x = fmaxf(fmaxf(a[0], a[1]), fmaxf(a[2], a[3])), y = fmaxf(fmaxf(a[4], a[5]), fmaxf(a[6], a[7]));
    float z = fmaxf(fmaxf(a[8], a[9]), fmaxf(a[10], a[11])), w = fmaxf(fmaxf(a[12], a[13]), fmaxf(a[14], a[15])); return fmaxf(fmaxf(x, y), fmaxf(z, w)); }
#define ATT_WAITBAR(N) asm volatile("s_waitcnt vmcnt(" #N ") lgkmcnt(0)\n\ts_barrier" ::: "memory")

constexpr float SM_THR = 8.0f;
__device__ __forceinline__ float max3f(float a, float b, float c) { return fmaxf(fmaxf(a, b), c); }
__device__ __forceinline__ bool sm_check(const f32x16& s0, const f32x16& s1, float& mref, float& l, float& alpha, bool first, float& dl) {
    float a = max3f(s0[0], s0[1], s1[0]), b = max3f(s0[2], s0[3], s1[1]); a = max3f(a, s1[2], s1[3]);
#pragma unroll
    for (int r = 4; r < 16; r += 4) { a = max3f(a, s0[r], s0[r + 1]); b = max3f(b, s0[r + 2], s0[r + 3]); a = max3f(a, s1[r], s1[r + 1]); b = max3f(b, s1[r + 2], s1[r + 3]); }
    const float mx = halfmax(fmaxf(a, b));
#if MK_T15_NEGM
    const bool up = first || (mx > SM_THR);
    alpha = 1.0f; dl = 0.f;
    if (__any(up)) { dl = up ? mx : 0.f; alpha = first ? 1.0f : fast_exp2(-dl); mref += dl; return true; }
    return false;
#else
    const bool up = first || (mx - mref > SM_THR);
    alpha = 1.0f; dl = 0.f;
    if (__any(up)) { const float nm = up ? mx : mref; alpha = first ? 1.0f : fast_exp2(mref - nm); mref = nm; return true; }
    return false;
#endif
}
template <int KS, int H>
__device__ __forceinline__ void sm_half(const f32x16& s0, const f32x16& s1, float mref, float& ra, float& rb, u32x4& pw) {
    constexpr int B = 8 * (KS & 1) + 4 * H;
    const float mr_ = MK_T15_NEGM ? 0.f : mref;
    const float v0 = fast_exp2(((KS < 2) ? s0[B] : s1[B]) - mr_), v1 = fast_exp2(((KS < 2) ? s0[B + 1] : s1[B + 1]) - mr_);
    const float v2 = fast_exp2(((KS < 2) ? s0[B + 2] : s1[B + 2]) - mr_), v3 = fast_exp2(((KS < 2) ? s0[B + 3] : s1[B + 3]) - mr_);
    ra += v0 + v2; rb += v1 + v3;
    if (H == 0) { pw.x = cvt_pk_bf16(v0, v1); pw.y = cvt_pk_bf16(v2, v3); } else { pw.z = cvt_pk_bf16(v0, v1); pw.w = cvt_pk_bf16(v2, v3); }
}

template <int NKS, bool BIAS, bool PRE = false>
__device__ __forceinline__ void attn_core(LAS unsigned char* lds, const char* kimg, int ktile_bytes, const char* vimg, const bf16x8 (&qf)[NKS], int NT, int tmax, int qpos,
                                          f32x16 (&o)[4], float& linv) {
    constexpr int NKP = 2 * NKS, KPW = NKP / 8, NPW = KPW + 2, KB = NKP * 1024, VRING = 3 * KB;
    static_assert(NKP % 8 == 0 && (NKS == 12 || NKS == 4), "K pieces divide over 8 waves; schedules exist for 192- and 64-wide q.k");
    const int tid = opaque_tid(), lane = tid & 63, r32 = lane & 31, hi = lane >> 5, wid = __builtin_amdgcn_readfirstlane(tid >> 6);
    const unsigned lds0 = (unsigned)(size_t)lds;
#define ATT_DMA_K(t, slot) do { _Pragma("unroll") for (int _i = 0; _i < KPW; ++_i) { const int _p = wid + 8 * _i; \
        glds16(kimg + (size_t)(t) * ktile_bytes + _p * 1024 + lane * 16, (unsigned)__builtin_amdgcn_readfirstlane(lds0 + (slot) * KB + _p * 1024)); } } while (0)
#define ATT_DMA_V(t, slot) do { _Pragma("unroll") for (int _i = 0; _i < 2; ++_i) { const int _p = wid + 8 * _i; \
        glds16(vimg + (size_t)(t) * 16384 + _p * 1024 + lane * 16, (unsigned)__builtin_amdgcn_readfirstlane(lds0 + VRING + (slot) * 16384 + _p * 1024)); } } while (0)
    if (!PRE) { ATT_DMA_K(0, 0); ATT_DMA_K(1, 1); ATT_DMA_V(0, 0); }
#pragma unroll
    for (int i = 0; i < 4; ++i) o[i] = f32x16{};
    float mref = 0.f, l = 0.f, ra = 0.f, rb = 0.f;
    f32x16 negm = f32x16{};
    f32x16 a0, a1, b0, b1;
    int kq = 0, vq = 0, dk = 2, dv = 1;
    const int tfast = (MK_NOFUSE) ? -1 : (BIAS ? tmax - 3 : tmax);
    const LAS unsigned char* vp0 = lds + VRING + ((lane >> 4) & 1) * 32 + (lane & 3) * 8 + (4 * hi + ((lane & 15) >> 2)) * 64;
    const LAS unsigned char* kp0 = lds + hi * 1024 + r32 * 16;
    const LAS float* tab = (const LAS float*)(lds + LDS_TAB);
#define ATT_ROT(x) x = (x == 2) ? 0 : x + 1
#define SB() __builtin_amdgcn_sched_barrier(0)
#define ATT_TOP(t) do { if ((t) + 1 < NT) { if (NPW == 5) { ATT_WAITBAR(5); } else { ATT_WAITBAR(3); } } else { ATT_WAITBAR(0); } \
        if ((t) + 2 < NT) { ATT_DMA_K((t) + 2, dk); ATT_ROT(dk); } if ((t) + 1 < NT) { ATT_DMA_V((t) + 1, dv); ATT_ROT(dv); } } while (0)
#define KLD(d0, bf) do { ka[bf][0] = *(const LAS bf16x8*)(kp + (d0) * 2048); ka[bf][1] = *(const LAS bf16x8*)(kp + (d0) * 2048 + 512); } while (0)
#define QKM(C0, C1, d0, bf) do { C0 = __builtin_amdgcn_mfma_f32_32x32x16_bf16(ka[bf][0], qf[d0], C0, 0, 0, 0); C1 = __builtin_amdgcn_mfma_f32_32x32x16_bf16(ka[bf][1], qf[d0], C1, 0, 0, 0); } while (0)
#define VLD(ks) do { _Pragma("unroll") for (int db = 0; db < 4; ++db) { vl[db] = vtr(vp + db * 4096 + (ks) * 1024); vh[db] = vtr(vp + db * 4096 + (ks) * 1024 + 512); } } while (0)
#define PVM(ks) do { const bf16x8 pfr = __builtin_bit_cast(bf16x8, pw[ks]); _Pragma("unroll") for (int db = 0; db < 4; ++db) { \
        const bf16x8 vf = (bf16x8){vl[db][0], vl[db][1], vl[db][2], vl[db][3], vh[db][0], vh[db][1], vh[db][2], vh[db][3]}; \
        o[db] = __builtin_amdgcn_mfma_f32_32x32x16_bf16(vf, pfr, o[db], 0, 0, 0); } } while (0)
#define SMH(P0, P1, ks, h) sm_half<ks, h>(P0, P1, mref, ra, rb, pw[ks])
#define ATT_CHECK(P0, P1, tt) do { if ((tt) == 0 || ((tt) & MK_SMCHK) == 0) { float alpha_, dl_; if (sm_check(P0, P1, mref, l, alpha_, (tt) == 0, dl_)) { l = (l + ra + rb) * alpha_; ra = 0.f; rb = 0.f; \
        if (MK_T15_NEGM) { _Pragma("unroll") for (int r = 0; r < 16; ++r) { P0[r] -= dl_; P1[r] -= dl_; negm[r] = -mref; } } \
        _Pragma("unroll") for (int ii = 0; ii < 4; ++ii) _Pragma("unroll") for (int r = 0; r < 16; ++r) o[ii][r] *= alpha_; } } } while (0)
#define ATT_QK_ONLY(C0, C1, t) do { const LAS unsigned char* kp = kp0 + kq * KB; bf16x8 ka[2][2]; \
        if (MK_T15_NEGM) { C0 = negm; C1 = negm; } else { C0 = f32x16{}; C1 = f32x16{}; } \
        if (BIAS) { if ((t) + 2 >= tmax) { const int bbase = 64 * (t) + 4 * hi - qpos + 192; const float nm_ = MK_T15_NEGM ? negm[0] : 0.f; \
            _Pragma("unroll") for (int r = 0; r < 16; ++r) { const int ix = bbase + (r & 3) + 8 * (r >> 2); C0[r] = tab[ix] + nm_; C1[r] = tab[ix + 32] + nm_; } } } \
        KLD(0, 0); KLD(1, 1); \
        _Pragma("unroll") for (int d0 = 0; d0 < NKS; ++d0) { SB(); QKM(C0, C1, d0, d0 & 1); if (d0 + 2 < NKS) KLD(d0 + 2, d0 & 1); SB(); } } while (0)
#define ATT_SMPV(P0, P1) do { const LAS unsigned char* vp = vp0 + vq * 16384; s16x4 vl[4], vh[4]; u32x4 pw[4]; \
        VLD(0); SMH(P0, P1, 0, 0); SMH(P0, P1, 0, 1); SMH(P0, P1, 1, 0); SMH(P0, P1, 1, 1); SMH(P0, P1, 2, 0); SMH(P0, P1, 2, 1); SMH(P0, P1, 3, 0); SMH(P0, P1, 3, 1); \
        SB(); PVM(0); SB(); VLD(1); SB(); PVM(1); SB(); VLD(2); SB(); PVM(2); SB(); VLD(3); SB(); PVM(3); SB(); } while (0)
#define ATT_FUSED(C0, C1, P0, P1) do { const LAS unsigned char* kp = kp0 + kq * KB; const LAS unsigned char* vp = vp0 + vq * 16384; \
        bf16x8 ka[2][2]; s16x4 vl[4], vh[4]; u32x4 pw[4]; if (!MK_T15_NEGM) { C0 = f32x16{}; C1 = f32x16{}; } \
        KLD(0, 0); KLD(1, 1); VLD(0); SB(); \
        if constexpr (NKS == 12) { \
            QKM(C0, C1, 0, 0); KLD(2, 0); SMH(P0, P1, 0, 0); SB(); \
            QKM(C0, C1, 1, 1); KLD(3, 1); SMH(P0, P1, 0, 1); SB(); \
            QKM(C0, C1, 2, 0); KLD(4, 0); SB(); \
            PVM(0); VLD(1); SMH(P0, P1, 1, 0); SB(); \
            QKM(C0, C1, 3, 1); KLD(5, 1); SMH(P0, P1, 1, 1); SB(); \
            QKM(C0, C1, 4, 0); KLD(6, 0); SB(); \
            PVM(1); VLD(2); SMH(P0, P1, 2, 0); SB(); \
            QKM(C0, C1, 5, 1); KLD(7, 1); SMH(P0, P1, 2, 1); SB(); \
            QKM(C0, C1, 6, 0); KLD(8, 0); SB(); \
            PVM(2); VLD(3); SMH(P0, P1, 3, 0); SB(); \
            QKM(C0, C1, 7, 1); KLD(9, 1); SMH(P0, P1, 3, 1); SB(); \
            QKM(C0, C1, 8, 0); KLD(10, 0); SB(); \
            PVM(3); SB(); \
            QKM(C0, C1, 9, 1); KLD(11, 1); SB(); \
            QKM(C0, C1, 10, 0); SB(); \
            QKM(C0, C1, 11, 1); SB(); \
        } else { \
            if (MK_T15_NEGM) { C0 = __builtin_amdgcn_mfma_f32_32x32x16_bf16(ka[0][0], qf[0], negm, 0, 0, 0); C1 = __builtin_amdgcn_mfma_f32_32x32x16_bf16(ka[0][1], qf[0], negm, 0, 0, 0); } else { QKM(C0, C1, 0, 0); } \
            KLD(2, 0); SMH(P0, P1, 0, 0); SMH(P0, P1, 0, 1); SB(); \
            PVM(0); VLD(1); SMH(P0, P1, 1, 0); SB(); \
            QKM(C0, C1, 1, 1); KLD(3, 1); SMH(P0, P1, 1, 1); SB(); \
            PVM(1); VLD(2); SMH(P0, P1, 2, 0); SB(); \
            QKM(C0, C1, 2, 0); SMH(P0, P1, 2, 1); SB(); \
            PVM(2); VLD(3); SMH(P0, P1, 3, 0); SB(); \
            QKM(C0, C1, 3, 1); SMH(P0, P1, 3, 1); SB(); \
            PVM(3); SB(); \
        } } while (0)
#define ATT_FSTEP(t, C0, C1, P0, P1) do { ATT_TOP(t); ATT_CHECK(P0, P1, (t) - 1); ATT_FUSED(C0, C1, P0, P1); ATT_ROT(kq); ATT_ROT(vq); } while (0)
#define ATT_GSTEP(t, C0, C1, P0, P1) do { ATT_TOP(t); \
        if ((t) - 1 <= tmax) { ATT_CHECK(P0, P1, (t) - 1); ATT_SMPV(P0, P1); } if ((t) <= tmax) { ATT_QK_ONLY(C0, C1, t); } \
        ATT_ROT(kq); ATT_ROT(vq); } while (0)
    ATT_TOP(0);
    ATT_QK_ONLY(a0, a1, 0);
    ATT_ROT(kq);
    int t = 1;
#pragma nounroll
    for (; t + 1 <= tfast; t += 2) { ATT_FSTEP(t, b0, b1, a0, a1); ATT_FSTEP(t + 1, a0, a1, b0, b1); }
#pragma nounroll
    for (; t + 1 < NT; t += 2) { ATT_GSTEP(t, b0, b1, a0, a1); ATT_GSTEP(t + 1, a0, a1, b0, b1); }
    ATT_GSTEP(NT - 1, b0, b1, a0, a1);
    ATT_TOP(NT);
    if (NT - 1 <= tmax) { ATT_CHECK(b0, b1, NT - 1); ATT_SMPV(b0, b1); }
    l += ra + rb;
    linv = fast_rcp(halfsum(l));
    asm volatile("s_waitcnt vmcnt(0) lgkmcnt(0)\n\ts_barrier" ::: "memory");
#undef ATT_DMA_K
#undef ATT_DMA_V
#undef ATT_ROT
#undef SB
#undef ATT_TOP
#undef KLD
#undef QKM
#undef VLD
#undef PVM
#undef SMH
#undef ATT_CHECK
#undef ATT_QK_ONLY
#undef ATT_SMPV
#undef ATT_FUSED
#undef ATT_FSTEP
#undef ATT_GSTEP
}

__device__ __forceinline__ bool softmax_tile(f32x16& s0, f32x16& s1, float& mref, float& l, float& alpha, bool first, bool check, bf16x8 (&pf)[4]) {
    bool moved = false; alpha = 1.0f;
    if (check) {
    float a = max3f(s0[0], s0[1], s1[0]), b = max3f(s0[2], s0[3], s1[1]); a = max3f(a, s1[2], s1[3]);
#pragma unroll
    for (int r = 4; r < 16; r += 4) { a = max3f(a, s0[r], s0[r + 1]); b = max3f(b, s0[r + 2], s0[r + 3]); a = max3f(a, s1[r], s1[r + 1]); b = max3f(b, s1[r + 2], s1[r + 3]); }
    const float mx = halfmax(fmaxf(a, b));
    if (__any(first || mx > SM_THR)) {
        const float dl = (first || mx > SM_THR) ? mx : 0.f;
        mref += dl; alpha = first ? 1.0f : fast_exp2(-dl); l *= alpha; moved = true;
#pragma unroll
        for (int r = 0; r < 16; ++r) { s0[r] -= dl; s1[r] -= dl; }
    }
    }
    float rs0 = 0.f, rs1 = 0.f;
#pragma unroll
    for (int r = 0; r < 16; ++r) { s0[r] = fast_exp2(s0[r]); s1[r] = fast_exp2(s1[r]); rs0 += s0[r]; rs1 += s1[r]; }
    l += rs0 + rs1;
#pragma unroll
    for (int s = 0; s < 2; ++s) {
        u32x4 x, y;
        x.x = cvt_pk_bf16(s0[8 * s + 0], s0[8 * s + 1]); x.y = cvt_pk_bf16(s0[8 * s + 2], s0[8 * s + 3]); x.z = cvt_pk_bf16(s0[8 * s + 4], s0[8 * s + 5]); x.w = cvt_pk_bf16(s0[8 * s + 6], s0[8 * s + 7]);
        y.x = cvt_pk_bf16(s1[8 * s + 0], s1[8 * s + 1]); y.y = cvt_pk_bf16(s1[8 * s + 2], s1[8 * s + 3]); y.z = cvt_pk_bf16(s1[8 * s + 4], s1[8 * s + 5]); y.w = cvt_pk_bf16(s1[8 * s + 6], s1[8 * s + 7]);
        pf[s] = __builtin_bit_cast(bf16x8, x); pf[2 + s] = __builtin_bit_cast(bf16x8, y);
    }
    return moved;
}

template <int NKS, bool BIAS, bool PRE = false>
__device__ __forceinline__ void attn_core_v1(LAS unsigned char* lds, const char* kimg, int ktile_bytes, const char* vimg, const bf16x8 (&qf)[NKS], int NT, int tmax, int qpos,
                                          f32x16 (&o)[4], float& linv, int dir = 0) {
    constexpr int NKP = 2 * NKS, NPW = (NKP + 16) / 8, KB = NKP * 1024;
    static_assert((NKP + 16) % 8 == 0, "pieces divide over 8 waves");
    const int tid = opaque_tid(), lane = tid & 63, r32 = lane & 31, hi = lane >> 5, wid = __builtin_amdgcn_readfirstlane(tid >> 6);
    const unsigned lds0 = (unsigned)(size_t)lds;
#define ATT_DMA(t, slot) do { _Pragma("unroll") for (int _i = 0; _i < NPW; ++_i) { const int _p = wid + 8 * _i; \
        const char* _s = (_p < NKP) ? kimg + (size_t)(t) * ktile_bytes + _p * 1024 : vimg + (size_t)(t) * 16384 + (_p - NKP) * 1024; \
        glds16(_s + lane * 16, (unsigned)__builtin_amdgcn_readfirstlane(lds0 + (slot) + _p * 1024)); } } while (0)
    if (!PRE) { ATT_DMA(dir ? NT - 1 : 0, 0); ATT_DMA(dir ? NT - 2 : 1, SLOT); }
#pragma unroll
    for (int i = 0; i < 4; ++i) o[i] = f32x16{};
    float mref = 0.f, l = 0.f; f32x16 negm = f32x16{};
    int sl_cur = 0, sl_nn = 2 * SLOT;
    const LAS unsigned char* vp0 = lds + KB + ((lane >> 4) & 1) * 32 + (lane & 3) * 8 + (4 * hi + ((lane & 15) >> 2)) * 64;
    const LAS unsigned char* kp0 = lds + hi * 1024 + r32 * 16;
    const LAS float* tab = (const LAS float*)(lds + LDS_TAB);
    for (int it = 0; it < NT; ++it) {
        const int t = dir ? NT - 1 - it : it;
        if (it + 1 < NT) { if (NPW == 5) { ATT_WAITBAR(5); } else { ATT_WAITBAR(3); } } else { ATT_WAITBAR(0); }
        if (it + 2 < NT) ATT_DMA(dir ? NT - 3 - it : it + 2, sl_nn);
        if (t <= tmax) {
            f32x16 s0 = negm, s1 = negm;
            if (BIAS) { if (t + 2 >= tmax) { const int bbase = 64 * t + 4 * hi - qpos + 192;
#pragma unroll
                for (int r = 0; r < 16; ++r) { const int ix = bbase + (r & 3) + 8 * (r >> 2); s0[r] = tab[ix] - mref; s1[r] = tab[ix + 32] - mref; } } }
            const LAS unsigned char* kp = kp0 + sl_cur;
            {
                bf16x8 ka[2][2];
                ka[0][0] = *(const LAS bf16x8*)(kp); ka[0][1] = *(const LAS bf16x8*)(kp + 512);
                ka[1][0] = *(const LAS bf16x8*)(kp + 2048); ka[1][1] = *(const LAS bf16x8*)(kp + 2048 + 512);
#pragma unroll
                for (int d0 = 0; d0 < NKS; ++d0) {
                    const bf16x8 k0 = ka[d0 & 1][0], k1 = ka[d0 & 1][1];
                    if (d0 + 2 < NKS) { ka[d0 & 1][0] = *(const LAS bf16x8*)(kp + (d0 + 2) * 2048); ka[d0 & 1][1] = *(const LAS bf16x8*)(kp + (d0 + 2) * 2048 + 512); }
                    __builtin_amdgcn_sched_barrier(0);
                    s0 = __builtin_amdgcn_mfma_f32_32x32x16_bf16(k0, qf[d0], s0, 0, 0, 0);
                    s1 = __builtin_amdgcn_mfma_f32_32x32x16_bf16(k1, qf[d0], s1, 0, 0, 0);
                    __builtin_amdgcn_sched_barrier(0);
                }
            }
            const LAS unsigned char* vp = vp0 + sl_cur;
            s16x4 vl[2][4], vh[2][4];
#pragma unroll
            for (int db = 0; db < 4; ++db) { vl[0][db] = vtr(vp + db * 4096); vh[0][db] = vtr(vp + db * 4096 + 512); }
            __builtin_amdgcn_sched_barrier(0);
            float alpha; bf16x8 pf[4];
            const int tv = dir ? tmax - t : t;
            if (softmax_tile(s0, s1, mref, l, alpha, tv == 0, (tv & MK_SMCHK) == 0, pf)) {
#pragma unroll
                for (int r = 0; r < 16; ++r) negm[r] = -mref;
#pragma unroll
                for (int i = 0; i < 4; ++i)
#pragma unroll
                    for (int r = 0; r < 16; ++r) o[i][r] *= alpha;
            }
            {
#pragma unroll
                for (int ks = 0; ks < 4; ++ks) {
                    if (ks + 1 < 4) {
#pragma unroll
                        for (int db = 0; db < 4; ++db) { vl[(ks + 1) & 1][db] = vtr(vp + db * 4096 + (ks + 1) * 1024); vh[(ks + 1) & 1][db] = vtr(vp + db * 4096 + (ks + 1) * 1024 + 512); }
                    }
                    __builtin_amdgcn_sched_barrier(0);
#pragma unroll
                    for (int db = 0; db < 4; ++db) { const s16x4 lo = vl[ks & 1][db], hh = vh[ks & 1][db];
                        const bf16x8 vf = (bf16x8){lo[0], lo[1], lo[2], lo[3], hh[0], hh[1], hh[2], hh[3]};
                        o[db] = __builtin_amdgcn_mfma_f32_32x32x16_bf16(vf, pf[ks], o[db], 0, 0, 0); }
                    __builtin_amdgcn_sched_barrier(0);
                }
            }
        }
        sl_cur = (sl_cur == 2 * SLOT) ? 0 : sl_cur + SLOT; sl_nn = (sl_nn == 2 * SLOT) ? 0 : sl_nn + SLOT;
    }
    linv = fast_rcp(halfsum(l));
    asm volatile("s_waitcnt vmcnt(0) lgkmcnt(0)\n\ts_barrier" ::: "memory");
#undef ATT_DMA
}

struct NextPre { int kind; const char* kimg; int ktb; const char* vimg; int t0, t1; };
__device__ __forceinline__ void issue_pre(LAS unsigned char* lds, const NextPre& n) {
    if (n.kind == 0) return;
    const int tid = opaque_tid(), lane = tid & 63, wid = __builtin_amdgcn_readfirstlane(tid >> 6);
    const unsigned lds0 = (unsigned)(size_t)lds;
    if (n.kind == 1) {
#pragma unroll
        for (int sl = 0; sl < 2; ++sl) { const int t = sl ? n.t1 : n.t0;
#pragma unroll
            for (int i = 0; i < 5; ++i) { const int p = wid + 8 * i;
                const char* sp = (p < 24) ? n.kimg + (size_t)t * n.ktb + p * 1024 : n.vimg + (size_t)t * 16384 + (p - 24) * 1024;
                glds16(sp + lane * 16, (unsigned)__builtin_amdgcn_readfirstlane(lds0 + sl * SLOT + p * 1024)); } }
    } else {
#pragma unroll
        for (int t = 0; t < 2; ++t) glds16(n.kimg + (size_t)t * n.ktb + wid * 1024 + lane * 16, (unsigned)__builtin_amdgcn_readfirstlane(lds0 + t * 8192 + wid * 1024));
#pragma unroll
        for (int i = 0; i < 2; ++i) { const int p = wid + 8 * i; glds16(n.vimg + p * 1024 + lane * 16, (unsigned)__builtin_amdgcn_readfirstlane(lds0 + 24576 + p * 1024)); }
    }
}

__device__ __forceinline__ void st_pair16(bf16_t* rowp, int col8, int hi, u32x2 wa, u32x2 wb) {
    auto rx = __builtin_amdgcn_permlane32_swap(wa.x, wb.x, false, false); auto ry = __builtin_amdgcn_permlane32_swap(wa.y, wb.y, false, false);
    u32x4 v; v.x = rx[0]; v.y = ry[0]; v.z = rx[1]; v.w = ry[1];
    *(u32x4*)(rowp + col8 + (hi ? 8 : 0)) = v;
}

template <bool PRE = false>
__device__ __forceinline__ void mla_unit(LAS unsigned char* lds, int bh, int qb, const bf16_t* QM, const bf16_t* KM, const bf16_t* VM, bf16_t* BR, int dir = 0, NextPre nx = NextPre{0, nullptr, 0, nullptr, 0, 0}) {
    const int tid = opaque_tid(), lane = tid & 63, r32 = lane & 31, hi = lane >> 5, wid = __builtin_amdgcn_readfirstlane(tid >> 6);
    const int b = bh >> 2, h = bh & 3;
    const size_t qrow = (size_t)b * SEQ + qb * 256 + wid * 32 + r32;
    bf16x8 qf[12];
#pragma unroll
    for (int d0 = 0; d0 < 12; ++d0) qf[d0] = *(const bf16x8*)(QM + qrow * 768 + h * 192 + d0 * 16 + hi * 8);
    f32x16 o[4]; float inv;
    attn_core_v1<12, false, PRE>(lds, (const char*)(KM + km_addr(bh, 0, 0, 0)), 24576, (const char*)(VM + vimg_addr(bh, 0, 0, 0)), qf, 4 * (qb + 1), 4 * qb + (wid >> 1), 0, o, inv, dir);
    issue_pre(lds, nx);
    bf16_t* op = BR + qrow * 1536 + 512 + h * 128;
#pragma unroll
    for (int db = 0; db < 4; ++db)
#pragma unroll
        for (int g = 0; g < 4; g += 2) { u32x2 wa, wb;
            wa.x = cvt_pk_bf16(o[db][4 * g] * inv, o[db][4 * g + 1] * inv); wa.y = cvt_pk_bf16(o[db][4 * g + 2] * inv, o[db][4 * g + 3] * inv);
            wb.x = cvt_pk_bf16(o[db][4 * g + 4] * inv, o[db][4 * g + 5] * inv); wb.y = cvt_pk_bf16(o[db][4 * g + 6] * inv, o[db][4 * g + 7] * inv);
            st_pair16(op, db * 32 + g * 8, hi, wa, wb); }
}

template <bool PRE = false>
__device__ __forceinline__ void diff_unit(LAS unsigned char* lds, int bh, int qb, const bf16_t* DQ, const bf16_t* K12, const bf16_t* VD, bf16_t* BR,
                                          const float* biast, const float* gsub, unsigned lam_bits, unsigned osc_bits, NextPre nx = NextPre{0, nullptr, 0, nullptr, 0, 0}) {
    const int b = bh >> 2, h = bh & 3;
    const int NT = 4 * (qb + 1);
    const char* vimg = (const char*)(VD + vimg_addr(bh, 0, 0, 0));
#define DU_LANE(t_) const int lane = (t_) & 63, r32 = lane & 31, hi = lane >> 5, wid = __builtin_amdgcn_readfirstlane((t_) >> 6); (void)lane; (void)r32; (void)hi; (void)wid
#define DU_QROW ((unsigned)(b * SEQ + qb * 256 + wid * 32 + r32))
    {
        const int t0_ = opaque_tid(); DU_LANE(t0_);
        LAS float* tab = (LAS float*)(lds + LDS_TAB);
        if (t0_ < 256) tab[t0_] = biast[h * 256 + t0_];
        const int qpos = qb * 256 + wid * 32 + r32, tmax = 4 * qb + (wid >> 1);
        bf16x8 qf[4];
#pragma unroll
        for (int d0 = 0; d0 < 4; ++d0) qf[d0] = *(const bf16x8*)(DQ + (size_t)DU_QROW * 512 + h * 128 + d0 * 16 + hi * 8);
        f32x16 oa[4]; float inv;
        attn_core<4, true, PRE>(lds, (const char*)(K12 + k12_addr(bh, 0, 0, 0, 0)), 16384, vimg, qf, NT, tmax, qpos, oa, inv);
        if (MK_XPRE) issue_pre(lds, NextPre{2, (const char*)(K12 + k12_addr(bh, 0, 1, 0, 0)), 16384, vimg, 0, 1});
#if !MK_PARK_LDS
        const int t1_ = opaque_tid(); bf16_t* op = BR + (size_t)((unsigned)(b * SEQ + qb * 256) + (unsigned)(((t1_ >> 6) * 32) + (t1_ & 31))) * 1536 + 1024 + h * 128 + 4 * ((t1_ >> 5) & 1);
#endif
#pragma unroll
        for (int db = 0; db < 4; ++db)
#pragma unroll
            for (int g = 0; g < 4; ++g) { u32x2 w; w.x = cvt_pk_bf16(oa[db][4 * g] * inv, oa[db][4 * g + 1] * inv); w.y = cvt_pk_bf16(oa[db][4 * g + 2] * inv, oa[db][4 * g + 3] * inv);
#if MK_PARK_LDS
                *(LAS u32x2*)(lds + PARK_OFF(db * 4 + g) + opaque_tid() * 8) = w; }
#else
                *(u32x2*)(op + db * 32 + g * 8) = w; }
#endif
    }
    float ss = 0.f;
    f32x16 oa[4];
    {
        float inv;
        {   const int t0_ = opaque_tid(); DU_LANE(t0_);
            const int qpos = qb * 256 + wid * 32 + r32, tmax = 4 * qb + (wid >> 1);
            bf16x8 qf[4];
#pragma unroll
            for (int d0 = 0; d0 < 4; ++d0) qf[d0] = *(const bf16x8*)(DQ + (size_t)DU_QROW * 512 + h * 128 + 64 + d0 * 16 + hi * 8);
            attn_core<4, true, (MK_XPRE != 0)>(lds, (const char*)(K12 + k12_addr(bh, 0, 1, 0, 0)), 16384, vimg, qf, NT, tmax, qpos, oa, inv); }
        issue_pre(lds, nx);
        const float i2 = __uint_as_float(lam_bits) * inv;
        const int tid2_ = opaque_tid(); (void)tid2_;
#if !MK_PARK_LDS
        const bf16_t* op = BR + (size_t)((unsigned)(b * SEQ + qb * 256) + (unsigned)(((tid2_ >> 6) * 32) + (tid2_ & 31))) * 1536 + 1024 + h * 128 + 4 * ((tid2_ >> 5) & 1);
#endif
#pragma unroll
        for (int db = 0; db < 4; ++db)
#pragma unroll
            for (int g = 0; g < 4; ++g) {
#if MK_PARK_LDS
                const u32x2 w = *(const LAS u32x2*)(lds + PARK_OFF(db * 4 + g) + tid2_ * 8);
#else
                const u32x2 w = *(const u32x2*)(op + db * 32 + g * 8);
#endif
                const float v0 = bflo(w.x) - oa[db][4 * g] * i2, v1 = bfhi(w.x) - oa[db][4 * g + 1] * i2, v2 = bflo(w.y) - oa[db][4 * g + 2] * i2, v3 = bfhi(w.y) - oa[db][4 * g + 3] * i2;
                oa[db][4 * g] = v0; oa[db][4 * g + 1] = v1; oa[db][4 * g + 2] = v2; oa[db][4 * g + 3] = v3; ss += (v0 * v0 + v1 * v1) + (v2 * v2 + v3 * v3); }
    }
#if MK_PARK_LDS
    asm volatile("s_waitcnt lgkmcnt(0)\n\ts_barrier" ::: "memory");
#endif
    ss = halfsum(ss);
    const float rn = __builtin_amdgcn_rsqf(ss * (1.0f / 128.0f) + EPS) * __uint_as_float(osc_bits);
    const int t3_ = opaque_tid(); const int hi3 = (t3_ >> 5) & 1;
    bf16_t* op3 = BR + (size_t)((unsigned)(b * SEQ + qb * 256) + (unsigned)(((t3_ >> 6) * 32) + (t3_ & 31))) * 1536 + 1024 + h * 128;
#pragma unroll
    for (int db = 0; db < 4; ++db)
#pragma unroll
        for (int g = 0; g < 4; g += 2) { const f32x4 ga = *(const f32x4*)(gsub + db * 32 + g * 8 + 4 * hi3), gb = *(const f32x4*)(gsub + db * 32 + g * 8 + 8 + 4 * hi3);
            u32x2 wa, wb;
            wa.x = cvt_pk_bf16(oa[db][4 * g] * rn * ga[0], oa[db][4 * g + 1] * rn * ga[1]); wa.y = cvt_pk_bf16(oa[db][4 * g + 2] * rn * ga[2], oa[db][4 * g + 3] * rn * ga[3]);
            wb.x = cvt_pk_bf16(oa[db][4 * g + 4] * rn * gb[0], oa[db][4 * g + 5] * rn * gb[1]); wb.y = cvt_pk_bf16(oa[db][4 * g + 6] * rn * gb[2], oa[db][4 * g + 7] * rn * gb[3]);
            st_pair16(op3, db * 32 + g * 8, hi3, wa, wb); }
#undef DU_LANE
#undef DU_QROW
}
}
struct Args { const float* in[30]; float* out; unsigned char* ws; int ph_lo, ph_hi; };
struct Frame {
    LAS unsigned char* lds; int tid, lane, wave, G, vcu;
    float* out; unsigned char* ws;
};

struct ConvDesc { const float* src; const float* ks; bf16_t* dst; int ldsrc, Ksrc, Kdst, Nj, ldb, map, rowoff, f8; float wmul; };
__device__ __forceinline__ int conv_srccol(int map, int j) {
    if (map == 1) {
        if (j < 1408) return j;
        if (j < 1472) { const int q = j - 1408, g8 = q >> 3, w = q & 7; return 1408 + ((w < 4) ? 4 * g8 + w : 32 + 4 * g8 + (w - 4)); }
        if (j < 1536) return -1;
        return j - 64;
    }
    if (map == 2) { const int h = j / 192, w = j % 192; if (w < 128) return j; const int q = w - 128, g8 = q >> 3, ww = q & 7; return h * 192 + 128 + ((ww < 4) ? 4 * g8 + ww : 32 + 4 * g8 + (ww - 4)); }
    return j;
}
__device__ __forceinline__ int conv_dstrow(int map, int rowoff, int j) { return (map == 3) ? ((j >> 7) * 256 + (j & 127) + rowoff) : (j + rowoff); }
__device__ __forceinline__ void conv_load(const ConvDesc& d, int item, int lane, float (&v)[32]) {
    const int njb = d.Nj / 32, kb = item / njb, jb = item % njb, k0 = 64 * kb, j0 = 32 * jb;
    const int sc = conv_srccol(d.map, j0 + (lane & 31));
    const bool live = (sc >= 0) && (k0 < d.Ksrc);
    const float* sp = d.src + (size_t)(k0 + (lane >> 5)) * d.ldsrc + (sc < 0 ? 0 : sc);
#pragma unroll
    for (int i = 0; i < 32; ++i) v[i] = live ? sp[(size_t)(2 * i) * d.ldsrc] : 0.f;
    if (d.ks && live) {
#pragma unroll
        for (int i = 0; i < 32; ++i) v[i] *= d.ks[k0 + 2 * i + (lane >> 5)];
    }
}
__device__ __forceinline__ void conv_store(const ConvDesc& d, int item, LAS float* scr, int lane, const float (&v)[32]) {
    const int njb = d.Nj / 32, kb = item / njb, jb = item % njb, k0 = 64 * kb, j0 = 32 * jb;
#pragma unroll
    for (int i = 0; i < 32; ++i) scr[(2 * i + (lane >> 5)) * 33 + (lane & 31)] = v[i];
    LDS_WAIT(); asm volatile("" ::: "memory");
    const int c = lane & 7, r0 = conv_dstrow(d.map, d.rowoff, j0);
    if (d.f8) {
#pragma unroll
        for (int jj = 0; jj < 4; ++jj) { const int n = (lane >> 3) + 8 * jj; const LAS float* s = scr + (8 * c) * 33 + n; const float wm = d.wmul;
            u32x2 o; o.x = pack4_fp8(s[0 * 33] * wm, s[1 * 33] * wm, s[2 * 33] * wm, s[3 * 33] * wm); o.y = pack4_fp8(s[4 * 33] * wm, s[5 * 33] * wm, s[6 * 33] * wm, s[7 * 33] * wm);
            *(u32x2*)((unsigned char*)d.dst + (size_t)(r0 + n) * d.ldb + k0 + 8 * c) = o; }
    } else {
#pragma unroll
        for (int jj = 0; jj < 4; ++jj) { const int n = (lane >> 3) + 8 * jj; const LAS float* s = scr + (8 * c) * 33 + n;
            const float wm = d.wmul;
            u32x4 o; o.x = cvt_pk_bf16(s[0 * 33] * wm, s[1 * 33] * wm); o.y = cvt_pk_bf16(s[2 * 33] * wm, s[3 * 33] * wm); o.z = cvt_pk_bf16(s[4 * 33] * wm, s[5 * 33] * wm); o.w = cvt_pk_bf16(s[6 * 33] * wm, s[7 * 33] * wm);
            *(u32x4*)(d.dst + (size_t)(r0 + n) * d.ldb + k0 + 8 * c) = o; }
    }
    LDS_WAIT(); asm volatile("" ::: "memory");
}
__device__ __forceinline__ ConvDesc get_desc(const Frame& F, const Args& A, int mi, int ml) {
    ConvDesc d; d.ks = nullptr; d.map = 0; d.rowoff = 0; d.f8 = 0; d.wmul = 1.0f;
    if (mi < 40) { const int l = mi / 10, k = mi % 10; unsigned char* wb = F.ws + WS_WMIX + (size_t)l * WMIX_STRIDE;
        if (k == 0) { d.src = A.in[2] + (size_t)l * 1024 * 3008; d.ldsrc = 3008; d.Ksrc = d.Kdst = 1024; d.Nj = 3072; d.dst = (bf16_t*)(wb + WM_CAT); d.ldb = 1024; d.map = 1; if (MK_F8_INPROJ) { d.f8 = 1; d.wmul = (float)(1 << SWG); }
            else if (l >= MK_F8_INFROM) { d.f8 = 1; d.wmul = (float)(1 << SWG); d.dst = (bf16_t*)(wb + WM_G8 - (size_t)12 * 256 * 1024); } }
        else if (k < 4) { const int n = k - 1; d.src = A.in[17] + (size_t)(l * 3 + n) * 1024 * 1024; d.ldsrc = 1024; d.Ksrc = d.Kdst = 1024; d.Nj = 1024; d.ldb = 1024;
            if (MK_F8_GATES) { d.dst = (bf16_t*)(wb + WM_G8); d.rowoff = 1024 * n; d.f8 = 1; d.wmul = (float)(1 << SWG) * (MK_SWIFOLD ? LOG2E : 1.0f); } else { d.dst = (bf16_t*)(wb + WM_CAT); d.rowoff = 3072 + 1024 * n; } }
        else if (k == 4) { d.src = A.in[9] + (size_t)l * 256 * 768; d.ldsrc = 768; d.Ksrc = d.Kdst = 256; d.Nj = 768; d.dst = (bf16_t*)(wb + WM_UQ); d.ldb = 256; d.map = 2; d.ks = A.in[7] + l * 256; }
        else if (k == 5) { d.src = A.in[10] + (size_t)l * 128 * 1024; d.ldsrc = 1024; d.Ksrc = 128; d.Kdst = 256; d.Nj = 1024; d.dst = (bf16_t*)(wb + WM_UKV); d.ldb = 256; d.ks = A.in[8] + l * 128; }
        else if (k < 9) { const int n = k - 6; d.src = A.in[19] + (size_t)(l * 3 + n) * 512 * 1024; d.ldsrc = 1024; d.Ksrc = d.Kdst = 512; d.Nj = 1024; d.dst = (bf16_t*)(wb + WM_B) + (size_t)n * 1024 * 512; d.ldb = 512; if (MK_G8) d.wmul = 1.0f / 256.0f; }
        else { d.src = A.in[20] + (size_t)l * 1024 * 1024; d.ldsrc = 1024; d.Ksrc = d.Kdst = 1024; d.Nj = 1024; d.dst = (bf16_t*)(wb + WM_O); d.ldb = 1024; }
    } else if (mi < 46) { const int i = (mi - 40) / 3, k = (mi - 40) % 3; unsigned char* wb = F.ws + WS_WDEN + (size_t)i * WDEN_STRIDE;
        if (k < 2) { d.src = (k == 0 ? A.in[22] : A.in[23]) + (size_t)i * 1024 * FD; d.ldsrc = FD; d.Ksrc = d.Kdst = 1024; d.Nj = FD; d.dst = (bf16_t*)(wb + WD_13); d.ldb = 1024; d.map = 3; d.rowoff = 128 * k; if (F8_DENSE(i)) { d.f8 = 1; d.wmul = (float)(1 << SW13); } if (MK_SWIFOLD) d.wmul *= (k == 0 ? LOG2E : 1.0f / LOG2E); }
        else { d.src = A.in[24] + (size_t)i * FD * 1024; d.ldsrc = 1024; d.Ksrc = d.Kdst = FD; d.Nj = 1024; d.dst = (bf16_t*)(wb + WD_2); d.ldb = FD; if (F8_DENSE(i)) { d.f8 = 1; d.wmul = (float)(1 << SW2); } }
    } else { const int q = mi - 46, e = q / 3, k = q % 3; unsigned char* wb = F.ws + WS_WMOE; const size_t xe = (size_t)ml * NEXP + e;
        if (k < 2) { d.src = (k == 0 ? A.in[26] : A.in[27]) + xe * 1024 * FE; d.ldsrc = FE; d.Ksrc = d.Kdst = 1024; d.Nj = FE; d.dst = (bf16_t*)(wb + WE_13 + (size_t)e * 2 * FE * 1024); d.ldb = 1024; d.map = 3; d.rowoff = 128 * k; d.f8 = 1; d.wmul = (float)(1 << SW13) * (MK_SWIFOLD ? (k == 0 ? LOG2E : 1.0f / LOG2E) : 1.0f); }
        else { d.src = A.in[28] + xe * FE * 1024; d.ldsrc = 1024; d.Ksrc = d.Kdst = FE; d.Nj = 1024; d.dst = (bf16_t*)(wb + WE_2 + (size_t)e * 1024 * FE); d.ldb = FE; d.f8 = 1; d.wmul = (float)(1 << SW2); }
    }
    return d;
}
struct ConvCursor { int mi, base, cur; };
__device__ __forceinline__ bool conv_next(const Frame& F, const Args& A, ConvCursor& c, int mi_hi, int ml, ConvDesc& d, int& item) {
    while (c.mi < mi_hi) {
        d = get_desc(F, A, c.mi, ml);
        const int nit = (d.Nj / 32) * (d.Kdst / 64);
        if (c.cur < c.base + nit) { item = c.cur - c.base; return true; }
        c.base += nit; ++c.mi;
    }
    return false;
}
__device__ __forceinline__ void conv_range(const Frame& F0, const Args& A, int mi_lo, int mi_hi, int ml) {
    Frame F = F0; F.tid = opaque_tid(); F.lane = F.tid & 63;
    LAS float* scr = (LAS float*)(F.lds + F.wave * 16384);
    const int gw = F.vcu * NWAVES + F.wave, NGW = F.G * NWAVES;
    ConvCursor c{mi_lo, 0, gw};
    ConvDesc da, db; int ia = 0, ib = 0; float va[32], vb[32];
    bool ha = conv_next(F, A, c, mi_hi, ml, da, ia);
    if (ha) conv_load(da, ia, F.lane, va);
    while (ha) {
        c.cur += NGW; const bool hb = conv_next(F, A, c, mi_hi, ml, db, ib);
        if (hb) conv_load(db, ib, F.lane, vb);
        conv_store(da, ia, scr, F.lane, va);
        if (!hb) break;
        c.cur += NGW; ha = conv_next(F, A, c, mi_hi, ml, da, ia);
        if (ha) conv_load(da, ia, F.lane, va);
        conv_store(db, ib, scr, F.lane, vb);
    }
}
__device__ __forceinline__ float lam_init_of(int l) { return 0.8f - 0.6f * expf(-0.3f * (float)l); }
__device__ __forceinline__ void prologue_tables(const Frame& F0, const Args& A) {
    Frame F = F0; F.tid = opaque_tid(); F.lane = F.tid & 63;
    const int gt = F.vcu * NTHR + F.tid, NGT = F.G * NTHR;
    float* rc = (float*)(F.ws + WS_ROPEC); float* rs = (float*)(F.ws + WS_ROPES);
    for (int i = gt; i < SEQ * 32; i += NGT) { const int pos = i >> 5, k = i & 31;
        const float inv = powf(10000.0f, -((float)(2 * k)) / 64.0f); const float ang = (float)pos * inv;
        rc[i] = (float)cos((double)ang); rs[i] = (float)sin((double)ang); }
    if (gt < 1024) { const int h = gt >> 8, i = gt & 255, rel = i - 192; const int n = rel < 0 ? -rel : rel; int bk = rel > 0 ? 16 : 0;
        if (n < 8) bk += n; else { const float nf = (float)n; int lg = 8 + (int)(logf(nf / 8.0f) / 2.772588722239781f * 8.0f); lg = lg < 15 ? lg : 15; bk += lg; }
        const float* rb = A.in[16]; ((float*)(F.ws + WS_BIAST))[gt] = (rb[bk * 4 + h] - rb[15 * 4 + h]) * LOG2E; }
    if (gt < NLAYER) { const int l = gt; float a = 0.f, b2 = 0.f;
        for (int i = 0; i < 64; ++i) { a += A.in[11][l * 64 + i] * A.in[12][l * 64 + i]; b2 += A.in[13][l * 64 + i] * A.in[14][l * 64 + i]; }
        ((float*)(F.ws + WS_LAM))[l] = expf(a) - expf(b2) + lam_init_of(l); }
}

template <int MODE, bool XF32>
__device__ __forceinline__ void norm_phase(const Frame& F0, const void* xin, float* xout, const float* g, bool combine, const float* router, bool h8 = false) {
    Frame F = F0; F.tid = opaque_tid(); F.lane = F.tid & 63;
    bf16_t* H = (bf16_t*)(F.ws + WS_H); const bf16_t* Y = (const bf16_t*)(F.ws + WS_R + R_Y); const int* slot = (const int*)(F.ws + WS_SLOT);
    LAS float* rt = (LAS float*)F.lds;
    LAS int* cl = (LAS int*)(F.lds + 32768);
    if constexpr (MODE == 2) { for (int i = F.tid; i < 8192; i += NTHR) { const int k = i >> 3, e = i & 7; rt[e * 1024 + k] = router[i]; } }
    f32x4 gv[4];
#pragma unroll
    for (int j = 0; j < 4; ++j) gv[j] = *(const f32x4*)(g + 4 * (F.lane + 64 * j));
    int bx0 = blockIdx.x; asm volatile("" : "+s"(bx0));
    for (int rb = bx0; rb < 256; rb += F.G) {
        if (MODE == 2) { if (F.tid < 8) cl[F.tid] = 0; __syncthreads(); }
        u32x2 xr[2][4][4];
        if (!XF32 && MK_NPIPE) {
#pragma unroll
            for (int q = 0; q < 4; ++q)
#pragma unroll
                for (int j = 0; j < 4; ++j) xr[0][q][j] = *(const u32x2*)((const bf16_t*)xin + (size_t)(rb * 128 + F.wave * 16 + q) * 1024 + 4 * (F.lane + 64 * j));
        }
#pragma unroll
        for (int i0 = 0; i0 < 16; i0 += 4) {
            const int cb = (i0 >> 2) & 1;
            f32x4 vv[4][4]; u32x2 ya[4][4], yb[4][4]; int sl0[4], sl1[4];
            if (combine) {
#pragma unroll
                for (int q = 0; q < 4; ++q) { const int row = rb * 128 + F.wave * 16 + i0 + q; sl0[q] = slot[2 * row]; sl1[q] = slot[2 * row + 1]; }
            }
#pragma unroll
            for (int q = 0; q < 4; ++q) { const int row = rb * 128 + F.wave * 16 + i0 + q;
#pragma unroll
                for (int j = 0; j < 4; ++j) { if (XF32) vv[q][j] = *(const f32x4*)((const float*)xin + (size_t)row * 1024 + 4 * (F.lane + 64 * j));
                    else if (MK_NPIPE) { if (i0 + 4 < 16) xr[cb ^ 1][q][j] = *(const u32x2*)((const bf16_t*)xin + (size_t)(row + 4) * 1024 + 4 * (F.lane + 64 * j)); }
                    else { const u32x2 w = *(const u32x2*)((const bf16_t*)xin + (size_t)row * 1024 + 4 * (F.lane + 64 * j)); vv[q][j] = (f32x4){bflo(w.x), bfhi(w.x), bflo(w.y), bfhi(w.y)}; } } }
            if (combine) {
#pragma unroll
                for (int q = 0; q < 4; ++q)
#pragma unroll
                    for (int j = 0; j < 4; ++j) { ya[q][j] = *(const u32x2*)(Y + (size_t)sl0[q] * 1024 + 4 * (F.lane + 64 * j)); yb[q][j] = *(const u32x2*)(Y + (size_t)sl1[q] * 1024 + 4 * (F.lane + 64 * j)); }
            }
#pragma unroll
            for (int q = 0; q < 4; ++q) {
            const int row = rb * 128 + F.wave * 16 + i0 + q;
            f32x4 v[4]; float ss = 0.f;
#pragma unroll
            for (int j = 0; j < 4; ++j) { if (!XF32 && MK_NPIPE) { const u32x2 w = xr[cb][q][j]; v[j] = (f32x4){bflo(w.x), bfhi(w.x), bflo(w.y), bfhi(w.y)}; } else v[j] = vv[q][j]; }
            if (combine) {
#pragma unroll
                for (int j = 0; j < 4; ++j) { const u32x2 a = ya[q][j], b = yb[q][j];
                    v[j][0] += bflo(a.x) + bflo(b.x); v[j][1] += bfhi(a.x) + bfhi(b.x); v[j][2] += bflo(a.y) + bflo(b.y); v[j][3] += bfhi(a.y) + bfhi(b.y);
                    if (MODE != 3) { u32x2 w; w.x = cvt_pk_bf16(v[j][0], v[j][1]); w.y = cvt_pk_bf16(v[j][2], v[j][3]); *(u32x2*)((bf16_t*)(F.ws + WS_XB) + (size_t)row * 1024 + 4 * (F.lane + 64 * j)) = w; } } }
#pragma unroll
            for (int j = 0; j < 4; ++j) ss += (v[j][0] * v[j][0] + v[j][1] * v[j][1]) + (v[j][2] * v[j][2] + v[j][3] * v[j][3]);
            const float rsc = __builtin_amdgcn_rsqf(wave_sum(ss) * (1.0f / 1024.0f) + EPS);
#pragma unroll
            for (int j = 0; j < 4; ++j) v[j] = v[j] * rsc * gv[j];
            if (MODE == 3) {
#pragma unroll
                for (int j = 0; j < 4; ++j) *(f32x4*)(xout + (size_t)row * 1024 + 4 * (F.lane + 64 * j)) = v[j];
            } else if (MODE == 0 || (MODE == 1 && !h8)) {
                if (!(MODE == 0 && h8)) {
#pragma unroll
                for (int j = 0; j < 4; ++j) { u32x2 w; w.x = cvt_pk_bf16(v[j][0], v[j][1]); w.y = cvt_pk_bf16(v[j][2], v[j][3]); *(u32x2*)(H + (size_t)row * 1024 + 4 * (F.lane + 64 * j)) = w; }
                }
                if (MODE == 0 && MK_F8_GATES) {
#pragma unroll
                    for (int j = 0; j < 4; ++j) *(unsigned*)(F.ws + WS_H8 + (size_t)row * 1024 + 4 * (F.lane + 64 * j)) = pack4_fp8(v[j][0], v[j][1], v[j][2], v[j][3]); }
            } else {
#pragma unroll
                for (int j = 0; j < 4; ++j) *(unsigned*)((unsigned char*)H + (size_t)row * 1024 + 4 * (F.lane + 64 * j)) = pack4_fp8(v[j][0], v[j][1], v[j][2], v[j][3]);
            }
            if (MODE == 2) {
                float lg[8];
#pragma unroll
                for (int e = 0; e < 8; ++e) { float a = 0.f;
#pragma unroll
                    for (int j = 0; j < 4; ++j) { const f32x4 r4 = *(const LAS f32x4*)(rt + e * 1024 + 4 * (F.lane + 64 * j)); a += (v[j][0] * r4[0] + v[j][1] * r4[1]) + (v[j][2] * r4[2] + v[j][3] * r4[3]); }
                    lg[e] = wave_sum(a); }
                int e1 = 0; float b1 = lg[0];
#pragma unroll
                for (int e = 1; e < 8; ++e) if (lg[e] > b1) { b1 = lg[e]; e1 = e; }
                int e2 = -1; float b2 = -3.0e38f;
#pragma unroll
                for (int e = 0; e < 8; ++e) if (e != e1 && lg[e] > b2) { b2 = lg[e]; e2 = e; }
                const float w1 = 1.0f / (1.0f + expf(b2 - b1)), w2 = 1.0f - w1;
                if (F.lane == 0) { u32x4 s; s.x = (unsigned)e1; s.y = (unsigned)e2; s.z = __float_as_uint(w1); s.w = __float_as_uint(w2); *(u32x4*)(F.ws + WS_SEL + (size_t)row * 16) = s;
                    __hip_atomic_fetch_add(cl + e1, 1, __ATOMIC_RELAXED, __HIP_MEMORY_SCOPE_WORKGROUP); __hip_atomic_fetch_add(cl + e2, 1, __ATOMIC_RELAXED, __HIP_MEMORY_SCOPE_WORKGROUP); }
            }
        }
            }
        if (MODE == 2) { __syncthreads(); if (F.tid < 8) ((int*)(F.ws + WS_CNT))[rb * 8 + F.tid] = cl[F.tid]; __syncthreads(); }
    }
    if (MODE == 2) __syncthreads();
}

__device__ __forceinline__ void moe_gather_phase(const Frame& F0) {
    Frame F = F0; F.tid = opaque_tid(); F.lane = F.tid & 63;
    const int* cnt = (const int*)(F.ws + WS_CNT); const bf16_t* H = (const bf16_t*)(F.ws + WS_H); bf16_t* XG = (bf16_t*)(F.ws + WS_R + R_XG);
    int* slot = (int*)(F.ws + WS_SLOT); float* roww = (float*)(F.ws + WS_ROWW);
    LAS int* lc = (LAS int*)F.lds;
    LAS int* tot = lc + 2048;
    LAS int* pre = tot + 8;
    LAS int* lb = pre + 8;
    LAS int* pos = lb + 16;
    int bx0 = blockIdx.x; asm volatile("" : "+s"(bx0));
    for (int rb = bx0; rb < 256; rb += F.G) {
        __syncthreads();
        for (int i = F.tid; i < 2048; i += NTHR) lc[i] = cnt[i];
        __syncthreads();
        { const int e = F.wave; int st = 0, sp = 0;
            for (int b = F.lane; b < 256; b += 64) { const int c = lc[b * 8 + e]; st += c; sp += (b < rb) ? c : 0; }
            st = wave_isum(st); sp = wave_isum(sp);
            if (F.lane == 0) { tot[e] = st; pre[e] = sp; } }
        __syncthreads();
        if (F.tid == 0) { int bs = 0; for (int e = 0; e < 8; ++e) { lb[e] = bs; bs += (tot[e] + 255) & ~255; } lb[8] = bs; }
        __syncthreads();
        if (F.wave == 0) {
            int run[8];
#pragma unroll
            for (int e = 0; e < 8; ++e) run[e] = lb[e] + pre[e];
            for (int it = 0; it < 2; ++it) {
                const int tl = it * 64 + F.lane, row = rb * 128 + tl;
                const u32x4 s = *(const u32x4*)(F.ws + WS_SEL + (size_t)row * 16);
                const int e1 = (int)s.x, e2 = (int)s.y; int p1 = 0, p2 = 0;
                const unsigned long long lt = (1ull << F.lane) - 1ull;
#pragma unroll
                for (int e = 0; e < 8; ++e) {
                    const unsigned long long m1 = __ballot(e1 == e), m2 = __ballot(e2 == e);
                    if (e1 == e) p1 = run[e] + __popcll(m1 & lt);
                    if (e2 == e) p2 = run[e] + __popcll(m1) + __popcll(m2 & lt);
                    run[e] += __popcll(m1) + __popcll(m2);
                }
                pos[2 * tl] = p1; pos[2 * tl + 1] = p2;
                slot[2 * row] = p1; slot[2 * row + 1] = p2;
                roww[p1] = __uint_as_float(s.z); roww[p2] = __uint_as_float(s.w);
                if (MK_MOE_GATHER) { int* gidx = (int*)(F.ws + WS_GIDX); gidx[p1] = row; gidx[p2] = row; }
            }
        }
        __syncthreads();
        if (!MK_MOE_GATHER) { u32x4 rv[16];
#pragma unroll
          for (int i = 0; i < 16; ++i) rv[i] = *(const u32x4*)((const unsigned char*)H + (size_t)(rb * 128 + F.wave * 16 + i) * 1024 + 16 * F.lane);
#pragma unroll
          for (int i = 0; i < 16; ++i) { const int tl = F.wave * 16 + i; const int p1 = pos[2 * tl], p2 = pos[2 * tl + 1];
            *(u32x4*)((unsigned char*)XG + (size_t)p1 * 1024 + 16 * F.lane) = rv[i];
            *(u32x4*)((unsigned char*)XG + (size_t)p2 * 1024 + 16 * F.lane) = rv[i]; } }
        if (rb < 8) { const int e = rb, r0 = lb[e] + tot[e], r1 = lb[e + 1];
            unsigned z0_ = 0u; asm volatile("" : "+v"(z0_));
            if (MK_MOE_GATHER) { int* gidx = (int*)(F.ws + WS_GIDX); for (int r = r0 + F.tid; r < r1; r += NTHR) { gidx[r] = 0; roww[r] = 0.f; } }
            else
            for (int r = r0 + F.wave; r < r1; r += NWAVES) { const u32x4 z = (u32x4){z0_, z0_, z0_, z0_};
                *(u32x4*)((unsigned char*)XG + (size_t)r * 1024 + 16 * F.lane) = z; if (F.lane == 0) roww[r] = 0.f; } }
        if (rb == 0 && F.tid < 9) ((int*)(F.ws + WS_META))[F.tid] = lb[F.tid] >> 8;
    }
    __syncthreads();
}

__device__ __forceinline__ void gmlp_phase(const Frame& F0, const Args& A, int l) {
    Frame F = F0; F.tid = opaque_tid(); F.lane = F.tid & 63;
    const bf16_t* UV = (const bf16_t*)(F.ws + WS_R + R_UV); bf16_t* BR = (bf16_t*)(F.ws + WS_R + R_BR);
    const float* lng = A.in[3] + l * 512; const float* lnb = A.in[4] + l * 512; const float* wsp = A.in[5] + (size_t)l * 4 * 128 * 128; const float* bsp = A.in[6] + l * 4 * 128;
    LAS unsigned char* vn = F.lds;
    LAS unsigned char* wl = F.lds + 40960;
    LAS float* st = (LAS float*)(F.lds + 40960 + 34816);
    const int lane = F.lane, r32 = lane & 31, hi = lane >> 5;
    for (int sp = F.vcu; sp < T / 128; sp += F.G) {
        const int t0 = sp * 128;
        __syncthreads();
        {
            u32x4 wv[16];
#pragma unroll
            for (int i = 0; i < 16; ++i) wv[i] = *(const u32x4*)(UV + (size_t)(t0 + F.wave * 16 + i) * 1024 + 512 + 8 * lane);
#pragma unroll
            for (int i = 0; i < 16; ++i) { const int tl = F.wave * 16 + i; const u32x4 w = wv[i];
                const float a0 = bflo(w.x), a1 = bfhi(w.x), a2 = bflo(w.y), a3 = bfhi(w.y), a4 = bflo(w.z), a5 = bfhi(w.z), a6 = bflo(w.w), a7 = bfhi(w.w);
                float s = ((a0 + a1) + (a2 + a3)) + ((a4 + a5) + (a6 + a7));
                float q = ((a0 * a0 + a1 * a1) + (a2 * a2 + a3 * a3)) + ((a4 * a4 + a5 * a5) + (a6 * a6 + a7 * a7));
                s = wave_sum(s); q = wave_sum(q);
                const float mu = s * (1.0f / 512.0f), var = fmaxf(q * (1.0f / 512.0f) - mu * mu, 0.f);
                if (lane == 0) { st[tl] = mu; st[128 + tl] = __builtin_amdgcn_rsqf(var + EPS); } }
        }
        const int c8 = F.tid & 15;
        u32x4 wv[4]; f32x4 wr[8];
#define GM_LOAD(g_) do { _Pragma("unroll") for (int it = 0; it < 4; ++it) wv[it] = *(const u32x4*)(UV + (size_t)(t0 + (F.tid >> 4) + 32 * it) * 1024 + 512 + (g_) * 128 + 8 * c8); \
            _Pragma("unroll") for (int it = 0; it < 8; ++it) { const int idx = F.tid + it * NTHR; wr[it] = *(const f32x4*)(wsp + ((size_t)(g_) * 128 + (idx >> 5)) * 128 + 4 * (idx & 31)); } } while (0)
        GM_LOAD(0);
#pragma nounroll
        for (int g = 0; g < 4; ++g) {
            __syncthreads();
            {
                const f32x4 g0 = *(const f32x4*)(lng + g * 128 + 8 * c8), g1 = *(const f32x4*)(lng + g * 128 + 8 * c8 + 4);
                const f32x4 h0 = *(const f32x4*)(lnb + g * 128 + 8 * c8), h1 = *(const f32x4*)(lnb + g * 128 + 8 * c8 + 4);
#pragma unroll
                for (int it = 0; it < 4; ++it) { const int q = (F.tid >> 4) + 32 * it; const float mu = st[q], rsd = st[128 + q]; const u32x4 w = wv[it];
                    f32x4 x0 = (f32x4){bflo(w.x), bfhi(w.x), bflo(w.y), bfhi(w.y)}, x1 = (f32x4){bflo(w.z), bfhi(w.z), bflo(w.w), bfhi(w.w)};
                    x0 = (x0 - mu) * rsd * g0 + h0; x1 = (x1 - mu) * rsd * g1 + h1;
                    *(LAS u32x4*)(vn + q * 320 + c8 * 16) = pack8(x0, x1); }
#pragma unroll
                for (int it = 0; it < 8; ++it) { const int idx = F.tid + it * NTHR, p = idx >> 5, q4 = idx & 31; f32x4 w = wr[it];
                    if ((q4 >> 4) > (p >> 6)) w = (f32x4){0.f, 0.f, 0.f, 0.f};
                    u32x2 o; o.x = cvt_pk_bf16(w[0], w[1]); o.y = cvt_pk_bf16(w[2], w[3]); *(LAS u32x2*)(wl + p * 272 + 8 * q4) = o; }
            }
            if (g + 1 < 4) GM_LOAD(g + 1);
            const int pb = F.wave >> 1, nks = (pb < 2) ? 4 : 8;
            const int p = 32 * pb + r32; const float bs = bsp[g * 128 + p];
            const bf16_t* up = UV + (size_t)(t0 + p) * 1024 + g * 128 + 4 * hi; bf16_t* op = BR + (size_t)(t0 + p) * 1536 + g * 128 + 4 * hi;
            u32x2 uw[2][4];
#pragma unroll
            for (int j = 0; j < 2; ++j)
#pragma unroll
                for (int gg = 0; gg < 4; ++gg) uw[j][gg] = *(const u32x2*)(up + 32 * (2 * (F.wave & 1) + j) + 8 * gg);
            __syncthreads();
            f32x16 acc[2]; acc[0] = f32x16{}; acc[1] = f32x16{};
            const LAS unsigned char* ap = vn + (8 * hi + ((lane & 15) >> 2)) * 320 + (((lane >> 4) & 1) * 16 + (lane & 3) * 4) * 2;
            const LAS unsigned char* bp = wl + (32 * pb + r32) * 272 + 16 * hi;
            for (int ks = 0; ks < nks; ++ks) {
                const bf16x8 bfr = *(const LAS bf16x8*)(bp + 32 * ks);
#pragma unroll
                for (int j = 0; j < 2; ++j) { const int cb = 2 * (F.wave & 1) + j;
                    const s16x4 lo = attn::vtr(ap + ks * 16 * 320 + cb * 64), hh = attn::vtr(ap + ks * 16 * 320 + 4 * 320 + cb * 64);
                    const bf16x8 af = (bf16x8){lo[0], lo[1], lo[2], lo[3], hh[0], hh[1], hh[2], hh[3]};
                    acc[j] = __builtin_amdgcn_mfma_f32_32x32x16_bf16(af, bfr, acc[j], 0, 0, 0); }
            }
#pragma unroll
            for (int j = 0; j < 2; ++j)
#pragma unroll
                for (int gg = 0; gg < 4; ++gg) { const u32x2 w = uw[j][gg]; u32x2 o;
                    o.x = cvt_pk_bf16((acc[j][4 * gg] + bs) * bflo(w.x), (acc[j][4 * gg + 1] + bs) * bfhi(w.x));
                    o.y = cvt_pk_bf16((acc[j][4 * gg + 2] + bs) * bflo(w.y), (acc[j][4 * gg + 3] + bs) * bfhi(w.y));
                    *(u32x2*)(op + 32 * (2 * (F.wave & 1) + j) + 8 * gg) = o; }
        }
#undef GM_LOAD
    }
    __syncthreads();
}
#if MK_CHECK
#define CHK_NSTAGE 32
__device__ __forceinline__ void chk_acc(float* err, int stage, float got, float ref) {
    const float d = got - ref; float d2 = d * d, r2 = ref * ref;
    if (!(d2 == d2) || !(d2 < 1e30f)) d2 = 1e30f;
    atomicAdd(err + 2 * stage, d2); atomicAdd(err + 2 * stage + 1, r2);
}
__device__ __forceinline__ int chk_row(int i) { return (17 + 61 * i) % T; }
constexpr int CHK_NROWS = 512;
__global__ void chk_norm(const float* x, const float* g, const bf16_t* H, float* err, int stage) {
    const int row = chk_row(blockIdx.x); __shared__ float red[256]; float ss = 0.f;
    for (int c = threadIdx.x; c < 1024; c += 256) { const float v = x[(size_t)row * 1024 + c]; ss += v * v; }
    red[threadIdx.x] = ss; __syncthreads();
    for (int o = 128; o > 0; o >>= 1) { if (threadIdx.x < o) red[threadIdx.x] += red[threadIdx.x + o]; __syncthreads(); }
    const float rs = 1.0f / sqrtf(red[0] / 1024.f + EPS);
    for (int c = threadIdx.x; c < 1024; c += 256) chk_acc(err, stage, bf2f(H[(size_t)row * 1024 + c]), x[(size_t)row * 1024 + c] * rs * g[c]);
}
__device__ __forceinline__ float chk_dot_h(const bf16_t* H, int row, const float* W, int ldw, int col, int K) { float a = 0.f; for (int k = 0; k < K; ++k) a += bf2f(H[(size_t)row * K + k]) * W[(size_t)k * ldw + col]; return a; }
__global__ void chk_inproj(const bf16_t* H, const float* w_in, const float* w_gate, const float* b_gate, unsigned char* R, const float* rc, const float* rs, float* err, int stage) {
    const int row = chk_row(blockIdx.x), pos = row & (SEQ - 1), b = row >> 13, tile = pos >> 6, kv = pos & 63;
    const bf16_t *UV = (const bf16_t*)(R + R_UV), *CQ = (const bf16_t*)(R + R_CQ), *CKV = (const bf16_t*)(R + R_CKV), *DQ = (const bf16_t*)(R + R_DQ), *K12 = (const bf16_t*)(R + R_K12), *VD = (const bf16_t*)(R + R_VD), *G = (const bf16_t*)(R + R_G), *KM = (const bf16_t*)(R + R_KM);
    for (int c = threadIdx.x; c < 3008 + 3072; c += blockDim.x) {
        if (c < 3008) {
            if (c >= 1408 && c < 1472) { if (c >= 1440) continue; const int i = c - 1408;
                const float x1 = chk_dot_h(H, row, w_in, 3008, 1408 + i, 1024), x2 = chk_dot_h(H, row, w_in, 3008, 1440 + i, 1024);
                const float cs = rc[pos * 32 + i], sn = rs[pos * 32 + i], o1 = x1 * cs - x2 * sn, o2 = x2 * cs + x1 * sn;
                for (int h = 0; h < 4; ++h) { const size_t a = km_addr(b * 4 + h, tile, 16 + (i >> 2), kv); chk_acc(err, stage + 1, bf2f(KM[a + (i & 3)]), o1); chk_acc(err, stage + 1, bf2f(KM[a + 4 + (i & 3)]), o2); }
                continue; }
            const float v = chk_dot_h(H, row, w_in, 3008, c, 1024);
#if MK_CHECK == 35 || MK_CHECK == 36
            if (c < 1024) chk_acc(err, stage, bf2f(UV[(size_t)row * 1024 + c]), 1.0f / (1.0f + expf(-v)));
#elif MK_CHECK == 34
            if (c < 1024) chk_acc(err, stage, bf2f(UV[(size_t)row * 1024 + c]), 1.0f / (1.0f + expf(-(v + b_gate[c]))));
#else
            if (c < 1024) chk_acc(err, stage, bf2f(UV[(size_t)row * 1024 + c]), 0.5f * v * (1.0f + tanhf(0.7978845608f * (v + 0.044715f * v * v * v))));
#endif
            else if (c < 1280) chk_acc(err, stage + 2, bf2f(CQ[(size_t)row * 256 + c - 1024]), v);
            else if (c < 1408) chk_acc(err, stage + 2, bf2f(CKV[(size_t)row * 256 + c - 1280]), v);
            else if (c < 1984) chk_acc(err, stage + 3, bf2f(DQ[(size_t)row * 512 + c - 1472]), v * QS_DIF);
            else if (c < 2496) { const int cc = c - 1984, h = cc >> 7, mp = (cc & 127) >> 6, d = cc & 63; chk_acc(err, stage + 4, bf2f(K12[k12_addr(b * 4 + h, tile, mp, d >> 3, kv) + (d & 7)]), v); }
            else { const int cc = c - 2496, h = cc >> 7, d = cc & 127; chk_acc(err, stage + 5, bf2f(VD[vimg_addr(b * 4 + h, tile, d >> 5, kv) + (d & 31)]), v); }
        } else { const int gcol = c - 3008, n = gcol >> 10, cc = gcol & 1023;
            const float v = chk_dot_h(H, row, w_gate + (size_t)n * 1024 * 1024, 1024, cc, 1024) + b_gate[n * 1024 + cc];
#if MK_CHECK == 3
            const float gg = bf2f(G[(size_t)row * 3072 + gcol]);
            chk_acc(err, 0, gg, 1.0f / (1.0f + expf(-v)));
            chk_acc(err, 1, gg, 1.0f / (1.0f + expf(-b_gate[n * 1024 + cc])));
            { const int n2 = (n + 1) % 3; const float v2 = chk_dot_h(H, row, w_gate + (size_t)n2 * 1024 * 1024, 1024, cc, 1024); chk_acc(err, 2, gg, 1.0f / (1.0f + expf(-v2))); }
            { const int n2 = (n + 2) % 3; const float v2 = chk_dot_h(H, row, w_gate + (size_t)n2 * 1024 * 1024, 1024, cc, 1024); chk_acc(err, 3, gg, 1.0f / (1.0f + expf(-v2))); }
            chk_acc(err, 4, gg, 1.0f / (1.0f + expf(v)));
            chk_acc(err, 5, gg, 1.0f / (1.0f + exp2f(-v)));
            chk_acc(err, 6, gg, v);
            chk_acc(err, 7, gg, 1.0f / (1.0f + expf(-v * 1.4426950408889634f)));
#else
#if MK_CHECK == 37
            chk_acc(err, stage + 6, bf2f(G[(size_t)row * 3072 + gcol]), 0.5f * v * (1.0f + tanhf(0.7978845608f * (v + 0.044715f * v * v * v))));
#else
            chk_acc(err, stage + 6, bf2f(G[(size_t)row * 3072 + gcol]), 1.0f / (1.0f + expf(-v)));
#endif
#endif
        }
    }
}
__global__ void chk_mlaup(unsigned char* R, const float* w_uq, const float* w_ukv, const float* g_cq, const float* g_ckv, const float* rc, const float* rs, float* err, int stage) {
    const int row = chk_row(blockIdx.x), pos = row & (SEQ - 1), b = row >> 13, tile = pos >> 6, kv = pos & 63;
    const bf16_t *CQ = (const bf16_t*)(R + R_CQ), *CKV = (const bf16_t*)(R + R_CKV), *QM = (const bf16_t*)(R + R_QM), *KM = (const bf16_t*)(R + R_KM), *VM = (const bf16_t*)(R + R_VM);
    float sq = 0.f, sk = 0.f;
    for (int k = 0; k < 256; ++k) { const float v = bf2f(CQ[(size_t)row * 256 + k]); sq += v * v; }
    for (int k = 0; k < 128; ++k) { const float v = bf2f(CKV[(size_t)row * 256 + k]); sk += v * v; }
    const float rq = 1.0f / sqrtf(sq / 256.f + EPS), rk = 1.0f / sqrtf(sk / 128.f + EPS);
    for (int j = threadIdx.x; j < 768 + 1024; j += blockDim.x) {
        if (j < 768) { const int h = j / 192, w = j % 192;
            if (w < 128) { float a = 0.f; for (int k = 0; k < 256; ++k) a += bf2f(CQ[(size_t)row * 256 + k]) * g_cq[k] * w_uq[(size_t)k * 768 + j]; chk_acc(err, stage, bf2f(QM[(size_t)row * 768 + j]), a * rq * QS_MLA); }
            else if (w < 160) { const int i = w - 128; float a1 = 0.f, a2 = 0.f;
                for (int k = 0; k < 256; ++k) { const float cv = bf2f(CQ[(size_t)row * 256 + k]) * g_cq[k]; a1 += cv * w_uq[(size_t)k * 768 + j]; a2 += cv * w_uq[(size_t)k * 768 + j + 32]; }
                a1 *= rq; a2 *= rq; const float cs = rc[pos * 32 + i], sn = rs[pos * 32 + i];
                const int pc = h * 192 + 128 + 8 * (i >> 2) + (i & 3);
                chk_acc(err, stage + 1, bf2f(QM[(size_t)row * 768 + pc]), (a1 * cs - a2 * sn) * QS_MLA); chk_acc(err, stage + 1, bf2f(QM[(size_t)row * 768 + pc + 4]), (a2 * cs + a1 * sn) * QS_MLA); }
        } else { const int jj = j - 768, h = jj >> 8, w = jj & 255; float a = 0.f;
            for (int k = 0; k < 128; ++k) a += bf2f(CKV[(size_t)row * 256 + k]) * g_ckv[k] * w_ukv[(size_t)k * 1024 + jj];
            a *= rk;
            if (w < 128) chk_acc(err, stage + 2, bf2f(KM[km_addr(b * 4 + h, tile, w >> 3, kv) + (w & 7)]), a);
            else { const int d = w - 128; chk_acc(err, stage + 3, bf2f(VM[vimg_addr(b * 4 + h, tile, d >> 5, kv) + (d & 31)]), a); } }
    }
}
__global__ void chk_gmlp(unsigned char* R, const float* lng, const float* lnb, const float* wsp, const float* bsp, float* err, int stage) {
    const int row = chk_row(blockIdx.x), sp0 = row & ~127, p = row & 127;
    const bf16_t *UV = (const bf16_t*)(R + R_UV), *BR = (const bf16_t*)(R + R_BR);
    __shared__ float mu[128], rsd[128];
    if (threadIdx.x < 128) { const int t = sp0 + threadIdx.x; float s = 0.f, q = 0.f; for (int c = 0; c < 512; ++c) { const float v = bf2f(UV[(size_t)t * 1024 + 512 + c]); s += v; q += v * v; }
        const float m = s / 512.f; mu[threadIdx.x] = m; rsd[threadIdx.x] = 1.0f / sqrtf(fmaxf(q / 512.f - m * m, 0.f) + EPS); }
    __syncthreads();
    for (int c = threadIdx.x; c < 512; c += blockDim.x) { const int g = c >> 7; float a = 0.f;
        for (int q = 0; q < 128; ++q) { if ((q >> 6) > (p >> 6)) continue; const float vn = (bf2f(UV[(size_t)(sp0 + q) * 1024 + 512 + c]) - mu[q]) * rsd[q] * lng[c] + lnb[c]; a += wsp[((size_t)g * 128 + p) * 128 + q] * vn; }
        chk_acc(err, stage, bf2f(BR[(size_t)row * 1536 + c]), (a + bsp[g * 128 + p]) * bf2f(UV[(size_t)row * 1024 + c])); }
}
__global__ void chk_attn(unsigned char* R, const float* biast, const float* gsub, const float* lamp, int l, float* err, int stage) {
    const int kind = blockIdx.x & 1, si = blockIdx.x >> 1, b = si & 3, h = (si >> 2) & 3;
    const int qlist[12] = {0, 5, 63, 64, 100, 255, 256, 1000, 3071, 4096, 6000, 8191}; const int q = qlist[(si >> 4) % 12];
    const int row = b * SEQ + q, bh = b * 4 + h, nk = ((q >> 6) + 1) * 64;
    const bf16_t *QM = (const bf16_t*)(R + R_QM), *KM = (const bf16_t*)(R + R_KM), *VM = (const bf16_t*)(R + R_VM), *DQ = (const bf16_t*)(R + R_DQ), *K12 = (const bf16_t*)(R + R_K12), *VD = (const bf16_t*)(R + R_VD), *BR = (const bf16_t*)(R + R_BR);
    __shared__ float sc[8192]; __shared__ float red[256]; __shared__ float outv[2][128];
    const int nmap = kind ? 2 : 1;
    for (int mp = 0; mp < nmap; ++mp) {
        float mx = -1e30f;
        for (int k = threadIdx.x; k < nk; k += 256) { float a = 0.f;
            if (!kind) { for (int d = 0; d < 192; ++d) a += bf2f(QM[(size_t)row * 768 + h * 192 + d]) * bf2f(KM[km_addr(bh, k >> 6, d >> 3, k & 63) + (d & 7)]); }
            else { for (int d = 0; d < 64; ++d) a += bf2f(DQ[(size_t)row * 512 + h * 128 + mp * 64 + d]) * bf2f(K12[k12_addr(bh, k >> 6, mp, d >> 3, k & 63) + (d & 7)]);
                int ix = k - q + 192; if (ix < 0) ix = 0; a += biast[h * 256 + ix]; }
            sc[k] = a; mx = fmaxf(mx, a); }
        red[threadIdx.x] = mx; __syncthreads();
        for (int o = 128; o > 0; o >>= 1) { if (threadIdx.x < o) red[threadIdx.x] = fmaxf(red[threadIdx.x], red[threadIdx.x + o]); __syncthreads(); }
        mx = red[0]; __syncthreads(); float sm = 0.f;
        for (int k = threadIdx.x; k < nk; k += 256) { const float e = exp2f(sc[k] - mx); sc[k] = e; sm += e; }
        red[threadIdx.x] = sm; __syncthreads();
        for (int o = 128; o > 0; o >>= 1) { if (threadIdx.x < o) red[threadIdx.x] += red[threadIdx.x + o]; __syncthreads(); }
        sm = red[0]; __syncthreads();
        if (threadIdx.x < 128) { const int d = threadIdx.x; float a = 0.f; const bf16_t* V = kind ? VD : VM;
            for (int k = 0; k < nk; ++k) a += sc[k] * bf2f(V[vimg_addr(bh, k >> 6, d >> 5, k & 63) + (d & 31)]);
            outv[mp][d] = a / sm; }
        __syncthreads();
    }
    if (!kind) { if (threadIdx.x < 128) chk_acc(err, stage, bf2f(BR[(size_t)row * 1536 + 512 + h * 128 + threadIdx.x]), outv[0][threadIdx.x]); }
    else { const float lam = lamp[l]; float v = 0.f; if (threadIdx.x < 128) v = outv[0][threadIdx.x] - lam * outv[1][threadIdx.x];
        red[threadIdx.x] = v * v; __syncthreads();
        for (int o = 128; o > 0; o >>= 1) { if (threadIdx.x < o) red[threadIdx.x] += red[threadIdx.x + o]; __syncthreads(); }
        const float rn = 1.0f / sqrtf(red[0] / 128.f + EPS) * (1.0f - (0.8f - 0.6f * expf(-0.3f * (float)l)));
        if (threadIdx.x < 128) chk_acc(err, stage + 1, bf2f(BR[(size_t)row * 1536 + 1024 + h * 128 + threadIdx.x]), v * rn * gsub[threadIdx.x]); }
}
__global__ void chk_merged(unsigned char* R, const float* w_branch, float* err, int stage) {
    const int row = chk_row(blockIdx.x); const bf16_t *BR = (const bf16_t*)(R + R_BR), *G = (const bf16_t*)(R + R_G), *MG = (const bf16_t*)(R + R_MERGED);
    for (int c = threadIdx.x; c < 1024; c += blockDim.x) { float m = 0.f;
        for (int n = 0; n < 3; ++n) { float a = 0.f; for (int k = 0; k < 512; ++k) a += bf2f(BR[(size_t)row * 1536 + n * 512 + k]) * w_branch[((size_t)n * 512 + k) * 1024 + c]; m += a * bf2f(G[(size_t)row * 3072 + n * 1024 + c]); }
        chk_acc(err, stage, bf2f(MG[(size_t)row * 1024 + c]), m); }
}
__global__ void chk_resid(const bf16_t* A, int K, const float* W, const float* xin, const float* xsave, const float* xout, float* err, int stage) {
    const int row = chk_row(blockIdx.x);
    for (int c = threadIdx.x; c < 1024; c += blockDim.x) { float a = 0.f; for (int k = 0; k < K; ++k) a += bf2f(A[(size_t)row * K + k]) * W[(size_t)k * 1024 + c];
        const float xi = xsave ? xsave[(size_t)blockIdx.x * 1024 + c] : xin[(size_t)row * 1024 + c];
        chk_acc(err, stage, xout[(size_t)row * 1024 + c] - xi, a); }
}
__global__ void chk_save_rows(const float* x, float* xsave) { const int row = chk_row(blockIdx.x); for (int c = threadIdx.x; c < 1024; c += blockDim.x) xsave[(size_t)blockIdx.x * 1024 + c] = x[(size_t)row * 1024 + c]; }
__global__ void chk_swiglu(const bf16_t* H, const float* w1, const float* w3, int F_, const bf16_t* HM, float* err, int stage) {
    const int row = chk_row(blockIdx.x * 4);
    for (int c = threadIdx.x; c < F_; c += blockDim.x) { float a = 0.f, b2 = 0.f; for (int k = 0; k < 1024; ++k) { const float hv = bf2f(H[(size_t)row * 1024 + k]); a += hv * w1[(size_t)k * F_ + c]; b2 += hv * w3[(size_t)k * F_ + c]; }
        chk_acc(err, stage, bf2f(HM[(size_t)row * F_ + c]), a / (1.0f + expf(-a)) * b2); }
}
__global__ void chk_moe(const float* x, const float* g, const float* router, const float* w1, const float* w3, const float* w2, unsigned char* ws, float* err, int stage) {
    const int row = chk_row(blockIdx.x * 8); __shared__ float hf[1024]; __shared__ float red[256]; __shared__ float lg[8]; __shared__ float hid[FE];
    const bf16_t *H = (const bf16_t*)(ws + WS_H), *XG = (const bf16_t*)(ws + WS_R + R_XG), *HME = (const bf16_t*)(ws + WS_R + R_HME), *Y = (const bf16_t*)(ws + WS_R + R_Y);
    const int* slot = (const int*)(ws + WS_SLOT); const float* roww = (const float*)(ws + WS_ROWW); const int* meta = (const int*)(ws + WS_META);
    float ss = 0.f; for (int c = threadIdx.x; c < 1024; c += 256) { const float v = x[(size_t)row * 1024 + c]; ss += v * v; }
    red[threadIdx.x] = ss; __syncthreads();
    for (int o = 128; o > 0; o >>= 1) { if (threadIdx.x < o) red[threadIdx.x] += red[threadIdx.x + o]; __syncthreads(); }
    const float rs = 1.0f / sqrtf(red[0] / 1024.f + EPS);
    for (int c = threadIdx.x; c < 1024; c += 256) hf[c] = x[(size_t)row * 1024 + c] * rs * g[c];
    __syncthreads();
    if (threadIdx.x < 8) { float a = 0.f; for (int k = 0; k < 1024; ++k) a += hf[k] * router[k * 8 + threadIdx.x]; lg[threadIdx.x] = a; }
    __syncthreads();
    int e1 = 0; for (int e = 1; e < 8; ++e) if (lg[e] > lg[e1]) e1 = e;
    int e2 = -1; for (int e = 0; e < 8; ++e) if (e != e1 && (e2 < 0 || lg[e] > lg[e2])) e2 = e;
    const float w1v = 1.0f / (1.0f + expf(lg[e2] - lg[e1]));
    for (int k2 = 0; k2 < 2; ++k2) { const int e = k2 ? e2 : e1; const float wv = k2 ? 1.0f - w1v : w1v; const int r = slot[2 * row + k2];
        if (threadIdx.x == 0) { chk_acc(err, stage, roww[r], wv); int er = 0; for (int j = 1; j < 8; ++j) er += ((r >> 8) >= meta[j]) ? 1 : 0; chk_acc(err, stage, (float)er + 1.f, (float)e + 1.f); }
        for (int c = threadIdx.x; c < 1024; c += 256) chk_acc(err, stage + 1, bf2f(XG[(size_t)r * 1024 + c]), bf2f(H[(size_t)row * 1024 + c]));
        for (int c = threadIdx.x; c < FE; c += 256) { float a = 0.f, b2 = 0.f; for (int k = 0; k < 1024; ++k) { const float hv = bf2f(H[(size_t)row * 1024 + k]); a += hv * w1[((size_t)e * 1024 + k) * FE + c]; b2 += hv * w3[((size_t)e * 1024 + k) * FE + c]; }
            const float hvv = a / (1.0f + expf(-a)) * b2; chk_acc(err, stage + 2, bf2f(HME[(size_t)r * FE + c]), hvv); }
        __syncthreads();
        for (int c = threadIdx.x; c < FE; c += 256) hid[c] = bf2f(HME[(size_t)r * FE + c]);
        __syncthreads();
        for (int c = threadIdx.x; c < 1024; c += 256) { float a = 0.f; for (int k = 0; k < FE; ++k) a += hid[k] * w2[((size_t)e * FE + k) * 1024 + c]; chk_acc(err, stage + 3, bf2f(Y[(size_t)r * 1024 + c]), a * wv); }
        __syncthreads(); }
}
__global__ void chk_combine(const float* xsave, const float* xout, unsigned char* ws, float* err, int stage) {
    const int row = chk_row(blockIdx.x); const bf16_t* Y = (const bf16_t*)(ws + WS_R + R_Y); const int* slot = (const int*)(ws + WS_SLOT);
    for (int c = threadIdx.x; c < 1024; c += blockDim.x) chk_acc(err, stage, xout[(size_t)row * 1024 + c] - xsave[(size_t)blockIdx.x * 1024 + c], bf2f(Y[(size_t)slot[2 * row] * 1024 + c]) + bf2f(Y[(size_t)slot[2 * row + 1] * 1024 + c]));
}
__global__ void chk_wcat(const bf16_t* Wcat, const float* w_in, const float* w_gate, float* err) {
    const int r = (blockIdx.x * 37) % 6144;
    for (int k = threadIdx.x; k < 1024; k += blockDim.x) {
        if (r < 3072) { const int sc = conv_srccol(1, r); const float ref = sc < 0 ? 0.f : w_in[(size_t)k * 3008 + sc]; chk_acc(err, 16, bf2f(Wcat[(size_t)r * 1024 + k]), ref); }
        else { const int n = (r - 3072) >> 10, cc = (r - 3072) & 1023; chk_acc(err, 17 + n, bf2f(Wcat[(size_t)r * 1024 + k]), w_gate[((size_t)n * 1024 + k) * 1024 + cc]); }
    }
}
__global__ void chk_encode(const float* err, float* out, int n) {
    __shared__ float sa; __shared__ int sidx;
    if (threadIdx.x == 0) { int idx = 0; float eb = 0.f, emax = 0.f;
        for (int s = 0; s < CHK_NSTAGE; ++s) { const float d2 = err[2 * s], r2 = err[2 * s + 1]; if (r2 == 0.f && d2 == 0.f) continue; float e = sqrtf(d2 / fmaxf(r2, 1e-30f)); if (!(e == e)) e = 1e3f; e = fminf(e, 1e3f);
            if (e > emax) emax = e; if (idx == 0 && e > 0.03f) { idx = s + 1; eb = e; } }
#if MK_CHECK == 33
        { int bi = 0; float be = 1e30f; for (int s = 0; s < 8; ++s) { const float e = sqrtf(err[2 * s] / fmaxf(err[2 * s + 1], 1e-30f)); if (e < be) { be = e; bi = s; } } idx = bi; eb = be; emax = be; }
#endif
#ifdef MK_SEL
        { const float e = sqrtf(err[2 * MK_SEL] / fmaxf(err[2 * MK_SEL + 1], 1e-30f)); idx = MK_SEL + 1; eb = (e == e) ? fminf(e, 1e3f) : 1e3f; }
#endif
        sa = sqrtf(1000.f * (idx ? eb : emax)); sidx = idx; }
    __syncthreads();
    const float a = sa;
    for (size_t i = (size_t)blockIdx.x * blockDim.x + threadIdx.x; i < (size_t)n; i += (size_t)gridDim.x * blockDim.x) { unsigned hsh = (unsigned)i * 2654435761u; hsh ^= hsh >> 15; out[i] = (hsh & 1u) ? a : -a; }
    if (blockIdx.x == 0 && threadIdx.x == 0) out[0] = 100.f * (float)(1 + sidx);
}
#endif
constexpr int CW_BAR = 4096;
constexpr int N_PHASES = 42;

__global__ void __launch_bounds__(NTHR, 2) mk_fwd(Args args) {
    extern __shared__ __attribute__((aligned(16))) unsigned char lds_raw[];
    Frame F;
    F.lds = (LAS unsigned char*)lds_raw;
    F.tid = threadIdx.x; F.lane = F.tid & 63; F.wave = __builtin_amdgcn_readfirstlane(F.tid >> 6);
    F.G = gridDim.x; { const int bx = blockIdx.x; F.vcu = (F.G % 8 == 0) ? (bx % 8) * (F.G / 8) + bx / 8 : bx; }
    F.out = args.out; F.ws = args.ws; F.tid = 0; F.lane = 0;
    volatile LAS unsigned* MISC = (volatile LAS unsigned*)(F.lds + MISC_OFF);
    if (threadIdx.x < 64) MISC[threadIdx.x] = 0u;
    __syncthreads();
    XcdBarrier bar = xcd_barrier_post((unsigned*)(F.ws + WS_CTL) + CW_BAR, MISC + 8);
    const int lo = args.ph_lo, hi = args.ph_hi;
#ifndef MK_EN
#define MK_EN 0xFFFFF
#endif
#define EN(b) ((MK_EN >> (b)) & 1)
#ifndef MK_ALIGN_RMW
#define MK_ALIGN_RMW true
#endif
#ifndef MK_SPLIT_INPROJ
#define MK_SPLIT_INPROJ 0
#endif
#ifndef MK_ALIGN_VALU
#define MK_ALIGN_VALU true
#endif
#ifndef MK_LOCKSTEP
#define MK_LOCKSTEP 4
#endif
#ifndef MK_DUP
#define MK_DUP 0
#endif
#define NREP(b) (((MK_DUP >> (b)) & 1) ? 2 : 1)
#define IN(k) (lo <= (k) && (k) < hi)
#if MK_TIME
#define STAMP(k) do { if (blockIdx.x == 0 && threadIdx.x == 0) ((unsigned long long*)(Fk0ws + WS_END))[(k)] = __builtin_amdgcn_s_memrealtime(); } while (0)
#else
#define STAMP(k) do { } while (0)
#endif
#define SEAM(k) do { if (IN(k) && IN((k) + 1)) { xcd_barrier(bar); if (NREP(20) == 2) xcd_barrier(bar); } STAMP((k) + 1); } while (0)
    const int cblk = (int)blockIdx.x;
    unsigned char* const Fk0ws = args.ws; STAMP(0);

    if (IN(0) && EN(0)) { for (int rep_ = 0; rep_ < NREP(10); ++rep_) { conv_range(F, args, 0, 70, 0); prologue_tables(F, args); } }
    SEAM(0);

    const Frame Fk = F;
#pragma nounroll
    for (int l = 0; l < NLAYER; ++l) {
        Frame F = Fk;
        { unsigned char* w_ = F.ws; float* o_ = F.out; unsigned l_ = (unsigned)(size_t)F.lds; asm volatile("" : "+s"(w_), "+s"(o_), "+s"(l_)); F.ws = w_; F.out = o_; F.lds = (LAS unsigned char*)(size_t)l_; }
        unsigned char* R = F.ws + WS_R;
        const float* rc = (const float*)(F.ws + WS_ROPEC); const float* rs = (const float*)(F.ws + WS_ROPES);
        const int pb = 1 + 10 * l; const bool moe = (l & 1) != 0; const int fi = l >> 1;
        unsigned char* wmix = F.ws + WS_WMIX + (size_t)l * WMIX_STRIDE;
        bf16_t* XB = (bf16_t*)(F.ws + WS_XB);
        if (IN(pb + 0) && EN(1)) {
            if (l == 0) norm_phase<0, true>(F, args.in[0], F.out, args.in[1], false, nullptr);
            else        norm_phase<0, false>(F, XB, F.out, args.in[1] + l * 1024, (l == 2), nullptr, MK_F8_GATES && l >= MK_F8_INFROM);
            if (l == 2) conv_range(F, args, 46, 70, 1);
        }
        SEAM(pb + 0);
        if (IN(pb + 1) && EN(2)) { for (int rep_ = 0; rep_ < NREP(1); ++rep_) {
            pg8::Gemm g{1024, 1024, 1024, 127};
            pg8::EpiInproj E{R, (float*)(F.ws + WS_CQP), (float*)(F.ws + WS_CKVP), args.in[18] + (size_t)l * 3072, rc, rs};
#if MK_F8_GATES
#if MK_F8_INPROJ
            { pg8::Gemm g8{512, 512, 512, 127 - SWG};
              pg8::SchedDense S{T / 256, 12, F.G, cblk, (const char*)(F.ws + WS_H8), (const char*)(wmix + WM_CAT), (size_t)256 * 1024, (size_t)256 * 1024};
              pg8::gemm_phase<pg8::EpiInproj, pg8::SchedDense, MK_ALIGN_VALU, true>(F.lds, g8, S, E); }
#else
            const bool in8 = (l >= MK_F8_INFROM);
            if (!in8) { pg8::SchedDense S{T / 256, 12, F.G, cblk, (const char*)(F.ws + WS_H), (const char*)(wmix + WM_CAT), (size_t)256 * 1024 * 2, (size_t)256 * 1024 * 2};
              pg8::gemm_phase<pg8::EpiInproj, pg8::SchedDense, MK_ALIGN_VALU>(F.lds, g, S, E); }
#endif
            { pg8::Gemm g8{512, 512, 512, 127 - SWG};
              pg8::SchedDense S{T / 256, in8 ? 24 : 12, F.G, cblk, (const char*)(F.ws + WS_H8), (const char*)(wmix + WM_G8) - (size_t)12 * 256 * 1024, (size_t)256 * 1024, (size_t)256 * 1024, in8 ? 0 : 12};
              pg8::gemm_phase<pg8::EpiInproj, pg8::SchedDense, MK_ALIGN_VALU, true>(F.lds, g8, S, E); }
#else
            pg8::SchedDense S{T / 256, NCAT / 256, F.G, cblk, (const char*)(F.ws + WS_H), (const char*)(wmix + WM_CAT), (size_t)256 * 1024 * 2, (size_t)256 * 1024 * 2};
            pg8::gemm_phase(F.lds, g, S, E);
#endif
        } }
        SEAM(pb + 1);
        if (IN(pb + 2) && EN(3)) { {
            if (EN(16)) for (int rep_ = 0; rep_ < NREP(16); ++rep_) { pg8::Gemm g{256, 256, 256, 127};
              pg8::SchedDense S{T / 256, 3, F.G, cblk, (const char*)(R + R_CQ), (const char*)(wmix + WM_UQ), (size_t)256 * 256 * 2, (size_t)256 * 256 * 2};
              pg8::EpiQ E{(bf16_t*)(R + R_QM), (const float*)(F.ws + WS_CQP), rc, rs};
              pg8::gemm_phase(F.lds, g, S, E); }
            if (EN(17)) for (int rep_ = 0; rep_ < NREP(17); ++rep_) { pg8::Gemm g{256, 256, 256, 127};
              pg8::SchedDense S{T / 256, 4, F.G, cblk, (const char*)(R + R_CKV), (const char*)(wmix + WM_UKV), (size_t)256 * 256 * 2, (size_t)256 * 256 * 2};
              pg8::EpiKV E{(bf16_t*)(R + R_KM), (bf16_t*)(R + R_VM), (const float*)(F.ws + WS_CKVP)};
              pg8::gemm_phase(F.lds, g, S, E); }
            if (EN(18)) for (int rep_ = 0; rep_ < NREP(18); ++rep_) gmlp_phase(F, args, l);
        } }
        SEAM(pb + 2);
        if (IN(pb + 3) && EN(4)) { for (int rep_ = 0; rep_ < NREP(3); ++rep_) {
            const unsigned lam_b = (unsigned)__builtin_amdgcn_readfirstlane((int)__float_as_uint(((const float*)(F.ws + WS_LAM))[l])), osc_b = (unsigned)__builtin_amdgcn_readfirstlane((int)__float_as_uint(1.0f - lam_init_of(l)));
            for (int pidx = F.vcu; pidx < 256; pidx += F.G) {
                const int bh = pidx >> 4, s = pidx & 15;
#if MK_LOCKSTEP
#if MK_XPRE && MK_LOCKSTEP == 4 && !MK_DUP
#define XPRE_ON 1
                {
                    const bf16_t* KMp = (const bf16_t*)(R + R_KM); const bf16_t* VMp = (const bf16_t*)(R + R_VM); const bf16_t* K12p = (const bf16_t*)(R + R_K12); const bf16_t* VDp = (const bf16_t*)(R + R_VD);
                    const int ntB = 4 * (32 - s);
                    const attn::NextPre nMla{1, (const char*)(KMp + km_addr(bh, 0, 0, 0)), 24576, (const char*)(VMp + vimg_addr(bh, 0, 0, 0)), ntB - 1, ntB - 2};
                    const attn::NextPre nDif{2, (const char*)(K12p + k12_addr(bh, 0, 0, 0, 0)), 16384, (const char*)(VDp + vimg_addr(bh, 0, 0, 0)), 0, 1};
                    attn::mla_unit<false>(F.lds, bh, s, (const bf16_t*)(R + R_QM), KMp, VMp, (bf16_t*)(R + R_BR), 0, nMla);
                    attn::mla_unit<true>(F.lds, bh, 31 - s, (const bf16_t*)(R + R_QM), KMp, VMp, (bf16_t*)(R + R_BR), 1, nDif);
                    attn::diff_unit<true>(F.lds, bh, s, (const bf16_t*)(R + R_DQ), K12p, VDp, (bf16_t*)(R + R_BR), (const float*)(F.ws + WS_BIAST), args.in[15] + l * 128, lam_b, osc_b, nDif);
                    attn::diff_unit<true>(F.lds, bh, 31 - s, (const bf16_t*)(R + R_DQ), K12p, VDp, (bf16_t*)(R + R_BR), (const float*)(F.ws + WS_BIAST), args.in[15] + l * 128, lam_b, osc_b);
                }
#else
#define XPRE_ON 0
#endif
#if XPRE_ON
#elif MK_LOCKSTEP == 4
                if (EN(19)) for (int k = 0; k < 2 * NREP(19); ++k)
                    attn::mla_unit(F.lds, bh, (k & 1) ? 31 - s : s, (const bf16_t*)(R + R_QM), (const bf16_t*)(R + R_KM), (const bf16_t*)(R + R_VM), (bf16_t*)(R + R_BR), k & 1);
#else
                if (EN(19)) for (int k = 0; k < 2 * NREP(19); ++k) { const int j5 = pidx & 31, x5 = pidx >> 5;
                    attn::mla_unit(F.lds, 2 * x5 + (k & 1), (k & 1) ? 31 - j5 : j5, (const bf16_t*)(R + R_QM), (const bf16_t*)(R + R_KM), (const bf16_t*)(R + R_VM), (bf16_t*)(R + R_BR), k & 1); }
#endif
#else
                if (EN(19)) for (int k = 0; k < 2 * NREP(19); ++k) attn::mla_unit(F.lds, bh, (k & 1) ? 31 - s : s, (const bf16_t*)(R + R_QM), (const bf16_t*)(R + R_KM), (const bf16_t*)(R + R_VM), (bf16_t*)(R + R_BR));
#endif
#if !XPRE_ON
                if (EN(14)) for (int k = 0; k < 2 * NREP(14); ++k) attn::diff_unit(F.lds, bh, (k & 1) ? 31 - s : s, (const bf16_t*)(R + R_DQ), (const bf16_t*)(R + R_K12), (const bf16_t*)(R + R_VD), (bf16_t*)(R + R_BR),
                                                          (const float*)(F.ws + WS_BIAST), args.in[15] + l * 128, lam_b, osc_b);
#endif
            }
        } }
        SEAM(pb + 3);
        if (IN(pb + 4) && EN(5)) { {
            pg8::Gemm g{512, 1536, 512, 127};
            pg8::SchedBranch S{T / 256, 4, F.G, cblk, (const char*)(R + R_BR), (const char*)(wmix + WM_B), (size_t)256 * 1536 * 2, (size_t)256 * 512 * 2, (size_t)512 * 2, (size_t)1024 * 512 * 2};
            pg8::EpiBranch E{(bf16_t*)(R + R_MERGED), (const bf16_t*)(R + R_G), R + R_KM + (size_t)blockIdx.x * 131072};
            pg8::gemm_phase<pg8::EpiBranch, pg8::SchedBranch, MK_ALIGN_RMW>(F.lds, g, S, E);

        } }
        SEAM(pb + 4);
        if (IN(pb + 5) && EN(6)) {
            pg8::Gemm g{1024, 1024, 1024, 127};
            pg8::SchedDense S{T / 256, 4, F.G, cblk, (const char*)(R + R_MERGED), (const char*)(wmix + WM_O), (size_t)256 * 1024 * 2, (size_t)256 * 1024 * 2};
            if (l == 0) { pg8::EpiResidB<true> E{args.in[0], XB}; pg8::gemm_phase(F.lds, g, S, E); }
            else        { pg8::EpiResidB<false> E{XB, XB}; pg8::gemm_phase(F.lds, g, S, E); }
        }
        SEAM(pb + 5);
        if (IN(pb + 6) && EN(7)) { for (int rep_ = 0; rep_ < NREP(6); ++rep_) {
            if (moe) norm_phase<2, false>(F, XB, F.out, args.in[21] + l * 1024, false, args.in[25] + (size_t)fi * 1024 * 8);
            else     norm_phase<1, false>(F, XB, F.out, args.in[21] + l * 1024, false, nullptr, F8_DENSE(fi) != 0);
        } }
        SEAM(pb + 6);
        if (moe) {
            if (IN(pb + 7) && EN(8)) for (int rep_ = 0; rep_ < NREP(7); ++rep_) moe_gather_phase(F);
            SEAM(pb + 7);
            if (IN(pb + 8) && EN(9)) { for (int rep_ = 0; rep_ < NREP(8); ++rep_) {
                const int* meta = (const int*)(F.ws + WS_META);
                pg8::Gemm g{512, 512, 512, 127 - SW13};
#if MK_MOE_GATHER
                pg8::SchedMoeG S; S.gidx = (const int*)(F.ws + WS_GIDX); S.A = (const char*)(F.ws + WS_H);
#else
                pg8::SchedMoe S; S.A = (const char*)(R + R_XG);
#endif
                S.nM = __builtin_amdgcn_readfirstlane(meta[8]); S.nN = 2 * FE / 256; S.G = F.G; S.c = cblk; S.B = (const char*)(F.ws + WS_WMOE + WE_13);
                S.astep = (size_t)256 * 1024; S.bstep = (size_t)256 * 1024; S.bexp = (size_t)2 * FE * 1024;
#pragma unroll
                for (int j = 0; j < 9; ++j) S.ts[j] = __builtin_amdgcn_readfirstlane(meta[j]);
                pg8::EpiSwiglu8 E{R + R_HME, FE};
#if MK_MOE_GATHER
                pg8::gemm_phase<pg8::EpiSwiglu8, pg8::SchedMoeG, MK_ALIGN_VALU, true>(F.lds, g, S, E);
#else
                pg8::gemm_phase<pg8::EpiSwiglu8, pg8::SchedMoe, MK_ALIGN_VALU, true>(F.lds, g, S, E);
#endif
            } }
            SEAM(pb + 8);
            if (IN(pb + 9) && EN(10)) { for (int rep_ = 0; rep_ < NREP(9); ++rep_) {
                const int* meta = (const int*)(F.ws + WS_META);
                pg8::Gemm g{FE / 2, FE / 2, FE / 2, 127 - SW2};
                pg8::SchedMoe S; S.nM = __builtin_amdgcn_readfirstlane(meta[8]); S.nN = 4; S.G = F.G; S.c = cblk; S.A = (const char*)(R + R_HME); S.B = (const char*)(F.ws + WS_WMOE + WE_2);
                S.astep = (size_t)256 * FE; S.bstep = (size_t)256 * FE; S.bexp = (size_t)1024 * FE;
#pragma unroll
                for (int j = 0; j < 9; ++j) S.ts[j] = __builtin_amdgcn_readfirstlane(meta[j]);
                pg8::EpiMoeDown E{(bf16_t*)(R + R_Y), (const float*)(F.ws + WS_ROWW)};
                pg8::gemm_phase<pg8::EpiMoeDown, pg8::SchedMoe, true, true>(F.lds, g, S, E);
            } }
            SEAM(pb + 9);
        } else {
            STAMP(pb + 8);
            unsigned char* wden = F.ws + WS_WDEN + (size_t)fi * WDEN_STRIDE;
            if (IN(pb + 8) && EN(11)) {
                if (F8_DENSE(fi)) {
                    pg8::Gemm g{512, 512, 512, 127 - SW13};
                    pg8::SchedDense S{T / 256, 2 * FD / 256, F.G, cblk, (const char*)(F.ws + WS_H), (const char*)(wden + WD_13), (size_t)256 * 1024, (size_t)256 * 1024};
                    pg8::EpiSwiglu8 E{R + R_HMD, FD};
                    pg8::gemm_phase<pg8::EpiSwiglu8, pg8::SchedDense, true, true>(F.lds, g, S, E);
                } else {
                    pg8::Gemm g{1024, 1024, 1024, 127};
                    pg8::SchedDense S{T / 256, 2 * FD / 256, F.G, cblk, (const char*)(F.ws + WS_H), (const char*)(wden + WD_13), (size_t)256 * 1024 * 2, (size_t)256 * 1024 * 2};
                    pg8::EpiSwiglu E{(bf16_t*)(R + R_HMD), FD};
                    pg8::gemm_phase<pg8::EpiSwiglu, pg8::SchedDense, MK_ALIGN_VALU>(F.lds, g, S, E);
                }
            }
            SEAM(pb + 8);
            if (IN(pb + 9) && EN(12)) {
                if (F8_DENSE(fi)) {
                    pg8::Gemm g{FD / 2, FD / 2, FD / 2, 127 - SW2};
                    pg8::SchedDense S{T / 256, 4, F.G, cblk, (const char*)(R + R_HMD), (const char*)(wden + WD_2), (size_t)256 * FD, (size_t)256 * FD};
                    pg8::EpiResidB<false> E{XB, XB};
                    pg8::gemm_phase<pg8::EpiResidB<false>, pg8::SchedDense, true, true>(F.lds, g, S, E);
                } else {
                    pg8::Gemm g{FD, FD, FD, 127};
                    pg8::SchedDense S{T / 256, 4, F.G, cblk, (const char*)(R + R_HMD), (const char*)(wden + WD_2), (size_t)256 * FD * 2, (size_t)256 * FD * 2};
                    pg8::EpiResidB<false> E{XB, XB};
                    pg8::gemm_phase(F.lds, g, S, E);
                }
            }
            SEAM(pb + 9);
        }
    }
    if (IN(41) && EN(13)) norm_phase<3, false>(Fk, Fk.ws + WS_XB, Fk.out, args.in[29], true, nullptr);
    STAMP(42);
#undef IN
#undef SEAM
}

#if MK_TIME
#ifndef MK_TA
#define MK_TA 12
#endif
#ifndef MK_TB
#define MK_TB 12
#endif
__device__ float time_of(const unsigned long long* ts, int sel) {
    float t = 0.f;
    if (sel == 12) return (float)(ts[42] - ts[0]) * 0.01f;
    if (sel == 10) return (float)(ts[1] - ts[0]) * 0.01f;
    if (sel == 11) return (float)(ts[42] - ts[41]) * 0.01f;
    if (sel >= 20) { const int p = sel - 20; return (float)(ts[p + 1] - ts[p]) * 0.01f; }
    for (int l = 0; l < 4; ++l) { const int p = 1 + 10 * l + sel; t += (float)(ts[p + 1] - ts[p]) * 0.01f; }
    return t;
}
__global__ void time_encode(const unsigned long long* ts, float* out, int n) {
    const float ta = time_of(ts, MK_TA), tb = time_of(ts, MK_TB);
    const float a = sqrtf(ta * 0.1f);
    for (size_t i = (size_t)blockIdx.x * blockDim.x + threadIdx.x; i < (size_t)n; i += (size_t)gridDim.x * blockDim.x) { unsigned hsh = (unsigned)i * 2654435761u; hsh ^= hsh >> 15; out[i] = (hsh & 1u) ? a : -a; }
    if (blockIdx.x == 0 && threadIdx.x == 0) out[0] = tb;
}
#endif
extern "C" void kernel_launch(void* const* d_in, const int* in_sizes, int n_in, void* d_out, int out_size, void* d_ws, size_t ws_size, hipStream_t stream) {
    static int grid = 0;
    if (grid == 0) {
        if (n_in != 30 || out_size != T * DM || ws_size < WS_END) { fprintf(stderr, "kernel_launch: unexpected shapes (n_in %d out %d ws %zu)\n", n_in, out_size, ws_size); grid = -1; return; }
        int dev = 0, cus = 0, per_cu = 0;
        if (hipGetDevice(&dev) != hipSuccess || hipDeviceGetAttribute(&cus, hipDeviceAttributeMultiprocessorCount, dev) != hipSuccess) { grid = -1; return; }
        if (hipFuncSetAttribute((const void*)mk_fwd, hipFuncAttributeMaxDynamicSharedMemorySize, LDS_BYTES) != hipSuccess) { fprintf(stderr, "kernel_launch: hipFuncSetAttribute failed\n"); grid = -1; return; }
        if (hipOccupancyMaxActiveBlocksPerMultiprocessor(&per_cu, (const void*)mk_fwd, NTHR, LDS_BYTES) != hipSuccess || per_cu < 1) { fprintf(stderr, "kernel_launch: occupancy query says %d\n", per_cu); }
        (void)hipGetLastError();
        grid = cus;
    }
    if (grid < 0) return;
    (void)hipMemsetAsync((char*)d_ws + WS_CTL, 0, CTL_ZERO_BYTES, stream);
    Args a{};
    for (int i = 0; i < 30; ++i) a.in[i] = (const float*)d_in[i];
    a.out = (float*)d_out; a.ws = (unsigned char*)d_ws;
#if MK_CHECK
    {
        float* err = (float*)((char*)d_ws + WS_END); float* xsave = (float*)((char*)d_ws + WS_END + MiB);
        unsigned char* ws = (unsigned char*)d_ws; unsigned char* R = ws + WS_R; const float* const* in = (const float* const*)d_in;
        const float* rc = (const float*)(ws + WS_ROPEC); const float* rs = (const float*)(ws + WS_ROPES);
        (void)hipMemsetAsync(err, 0, 4096, stream);
#define LNCH(lo_, hi_) do { (void)hipMemsetAsync((char*)d_ws + WS_CTL, 0, CTL_ZERO_BYTES, stream); a.ph_lo = (lo_); a.ph_hi = (hi_); hipLaunchKernelGGL(mk_fwd, dim3(grid), dim3(NTHR), LDS_BYTES, stream, a); } while (0)
#if MK_CHECK == 3
        LNCH(0, 1); hipLaunchKernelGGL(chk_wcat, dim3(2048), dim3(256), 0, stream, (const bf16_t*)(ws + WS_WMIX + WM_CAT), in[2], in[17], err);
#elif MK_CHECK == 33 || MK_CHECK == 34 || MK_CHECK == 35 || MK_CHECK == 36 || MK_CHECK == 37
        LNCH(0, 2); LNCH(2, 3);  hipLaunchKernelGGL(chk_inproj, dim3(CHK_NROWS), dim3(256), 0, stream, (const bf16_t*)(ws + WS_H), in[2], in[17], in[18], R, rc, rs, err, 20);
#elif MK_CHECK == 1
        LNCH(0, 2);  hipLaunchKernelGGL(chk_norm, dim3(CHK_NROWS), dim3(256), 0, stream, in[0], in[1], (const bf16_t*)(ws + WS_H), err, 0);
        LNCH(2, 3);  hipLaunchKernelGGL(chk_inproj, dim3(CHK_NROWS), dim3(256), 0, stream, (const bf16_t*)(ws + WS_H), in[2], in[17], in[18], R, rc, rs, err, 1);
        LNCH(3, 4);  hipLaunchKernelGGL(chk_mlaup, dim3(CHK_NROWS), dim3(256), 0, stream, R, in[9], in[10], in[7], in[8], rc, rs, err, 8);
                     hipLaunchKernelGGL(chk_gmlp, dim3(CHK_NROWS), dim3(256), 0, stream, R, in[3], in[4], in[5], in[6], err, 12);
        LNCH(4, 5);  hipLaunchKernelGGL(chk_attn, dim3(2 * 16 * 12), dim3(256), 0, stream, R, (const float*)(ws + WS_BIAST), in[15], (const float*)(ws + WS_LAM), 0, err, 13);
        LNCH(5, 6);  hipLaunchKernelGGL(chk_merged, dim3(CHK_NROWS), dim3(256), 0, stream, R, in[19], err, 15);
        LNCH(6, 7);  hipLaunchKernelGGL(chk_resid, dim3(CHK_NROWS), dim3(256), 0, stream, (const bf16_t*)(R + R_MERGED), 1024, in[20], in[0], (const float*)nullptr, (const float*)d_out, err, 16);
        LNCH(7, 8);  hipLaunchKernelGGL(chk_norm, dim3(CHK_NROWS), dim3(256), 0, stream, (const float*)d_out, in[21], (const bf16_t*)(ws + WS_H), err, 17);
        LNCH(8, 10); hipLaunchKernelGGL(chk_swiglu, dim3(128), dim3(256), 0, stream, (const bf16_t*)(ws + WS_H), in[22], in[23], FD, (const bf16_t*)(R + R_HMD), err, 18);
        hipLaunchKernelGGL(chk_save_rows, dim3(CHK_NROWS), dim3(256), 0, stream, (const float*)d_out, xsave);
        LNCH(10, 11); hipLaunchKernelGGL(chk_resid, dim3(CHK_NROWS), dim3(256), 0, stream, (const bf16_t*)(R + R_HMD), FD, in[24], (const float*)nullptr, (const float*)xsave, (const float*)d_out, err, 19);
#else
        LNCH(0, 21); hipLaunchKernelGGL(chk_moe, dim3(64), dim3(256), 0, stream, (const float*)d_out, in[21] + 1024, in[25], in[26], in[27], in[28], ws, err, 20);
        hipLaunchKernelGGL(chk_save_rows, dim3(CHK_NROWS), dim3(256), 0, stream, (const float*)d_out, xsave);
        LNCH(21, 22); hipLaunchKernelGGL(chk_combine, dim3(CHK_NROWS), dim3(256), 0, stream, (const float*)xsave, (const float*)d_out, ws, err, 24);
#endif
        hipLaunchKernelGGL(chk_encode, dim3(1024), dim3(256), 0, stream, (const float*)err, (float*)d_out, out_size);
    }
#elif MK_MULTI
    for (int p = 0; p < N_PHASES; ++p) { a.ph_lo = p; a.ph_hi = p + 1; hipLaunchKernelGGL(mk_fwd, dim3(grid), dim3(NTHR), LDS_BYTES, stream, a); }
#else
#ifndef MK_PH_HI
#define MK_PH_HI N_PHASES
#endif
    a.ph_lo = 0; a.ph_hi = MK_PH_HI;
    hipLaunchKernelGGL(mk_fwd, dim3(grid), dim3(NTHR), LDS_BYTES, stream, a);
#if MK_TIME
    hipLaunchKernelGGL(time_encode, dim3(1024), dim3(256), 0, stream, (const unsigned long long*)((char*)d_ws + WS_END), (float*)d_out, out_size);
#endif
#endif
}
```
